# Optimizing an MI355X kernel written in HIP

```python
import jax, jax.numpy as jnp
from jax import lax
import numpy as np

D_MODEL = 1024
BATCH = 4
SEQ = 4096
DEPTH = 4

D_MIX = D_MODEL
HG_HEADS = 4
HG_DK = 128
HG_DV = 128
HG_W = HG_HEADS * HG_DV
HG_CHUNK = 64
NSA_HEADS = 8
NSA_KV_HEADS = 2
NSA_DH = 64
NSA_G = NSA_HEADS // NSA_KV_HEADS
NSA_W = NSA_HEADS * NSA_DH
KV_W = NSA_KV_HEADS * NSA_DH
CMP_BLOCK = 32
CMP_STRIDE = 16
CMP_HIDDEN = 128
SLC_BLOCK = 64
SLC_TOPK = 16
SLC_Q_BLOCK = 64
WINDOW = 512
Q_BLOCK = 128
FORCE_SCORE = 1e4
ROPE_THETA = 500000.0
ROPE_DIM = NSA_DH // 4
PLE_DIM = 256
RMS_EPS = 1e-6
IN_SPLITS = (HG_W,) * 5 + (NSA_W,) + (KV_W,) * 6 + (3 * NSA_HEADS, NSA_W)
IN_COLS = 5 * HG_W + NSA_W + 6 * KV_W + 3 * NSA_HEADS + NSA_W

kernel_name = "hymba_hgrn2_nsa_trunk"


def rmsnorm(x, g):
    xf = x.astype(jnp.float32)
    var = jnp.mean(xf * xf, axis=-1, keepdims=True)
    return (xf * lax.rsqrt(var + RMS_EPS)).astype(x.dtype) * g


def masked_softmax(s, mask):
    s = jnp.where(mask, s.astype(jnp.float32), -jnp.inf)
    m = jnp.max(s, axis=-1, keepdims=True)
    m = jnp.where(jnp.isfinite(m), m, 0.0)
    e = jnp.where(mask, jnp.exp(s - m), 0.0)
    return e / jnp.maximum(jnp.sum(e, axis=-1, keepdims=True), 1e-30)


def rope_tables(seq):
    pos = jnp.arange(seq, dtype=jnp.float32)
    inv = ROPE_THETA ** (-jnp.arange(0, ROPE_DIM, 2, dtype=jnp.float32) / ROPE_DIM)
    ang = pos[:, None] * inv[None, :]
    return jnp.cos(ang), jnp.sin(ang)


def partial_rope(x, cos, sin):
    half = ROPE_DIM // 2
    x1, x2, xp = x[..., :half], x[..., half:ROPE_DIM], x[..., ROPE_DIM:]
    c = cos.astype(x.dtype)
    s = sin.astype(x.dtype)
    return jnp.concatenate([x1 * c - x2 * s, x1 * s + x2 * c, xp], axis=-1)


def heads(a, n):
    B, T, W = a.shape
    return a.reshape(B, T, n, W // n).transpose(0, 2, 1, 3)


def hgrn2_chunkwise(q, log_f, k, v):
    B, H, T, DK = q.shape
    DV = v.shape[-1]
    C = HG_CHUNK
    N = T // C

    def to_chunks(a):
        return jnp.moveaxis(a.reshape(B, H, N, C, a.shape[-1]), 2, 0)

    causal = jnp.tril(jnp.ones((C, C), dtype=bool))[:, :, None]

    def step(S, inp):
        qi, lfi, ki, vi = inp
        b = jnp.cumsum(lfi.astype(jnp.float32), axis=-2)
        diff = b[..., :, None, :] - b[..., None, :, :]
        decay = jnp.exp(jnp.where(causal, diff, -jnp.inf))
        A = jnp.einsum('bhtd,bhsd,bhtsd->bhts', qi, ki, decay)
        o = jnp.einsum('bhts,bhsv->bhtv', A, vi) + jnp.einsum('bhtd,bhdv->bhtv', qi * jnp.exp(b), S)
        b_last = b[..., -1:, :]
        S_new = jnp.exp(b_last[..., 0, :])[..., None] * S + jnp.einsum(
            'bhsd,bhsv->bhdv', ki * jnp.exp(b_last - b), vi)
        return S_new, o

    S0 = jnp.zeros((B, H, DK, DV), jnp.float32)
    _, o = lax.scan(step, S0, (to_chunks(q), to_chunks(log_f), to_chunks(k), to_chunks(v)))
    return jnp.moveaxis(o, 0, 2).reshape(B, H, T, DV).astype(v.dtype)


def compress(kv, pe, w1, w2):
    B, G, T, dh = kv.shape
    NC = (T - CMP_BLOCK) // CMP_STRIDE + 1
    idx = jnp.arange(NC)[:, None] * CMP_STRIDE + jnp.arange(CMP_BLOCK)[None, :]
    blocks = kv[:, :, idx, :] + pe
    flat = blocks.reshape(B, G, NC, CMP_BLOCK * dh)
    return jax.nn.silu(flat @ w1) @ w2


def window_attn(q, k, v, scale):
    B, KVH, G, T, dh = q.shape
    NB = T // Q_BLOCK
    NW = WINDOW // Q_BLOCK
    pad = ((0, 0), (0, 0), (WINDOW, 0), (0, 0))
    kb = jnp.pad(k, pad).reshape(B, KVH, NB + NW, Q_BLOCK, dh)
    vb = jnp.pad(v, pad).reshape(B, KVH, NB + NW, Q_BLOCK, dh)
    band_k = jnp.concatenate([kb[:, :, i:i + NB] for i in range(NW + 1)], axis=3)
    band_v = jnp.concatenate([vb[:, :, i:i + NB] for i in range(NW + 1)], axis=3)
    qb = q.reshape(B, KVH, G, NB, Q_BLOCK, dh)
    s = jnp.einsum('bgnxqd,bgxkd->bgnxqk', qb, band_k) * scale
    qpos = jnp.arange(NB)[:, None] * Q_BLOCK + jnp.arange(Q_BLOCK)[None, :]
    kpos = jnp.arange(NB)[:, None] * Q_BLOCK - WINDOW + jnp.arange((NW + 1) * Q_BLOCK)[None, :]
    d = qpos[:, :, None] - kpos[:, None, :]
    mask = (d >= 0) & (d < WINDOW) & (kpos[:, None, :] >= 0)
    p = masked_softmax(s, mask)
    o = jnp.einsum('bgnxqk,bgxkd->bgnxqd', p.astype(v.dtype), band_v)
    return o.reshape(B, KVH, G, T, dh)


def selected_attn(q, k, v, sel, scale):
    B, KVH, G, T, dh = q.shape
    K = sel.shape[-1]
    NB = T // SLC_Q_BLOCK
    qb = jnp.moveaxis(q.reshape(B, KVH, G, NB, SLC_Q_BLOCK, dh), 3, 0)
    sb = jnp.moveaxis(sel.reshape(B, KVH, NB, SLC_Q_BLOCK, K), 2, 0)
    t0 = jnp.arange(NB) * SLC_Q_BLOCK
    bi = jnp.arange(B)[:, None, None, None]
    gi = jnp.arange(KVH)[None, :, None, None]

    def one(args):
        qx, sx, s0 = args
        tok = (sx[..., None] * SLC_BLOCK + jnp.arange(SLC_BLOCK)).reshape(B, KVH, SLC_Q_BLOCK, K * SLC_BLOCK)
        kg = k[bi, gi, tok]
        vg = v[bi, gi, tok]
        s = jnp.einsum('bgnqd,bgqkd->bgnqk', qx, kg) * scale
        qpos = s0 + jnp.arange(SLC_Q_BLOCK)
        mask = (tok <= qpos[:, None])[:, :, None]
        p = masked_softmax(s, mask)
        return jnp.einsum('bgnqk,bgqkd->bgnqd', p.astype(vg.dtype), vg)

    o = lax.map(one, (qb, sb, t0))
    return jnp.moveaxis(o, 0, 3).reshape(B, KVH, G, T, dh)


def setup_inputs(seed: int = 0) -> dict:
    key = jax.random.key(seed)
    ks = jax.random.split(key, 16)
    n = jax.random.normal
    f32 = jnp.float32
    return {
        "x": n(ks[0], (BATCH, SEQ, D_MODEL), f32),
        "p": n(ks[1], (DEPTH, BATCH, SEQ, PLE_DIM), f32),
        "norm_g": 1.0 + 0.05 * n(ks[2], (DEPTH, D_MODEL), f32),
        "w_in": n(ks[3], (DEPTH, D_MODEL, IN_COLS), f32) * D_MODEL ** -0.5,
        "hgrn_lb": 0.5 * n(ks[4], (DEPTH, HG_HEADS * HG_DK), f32),
        "hgrn_onorm_g": 1.0 + 0.05 * n(ks[5], (DEPTH, HG_DV), f32),
        "nsa_qnorm_g": 1.0 + 0.05 * n(ks[6], (DEPTH, NSA_DH), f32),
        "nsa_knorm_g": 1.0 + 0.05 * n(ks[7], (DEPTH, 3, NSA_DH), f32),
        "cmp_pe": 0.1 * n(ks[8], (DEPTH, 2, CMP_BLOCK, NSA_DH), f32),
        "cmp_w1": n(ks[9], (DEPTH, 2, CMP_BLOCK * NSA_DH, CMP_HIDDEN), f32) * (CMP_BLOCK * NSA_DH) ** -0.5,
        "cmp_w2": n(ks[10], (DEPTH, 2, CMP_HIDDEN, NSA_DH), f32) * CMP_HIDDEN ** -0.5,
        "w_out": n(ks[11], (DEPTH, D_MIX, D_MODEL), f32) * (0.5 * D_MIX ** -0.5),
        "ple_norm_g": 1.0 + 0.05 * n(ks[12], (DEPTH, D_MODEL), f32),
        "w_pg": n(ks[13], (DEPTH, D_MODEL, D_MODEL), f32) * D_MODEL ** -0.5,
        "w_pp": n(ks[14], (DEPTH, PLE_DIM, D_MODEL), f32) * (0.5 * PLE_DIM ** -0.5),
    }


def reference(x, p, norm_g, w_in, hgrn_lb, hgrn_onorm_g, nsa_qnorm_g, nsa_knorm_g,
              cmp_pe, cmp_w1, cmp_w2, w_out, ple_norm_g, w_pg, w_pp):
    B, T, _ = x.shape
    KVH, G, dh = NSA_KV_HEADS, NSA_G, NSA_DH
    scale = dh ** -0.5
    split_points = np.cumsum(IN_SPLITS)[:-1].tolist()

    cos, sin = rope_tables(T)
    lb_all = jnp.cumsum(jax.nn.softmax(hgrn_lb.astype(jnp.float32), axis=0), axis=0)
    lb_all = lb_all - lb_all[0]

    NC = (T - CMP_BLOCK) // CMP_STRIDE + 1
    NSB = T // SLC_BLOCK
    top_k = min(SLC_TOPK, NSB)
    c_tok = jnp.arange(NC)[:, None] * CMP_STRIDE + jnp.arange(CMP_BLOCK)[None, :]
    overlap = jnp.mean((c_tok[..., None] // SLC_BLOCK == jnp.arange(NSB)).astype(jnp.float32), axis=1)
    c_end = jnp.arange(NC) * CMP_STRIDE + CMP_BLOCK - 1
    cmp_mask = c_end[None, :] <= jnp.arange(T)[:, None]
    cur = (jnp.arange(T) // SLC_BLOCK)[:, None]
    jb = jnp.arange(NSB)[None, :]
    forced = (jb == 0) | (jb == cur) | (jb == cur - 1)
    eligible = jb <= cur

    h = x
    for i in range(DEPTH):
        xn = rmsnorm(h, norm_g[i])
        proj = xn @ w_in[i]
        (hq, hf, hi, hgo, hz, nq, kcm, vcm, ksl, vsl, kwn, vwn, ngate, nz) = jnp.split(proj, split_points, axis=-1)

        lb = lb_all[i].reshape(HG_HEADS, 1, HG_DK)
        fl = heads(hf, HG_HEADS).astype(jnp.float32)
        log_f = jnp.logaddexp(jnp.log(lb), jnp.log1p(-lb) + jax.nn.log_sigmoid(fl))
        k_hg = (1.0 - lb) * jax.nn.sigmoid(-fl)
        o_hg = hgrn2_chunkwise(heads(hq, HG_HEADS), log_f, k_hg, heads(hi, HG_HEADS))
        o_hg = rmsnorm(o_hg, hgrn_onorm_g[i]).transpose(0, 2, 1, 3).reshape(B, T, HG_W)
        y_hg = o_hg * jax.nn.sigmoid(hgo) * jax.nn.silu(hz)

        qn = rmsnorm(heads(nq, NSA_HEADS), nsa_qnorm_g[i])
        q_nope = qn.reshape(B, KVH, G, T, dh)
        q_rope = partial_rope(qn, cos, sin).reshape(B, KVH, G, T, dh)

        kc = rmsnorm(compress(heads(kcm, KVH), cmp_pe[i, 0], cmp_w1[i, 0], cmp_w2[i, 0]), nsa_knorm_g[i, 0])
        vc = compress(heads(vcm, KVH), cmp_pe[i, 1], cmp_w1[i, 1], cmp_w2[i, 1])
        s_cmp = jnp.einsum('bgntd,bgcd->bgntc', q_nope, kc) * scale
        p_cmp = masked_softmax(s_cmp, cmp_mask)
        o_cmp = jnp.einsum('bgntc,bgcd->bgntd', p_cmp.astype(vc.dtype), vc)

        imp = jnp.einsum('bgntc,cj->bgtj', p_cmp, overlap)
        score = jnp.where(forced, FORCE_SCORE, jnp.where(eligible, imp, -1.0))
        _, sel = lax.top_k(score, top_k)
        k_sl = partial_rope(rmsnorm(heads(ksl, KVH), nsa_knorm_g[i, 1]), cos, sin)
        o_slc = selected_attn(q_rope, k_sl, heads(vsl, KVH), sel, scale)

        k_wn = partial_rope(rmsnorm(heads(kwn, KVH), nsa_knorm_g[i, 2]), cos, sin)
        o_win = window_attn(q_rope, k_wn, heads(vwn, KVH), scale)

        gates = jax.nn.sigmoid(ngate).reshape(B, T, 3, KVH, G).transpose(2, 0, 3, 4, 1)[..., None]
        o_nsa = gates[0] * o_cmp + gates[1] * o_slc + gates[2] * o_win
        o_nsa = o_nsa.reshape(B, NSA_HEADS, T, dh).transpose(0, 2, 1, 3).reshape(B, T, NSA_W)
        y_nsa = o_nsa * jax.nn.silu(nz)

        h = h + jnp.concatenate([y_hg, y_nsa], axis=-1) @ w_out[i]

        gate = jax.nn.sigmoid(rmsnorm(h, ple_norm_g[i]) @ w_pg[i])
        h = h + gate * (p[i] @ w_pp[i])
    return h
```

```cpp
#include <hip/hip_runtime.h>
#include <stdint.h>

constexpr int D_MODEL = 1024, BATCH = 4, SEQ = 4096, DEPTH = 4;
constexpr int HG_HEADS = 4, HG_DK = 128, HG_DV = 128, HG_W = 512;
constexpr int NSA_HEADS = 8, KVH = 2, DH = 64, GRP = 4, NSA_W = 512, KV_W = 128;
constexpr int CMP_BLOCK = 32, CMP_STRIDE = 16, CMP_HIDDEN = 128, SLC_BLOCK = 64, SLC_TOPK = 16, WINDOW = 512;
constexpr int NC = (SEQ - CMP_BLOCK) / CMP_STRIDE + 1;
constexpr int NCP = 256;
constexpr int NSB = SEQ / SLC_BLOCK;
constexpr int PLE = 256;
constexpr int IN_COLS = 4376;
constexpr float RMS_EPS = 1e-6f;
constexpr int C_HQ = 0, C_HF = 512, C_HI = 1024, C_HGO = 1536, C_HZ = 2048, C_NQ = 2560, C_KCM = 3072, C_VCM = 3200,
              C_KSL = 3328, C_VSL = 3456, C_KWN = 3584, C_VWN = 3712, C_NGATE = 3840, C_NZ = 3864;

__device__ __forceinline__ float sigmoidf_(float x) { return 1.f / (1.f + expf(-x)); }
__device__ __forceinline__ float siluf_(float x) { return x * sigmoidf_(x); }

__global__ void k_tables(const float* __restrict__ hgrn_lb, float* __restrict__ lb_all, float* __restrict__ ropec,
                         float* __restrict__ ropes) {
    int i = blockIdx.x * blockDim.x + threadIdx.x;
    if (i < HG_W) {
        float v[DEPTH];
        float m = -1e30f;
        for (int l = 0; l < DEPTH; ++l) { v[l] = hgrn_lb[l * HG_W + i]; m = fmaxf(m, v[l]); }
        float s = 0.f;
        for (int l = 0; l < DEPTH; ++l) { v[l] = expf(v[l] - m); s += v[l]; }
        float c = 0.f;
        for (int l = 0; l < DEPTH; ++l) {
            if (l > 0) c += v[l] / s;
            lb_all[l * HG_W + i] = c;
        }
    }
    if (i < SEQ * 8) {
        int t = i >> 3, j = i & 7;
        double inv = pow(500000.0, -(double)(2 * j) / 16.0);
        double ang = (double)t * inv;
        ropec[i] = (float)cos(ang);
        ropes[i] = (float)sin(ang);
    }
}

__global__ void k_rmsnorm1024(const float* __restrict__ h, const float* __restrict__ g, float* __restrict__ out) {
    __shared__ float red[4];
    int row = blockIdx.x, tid = threadIdx.x;
    const float4 v = reinterpret_cast<const float4*>(h + (size_t)row * D_MODEL)[tid];
    float ss = v.x * v.x + v.y * v.y + v.z * v.z + v.w * v.w;
    for (int o = 32; o > 0; o >>= 1) ss += __shfl_xor(ss, o);
    if ((tid & 63) == 0) red[tid >> 6] = ss;
    __syncthreads();
    float tot = red[0] + red[1] + red[2] + red[3];
    float r = rsqrtf(tot / (float)D_MODEL + RMS_EPS);
    const float4 gg = reinterpret_cast<const float4*>(g)[tid];
    float4 o4;
    o4.x = v.x * r * gg.x; o4.y = v.y * r * gg.y; o4.z = v.z * r * gg.z; o4.w = v.w * r * gg.w;
    reinterpret_cast<float4*>(out + (size_t)row * D_MODEL)[tid] = o4;
}

template <int ACC>
__global__ void __launch_bounds__(256) k_gemm(const float* __restrict__ A, int lda, const float* __restrict__ B, int ldb,
                                              float* __restrict__ C, int ldc, int M, int N, int K) {
    __shared__ float As[16][64 + 4];
    __shared__ float Bs[16][64 + 4];
    int tid = threadIdx.x;
    int m0 = blockIdx.y * 64, n0 = blockIdx.x * 64;
    int tx = tid & 15, ty = tid >> 4;
    float acc[4][4];
#pragma unroll
    for (int i = 0; i < 4; ++i)
#pragma unroll
        for (int j = 0; j < 4; ++j) acc[i][j] = 0.f;
    for (int k0 = 0; k0 < K; k0 += 16) {
        {
            int r = tid >> 2, kq = (tid & 3) * 4;
            const float4 a = *reinterpret_cast<const float4*>(A + (size_t)(m0 + r) * lda + k0 + kq);
            As[kq + 0][r] = a.x; As[kq + 1][r] = a.y; As[kq + 2][r] = a.z; As[kq + 3][r] = a.w;
        }
        {
            int kk = tid >> 4, nq = (tid & 15) * 4;
#pragma unroll
            for (int j = 0; j < 4; ++j) {
                int n = n0 + nq + j;
                Bs[kk][nq + j] = (n < N) ? B[(size_t)(k0 + kk) * ldb + n] : 0.f;
            }
        }
        __syncthreads();
#pragma unroll
        for (int kk = 0; kk < 16; ++kk) {
            float a[4], b[4];
#pragma unroll
            for (int i = 0; i < 4; ++i) a[i] = As[kk][ty * 4 + i];
#pragma unroll
            for (int j = 0; j < 4; ++j) b[j] = Bs[kk][tx * 4 + j];
#pragma unroll
            for (int i = 0; i < 4; ++i)
#pragma unroll
                for (int j = 0; j < 4; ++j) acc[i][j] = fmaf(a[i], b[j], acc[i][j]);
        }
        __syncthreads();
    }
#pragma unroll
    for (int i = 0; i < 4; ++i)
#pragma unroll
        for (int j = 0; j < 4; ++j) {
            int m = m0 + ty * 4 + i, n = n0 + tx * 4 + j;
            if (n < N) {
                size_t idx = (size_t)m * ldc + n;
                if (ACC) C[idx] += acc[i][j]; else C[idx] = acc[i][j];
            }
        }
}

__global__ void __launch_bounds__(64) k_hgrn_scan(const float* __restrict__ proj, const float* __restrict__ lb_l,
                                                 float* __restrict__ o_raw) {
    int hv = blockIdx.x;
    int hd = hv >> 7;
    int lane = threadIdx.x;
    int c0 = hd * HG_DK + lane, c1 = c0 + 64;
    float lb0 = lb_l[c0], lb1 = lb_l[c1];
    float S0 = 0.f, S1 = 0.f;
    for (int t = 0; t < SEQ; ++t) {
        const float* pr = proj + (size_t)t * IN_COLS;
        float fl0 = pr[C_HF + c0], fl1 = pr[C_HF + c1];
        float q0 = pr[C_HQ + c0], q1 = pr[C_HQ + c1];
        float v = pr[C_HI + hv];
        float f0 = lb0 + (1.f - lb0) * sigmoidf_(fl0), f1 = lb1 + (1.f - lb1) * sigmoidf_(fl1);
        float k0 = (1.f - lb0) * sigmoidf_(-fl0), k1 = (1.f - lb1) * sigmoidf_(-fl1);
        S0 = f0 * S0 + k0 * v;
        S1 = f1 * S1 + k1 * v;
        float part = q0 * S0 + q1 * S1;
        for (int o = 32; o > 0; o >>= 1) part += __shfl_xor(part, o);
        if (lane == 0) o_raw[(size_t)t * HG_W + hv] = part;
    }
}

__global__ void __launch_bounds__(512) k_hgrn_out(const float* __restrict__ o_raw, const float* __restrict__ proj,
                                                  const float* __restrict__ onorm_g, float* __restrict__ y) {
    __shared__ float red[8];
    int t = blockIdx.x, c = threadIdx.x;
    float v = o_raw[(size_t)t * HG_W + c];
    float ss = v * v;
    for (int o = 32; o > 0; o >>= 1) ss += __shfl_xor(ss, o);
    if ((c & 63) == 0) red[c >> 6] = ss;
    __syncthreads();
    int hd = c >> 7;
    float tot = red[hd * 2] + red[hd * 2 + 1];
    float r = rsqrtf(tot / (float)HG_DV + RMS_EPS);
    const float* pr = proj + (size_t)t * IN_COLS;
    float o = v * r * onorm_g[c & 127];
    y[(size_t)t * D_MODEL + c] = o * sigmoidf_(pr[C_HGO + c]) * siluf_(pr[C_HZ + c]);
}

__global__ void k_nsa_prep(const float* __restrict__ proj, const float* __restrict__ qg, const float* __restrict__ kg,
                           const float* __restrict__ ropec, const float* __restrict__ ropes, float* __restrict__ q_nope,
                           float* __restrict__ q_rope, float* __restrict__ k_sl, float* __restrict__ k_wn) {
    int i = blockIdx.x * blockDim.x + threadIdx.x;
    if (i >= SEQ * 12) return;
    int t = i / 12, u = i % 12;
    const float* src;
    const float* g;
    if (u < 8) { src = proj + (size_t)t * IN_COLS + C_NQ + u * DH; g = qg; }
    else if (u < 10) { src = proj + (size_t)t * IN_COLS + C_KSL + (u - 8) * DH; g = kg + 1 * DH; }
    else { src = proj + (size_t)t * IN_COLS + C_KWN + (u - 10) * DH; g = kg + 2 * DH; }
    float ss = 0.f;
    for (int j = 0; j < DH; ++j) { float v = src[j]; ss += v * v; }
    float r = rsqrtf(ss / (float)DH + RMS_EPS);
    float* dn = nullptr;
    float* dr;
    if (u < 8) { dn = q_nope + (size_t)t * NSA_W + u * DH; dr = q_rope + (size_t)t * NSA_W + u * DH; }
    else if (u < 10) dr = k_sl + (size_t)t * KV_W + (u - 8) * DH;
    else dr = k_wn + (size_t)t * KV_W + (u - 10) * DH;
    for (int j = 0; j < DH; ++j) {
        float v = src[j] * r * g[j];
        if (dn) dn[j] = v;
        if (j >= 16) dr[j] = v;
    }
    for (int j = 0; j < 8; ++j) {
        float x1 = src[j] * r * g[j], x2 = src[j + 8] * r * g[j + 8];
        float c = ropec[t * 8 + j], s = ropes[t * 8 + j];
        dr[j] = x1 * c - x2 * s;
        dr[j + 8] = x1 * s + x2 * c;
    }
}

__global__ void k_cmp_hidden(const float* __restrict__ proj, const float* __restrict__ pe, const float* __restrict__ w1,
                             float* __restrict__ hid) {
    int i = blockIdx.x * blockDim.x + threadIdx.x;
    if (i >= 2 * KVH * NC * CMP_HIDDEN) return;
    int n = i % CMP_HIDDEN;
    int c = (i / CMP_HIDDEN) % NC;
    int g = (i / (CMP_HIDDEN * NC)) % KVH;
    int kv = i / (CMP_HIDDEN * NC * KVH);
    int col = (kv == 0 ? C_KCM : C_VCM) + g * DH;
    const float* pek = pe + (size_t)kv * CMP_BLOCK * DH;
    const float* w = w1 + (size_t)kv * CMP_BLOCK * DH * CMP_HIDDEN;
    float acc = 0.f;
    for (int l = 0; l < CMP_BLOCK; ++l) {
        const float* pr = proj + (size_t)(c * CMP_STRIDE + l) * IN_COLS + col;
        for (int j = 0; j < DH; ++j) acc = fmaf(pr[j] + pek[l * DH + j], w[(size_t)(l * DH + j) * CMP_HIDDEN + n], acc);
    }
    hid[i] = siluf_(acc);
}
__global__ void k_cmp_out(const float* __restrict__ hid, const float* __restrict__ w2, const float* __restrict__ kg0,
                          float* __restrict__ kvc) {
    int i = blockIdx.x * blockDim.x + threadIdx.x;
    if (i >= 2 * KVH * NC) return;
    int kv = i / (KVH * NC);
    const float* hrow = hid + (size_t)i * CMP_HIDDEN;
    const float* w = w2 + (size_t)kv * CMP_HIDDEN * DH;
    float out[DH];
#pragma unroll
    for (int j = 0; j < DH; ++j) out[j] = 0.f;
    for (int n = 0; n < CMP_HIDDEN; ++n) {
        float hv = hrow[n];
#pragma unroll
        for (int j = 0; j < DH; ++j) out[j] = fmaf(hv, w[n * DH + j], out[j]);
    }
    float r = 1.f;
    if (kv == 0) {
        float ss = 0.f;
#pragma unroll
        for (int j = 0; j < DH; ++j) ss += out[j] * out[j];
        r = rsqrtf(ss / (float)DH + RMS_EPS);
    }
#pragma unroll
    for (int j = 0; j < DH; ++j) kvc[(size_t)i * DH + j] = (kv == 0) ? out[j] * r * kg0[j] : out[j];
}

__global__ void __launch_bounds__(64) k_cmp_attn(const float* __restrict__ q_nope, const float* __restrict__ kvc,
                                                 float* __restrict__ pbuf, float* __restrict__ o_cmp) {
    int i = blockIdx.x * blockDim.x + threadIdx.x;
    int t = i % SEQ, hd = i / SEQ;
    int g = hd / GRP;
    const float* kc = kvc + (size_t)(0 * KVH + g) * NC * DH;
    const float* vc = kvc + (size_t)(1 * KVH + g) * NC * DH;
    float q[DH];
#pragma unroll
    for (int j = 0; j < DH; ++j) q[j] = q_nope[(size_t)t * NSA_W + hd * DH + j];
    int nv = (t >= CMP_BLOCK - 1) ? ((t - (CMP_BLOCK - 1)) / CMP_STRIDE + 1) : 0;
    if (nv > NC) nv = NC;
    float* pb = pbuf + ((size_t)hd * SEQ + t) * NCP;
    float m = -INFINITY;
    for (int c = 0; c < nv; ++c) {
        float s = 0.f;
#pragma unroll
        for (int j = 0; j < DH; ++j) s = fmaf(q[j], kc[c * DH + j], s);
        s *= 0.125f;
        pb[c] = s;
        m = fmaxf(m, s);
    }
    float sum = 0.f;
    for (int c = 0; c < nv; ++c) sum += expf(pb[c] - m);
    float inv = 1.f / fmaxf(sum, 1e-30f);
    float acc[DH];
#pragma unroll
    for (int j = 0; j < DH; ++j) acc[j] = 0.f;
    for (int c = 0; c < nv; ++c) {
        float p = expf(pb[c] - m) * inv;
        pb[c] = p;
#pragma unroll
        for (int j = 0; j < DH; ++j) acc[j] = fmaf(p, vc[c * DH + j], acc[j]);
    }
    for (int c = nv; c < NCP; ++c) pb[c] = 0.f;
#pragma unroll
    for (int j = 0; j < DH; ++j) o_cmp[(size_t)t * NSA_W + hd * DH + j] = acc[j];
}

__global__ void k_topk(const float* __restrict__ pbuf, float* __restrict__ scorebuf, unsigned long long* __restrict__ selmask) {
    int i = blockIdx.x * blockDim.x + threadIdx.x;
    if (i >= KVH * SEQ) return;
    int t = i % SEQ, g = i / SEQ;
    int cur = t / SLC_BLOCK;
    float* sc = scorebuf + (size_t)i * NSB;
    for (int j = 0; j < NSB; ++j) {
        float imp = 0.f;
        for (int n = 0; n < GRP; ++n) {
            const float* pb = pbuf + ((size_t)(g * GRP + n) * SEQ + t) * NCP;
            float a = 0.f;
            if (4 * j - 1 >= 0) a += 0.5f * pb[4 * j - 1];
            a += pb[4 * j];
            a += pb[4 * j + 1];
            a += pb[4 * j + 2];
            if (4 * j + 3 < NC) a += 0.5f * pb[4 * j + 3];
            imp += a;
        }
        bool forced = (j == 0) || (j == cur) || (j == cur - 1);
        bool elig = (j <= cur);
        sc[j] = forced ? 1e4f : (elig ? imp : -1.0f);
    }
    unsigned long long mask = 0ull;
    for (int k = 0; k < SLC_TOPK; ++k) {
        float best = -INFINITY;
        int bj = 0;
        for (int j = 0; j < NSB; ++j) {
            float s = sc[j];
            if (s > best) { best = s; bj = j; }
        }
        mask |= (1ull << bj);
        sc[bj] = -INFINITY;
    }
    selmask[i] = mask;
}

__global__ void __launch_bounds__(64) k_slc_attn(const float* __restrict__ q_rope, const float* __restrict__ k_sl,
                                                 const float* __restrict__ proj, const unsigned long long* __restrict__ selmask,
                                                 float* __restrict__ o_slc) {
    int i = blockIdx.x * blockDim.x + threadIdx.x;
    int t = i % SEQ, hd = i / SEQ;
    int g = hd / GRP;
    float q[DH], acc[DH];
#pragma unroll
    for (int j = 0; j < DH; ++j) { q[j] = q_rope[(size_t)t * NSA_W + hd * DH + j]; acc[j] = 0.f; }
    unsigned long long mask = selmask[(size_t)g * SEQ + t];
    float m = -INFINITY, l = 0.f;
    for (int jb = 0; jb < NSB; ++jb) {
        if (!((mask >> jb) & 1ull)) continue;
        int k0 = jb * SLC_BLOCK;
        for (int kk = k0; kk < k0 + SLC_BLOCK && kk <= t; ++kk) {
            const float* kr = k_sl + (size_t)kk * KV_W + g * DH;
            const float* vr = proj + (size_t)kk * IN_COLS + C_VSL + g * DH;
            float s = 0.f;
#pragma unroll
            for (int j = 0; j < DH; ++j) s = fmaf(q[j], kr[j], s);
            s *= 0.125f;
            float mn = fmaxf(m, s);
            float a = expf(m - mn), p = expf(s - mn);
            l = l * a + p;
#pragma unroll
            for (int j = 0; j < DH; ++j) acc[j] = fmaf(p, vr[j], acc[j] * a);
            m = mn;
        }
    }
    float inv = 1.f / fmaxf(l, 1e-30f);
#pragma unroll
    for (int j = 0; j < DH; ++j) o_slc[(size_t)t * NSA_W + hd * DH + j] = acc[j] * inv;
}

__global__ void __launch_bounds__(64) k_win_attn(const float* __restrict__ q_rope, const float* __restrict__ k_wn,
                                                 const float* __restrict__ proj, float* __restrict__ o_win) {
    int i = blockIdx.x * blockDim.x + threadIdx.x;
    int t = i % SEQ, hd = i / SEQ;
    int g = hd / GRP;
    float q[DH], acc[DH];
#pragma unroll
    for (int j = 0; j < DH; ++j) { q[j] = q_rope[(size_t)t * NSA_W + hd * DH + j]; acc[j] = 0.f; }
    float m = -INFINITY, l = 0.f;
    int kstart = t - (WINDOW - 1);
    if (kstart < 0) kstart = 0;
    for (int kk = kstart; kk <= t; ++kk) {
        const float* kr = k_wn + (size_t)kk * KV_W + g * DH;
        const float* vr = proj + (size_t)kk * IN_COLS + C_VWN + g * DH;
        float s = 0.f;
#pragma unroll
        for (int j = 0; j < DH; ++j) s = fmaf(q[j], kr[j], s);
        s *= 0.125f;
        float mn = fmaxf(m, s);
        float a = expf(m - mn), p = expf(s - mn);
        l = l * a + p;
#pragma unroll
        for (int j = 0; j < DH; ++j) acc[j] = fmaf(p, vr[j], acc[j] * a);
        m = mn;
    }
    float inv = 1.f / fmaxf(l, 1e-30f);
#pragma unroll
    for (int j = 0; j < DH; ++j) o_win[(size_t)t * NSA_W + hd * DH + j] = acc[j] * inv;
}

__global__ void k_nsa_combine(const float* __restrict__ proj, const float* __restrict__ o_cmp, const float* __restrict__ o_slc,
                              const float* __restrict__ o_win, float* __restrict__ y) {
    int i = blockIdx.x * blockDim.x + threadIdx.x;
    if (i >= SEQ * NSA_W) return;
    int t = i / NSA_W, c = i % NSA_W;
    int hd = c / DH;
    const float* pr = proj + (size_t)t * IN_COLS;
    float g0 = sigmoidf_(pr[C_NGATE + 0 * NSA_HEADS + hd]);
    float g1 = sigmoidf_(pr[C_NGATE + 1 * NSA_HEADS + hd]);
    float g2 = sigmoidf_(pr[C_NGATE + 2 * NSA_HEADS + hd]);
    float o = g0 * o_cmp[i] + g1 * o_slc[i] + g2 * o_win[i];
    y[(size_t)t * D_MODEL + HG_W + c] = o * siluf_(pr[C_NZ + c]);
}

__global__ void k_ple_apply(float* __restrict__ h, const float* __restrict__ G, const float* __restrict__ P2, int n) {
    int i = blockIdx.x * blockDim.x + threadIdx.x;
    if (i >= n) return;
    h[i] += sigmoidf_(G[i]) * P2[i];
}

extern "C" void kernel_launch(void* const* d_in, const int* in_sizes, int n_in, void* d_out, int out_size, void* d_ws,
                              size_t ws_size, hipStream_t stream) {
    const float* x = (const float*)d_in[0];
    const float* p = (const float*)d_in[1];
    const float* norm_g = (const float*)d_in[2];
    const float* w_in = (const float*)d_in[3];
    const float* hgrn_lb = (const float*)d_in[4];
    const float* hgrn_onorm_g = (const float*)d_in[5];
    const float* nsa_qnorm_g = (const float*)d_in[6];
    const float* nsa_knorm_g = (const float*)d_in[7];
    const float* cmp_pe = (const float*)d_in[8];
    const float* cmp_w1 = (const float*)d_in[9];
    const float* cmp_w2 = (const float*)d_in[10];
    const float* w_out = (const float*)d_in[11];
    const float* ple_norm_g = (const float*)d_in[12];
    const float* w_pg = (const float*)d_in[13];
    const float* w_pp = (const float*)d_in[14];
    float* h = (float*)d_out;

    float* ws = (float*)d_ws;
    size_t off = 0;
    auto take = [&](size_t n) { float* r = ws + off; off += (n + 63) & ~(size_t)63; return r; };
    float* lb_all = take(DEPTH * HG_W);
    float* ropec = take(SEQ * 8);
    float* ropes = take(SEQ * 8);
    float* xn = take((size_t)SEQ * D_MODEL);
    float* proj = take((size_t)SEQ * IN_COLS);
    float* o_raw = take((size_t)SEQ * HG_W);
    float* y = take((size_t)SEQ * D_MODEL);
    float* q_nope = take((size_t)SEQ * NSA_W);
    float* q_rope = take((size_t)SEQ * NSA_W);
    float* k_sl = take((size_t)SEQ * KV_W);
    float* k_wn = take((size_t)SEQ * KV_W);
    float* hid = take((size_t)2 * KVH * NC * CMP_HIDDEN);
    float* kvc = take((size_t)2 * KVH * NC * DH);
    float* pbuf = take((size_t)NSA_HEADS * SEQ * NCP);
    float* o_cmp = take((size_t)SEQ * NSA_W);
    float* o_slc = take((size_t)SEQ * NSA_W);
    float* o_win = take((size_t)SEQ * NSA_W);
    float* scorebuf = take((size_t)KVH * SEQ * NSB);
    unsigned long long* selmask = (unsigned long long*)take((size_t)KVH * SEQ * 2);
    float* Gb = proj;
    float* P2 = proj + (size_t)SEQ * D_MODEL;

    hipMemcpyAsync(h, x, (size_t)BATCH * SEQ * D_MODEL * sizeof(float), hipMemcpyDeviceToDevice, stream);
    k_tables<<<(SEQ * 8 + 255) / 256, 256, 0, stream>>>(hgrn_lb, lb_all, ropec, ropes);

    for (int i = 0; i < DEPTH; ++i) {
        const float* w_in_i = w_in + (size_t)i * D_MODEL * IN_COLS;
        const float* w_out_i = w_out + (size_t)i * D_MODEL * D_MODEL;
        const float* w_pg_i = w_pg + (size_t)i * D_MODEL * D_MODEL;
        const float* w_pp_i = w_pp + (size_t)i * PLE * D_MODEL;
        for (int b = 0; b < BATCH; ++b) {
            float* hb = h + (size_t)b * SEQ * D_MODEL;
            const float* pb = p + ((size_t)i * BATCH + b) * SEQ * PLE;
            k_rmsnorm1024<<<SEQ, 256, 0, stream>>>(hb, norm_g + i * D_MODEL, xn);
            k_gemm<0><<<dim3((IN_COLS + 63) / 64, SEQ / 64), 256, 0, stream>>>(xn, D_MODEL, w_in_i, IN_COLS, proj, IN_COLS, SEQ,
                                                                             IN_COLS, D_MODEL);
            k_hgrn_scan<<<HG_HEADS * HG_DV, 64, 0, stream>>>(proj, lb_all + i * HG_W, o_raw);
            k_hgrn_out<<<SEQ, 512, 0, stream>>>(o_raw, proj, hgrn_onorm_g + i * HG_DV, y);
            k_nsa_prep<<<(SEQ * 12 + 255) / 256, 256, 0, stream>>>(proj, nsa_qnorm_g + i * DH, nsa_knorm_g + (size_t)i * 3 * DH,
                                                                  ropec, ropes, q_nope, q_rope, k_sl, k_wn);
            k_cmp_hidden<<<(2 * KVH * NC * CMP_HIDDEN + 255) / 256, 256, 0, stream>>>(
                proj, cmp_pe + (size_t)i * 2 * CMP_BLOCK * DH, cmp_w1 + (size_t)i * 2 * CMP_BLOCK * DH * CMP_HIDDEN, hid);
            k_cmp_out<<<(2 * KVH * NC + 63) / 64, 64, 0, stream>>>(hid, cmp_w2 + (size_t)i * 2 * CMP_HIDDEN * DH,
                                                                  nsa_knorm_g + (size_t)i * 3 * DH, kvc);
            k_cmp_attn<<<NSA_HEADS * SEQ / 64, 64, 0, stream>>>(q_nope, kvc, pbuf, o_cmp);
            k_topk<<<(KVH * SEQ + 63) / 64, 64, 0, stream>>>(pbuf, scorebuf, selmask);
            k_slc_attn<<<NSA_HEADS * SEQ / 64, 64, 0, stream>>>(q_rope, k_sl, proj, selmask, o_slc);
            k_win_attn<<<NSA_HEADS * SEQ / 64, 64, 0, stream>>>(q_rope, k_wn, proj, o_win);
            k_nsa_combine<<<(SEQ * NSA_W + 255) / 256, 256, 0, stream>>>(proj, o_cmp, o_slc, o_win, y);
            k_gemm<1><<<dim3(D_MODEL / 64, SEQ / 64), 256, 0, stream>>>(y, D_MODEL, w_out_i, D_MODEL, hb, D_MODEL, SEQ, D_MODEL,
                                                                       D_MODEL);
            k_rmsnorm1024<<<SEQ, 256, 0, stream>>>(hb, ple_norm_g + i * D_MODEL, xn);
            k_gemm<0><<<dim3(D_MODEL / 64, SEQ / 64), 256, 0, stream>>>(xn, D_MODEL, w_pg_i, D_MODEL, Gb, D_MODEL, SEQ, D_MODEL,
                                                                       D_MODEL);
            k_gemm<0><<<dim3(D_MODEL / 64, SEQ / 64), 256, 0, stream>>>(pb, PLE, w_pp_i, D_MODEL, P2, D_MODEL, SEQ, D_MODEL, PLE);
            k_ple_apply<<<(SEQ * D_MODEL + 255) / 256, 256, 0, stream>>>(hb, Gb, P2, SEQ * D_MODEL);
        }
    }
}
```

```cpp
#include <hip/hip_runtime.h>
#include <stdint.h>
#include <cstdio>

constexpr int D_MODEL = 1024, BATCH = 4, SEQ = 4096, DEPTH = 4, MROWS = BATCH * SEQ;
constexpr int HG_HEADS = 4, HG_DK = 128, HG_DV = 128, HG_W = 512;
constexpr int NSA_HEADS = 8, KVH = 2, DH = 64, GRP = 4, NSA_W = 512, KV_W = 128;
constexpr int CMP_BLOCK = 32, CMP_STRIDE = 16, CMP_HIDDEN = 128, SLC_BLOCK = 64, SLC_TOPK = 16, WINDOW = 512;
constexpr int NC = (SEQ - CMP_BLOCK) / CMP_STRIDE + 1;
constexpr int NSB = SEQ / SLC_BLOCK;
constexpr int PLE = 256;
constexpr int IN_COLS = 4376;
constexpr int NPROJ = 4608;
constexpr int PP = 4480;
constexpr float RMS_EPS = 1e-6f;
constexpr int C_HQ = 0, C_HF = 512, C_HI = 1024, C_HGO = 1536, C_HZ = 2048, C_NQ = 2560, C_KCM = 3072, C_VCM = 3200,
              C_KSL = 3328, C_VSL = 3456, C_KWN = 3584, C_VWN = 3712, C_NGATE = 3840, C_NZ = 3968;
constexpr int SRC_NGATE_END = 3864;

typedef unsigned short bf16;
#define LAS __attribute__((address_space(3)))
__device__ __forceinline__ float bf2f(bf16 v) { return __uint_as_float((unsigned)v << 16); }
__device__ __forceinline__ unsigned f2bf(float f) { unsigned u = __float_as_uint(f); return (u + 0x7fffu + ((u >> 16) & 1u)) >> 16; }
__device__ __forceinline__ unsigned pk2(float lo, float hi) { return f2bf(lo) | (f2bf(hi) << 16); }
__device__ __forceinline__ float sigmoidf_(float x) { return 1.f / (1.f + expf(-x)); }
__device__ __forceinline__ float siluf_(float x) { return x * sigmoidf_(x); }
__device__ __forceinline__ float fast_sigmoid(float x) { return __builtin_amdgcn_rcpf(1.f + __builtin_amdgcn_exp2f(-1.4426950408889634f * x)); }

namespace pg8 {
#define PG8_LAS __attribute__((address_space(3)))
typedef unsigned short bf16_t;
typedef short bf16x8 __attribute__((ext_vector_type(8)));
typedef float f32x4 __attribute__((ext_vector_type(4)));
typedef unsigned u32x4 __attribute__((ext_vector_type(4)));
constexpr int BM = 256, BK = 64, HALF = 128, HTB = HALF * BK * 2  , STAGE_BYTES = 8 * HTB, NXCD = 8, WGM = 8;

__host__ __device__ __forceinline__ int lds_byte(int r, int c) { const int st = (r >> 4) * 2 + (c >> 5), rr = r & 15, cc = c & 31, ob = rr * 64 + cc * 2; return st * 1024 + (ob ^ (((ob >> 9) & 1) << 5)); }
__host__ __device__ __forceinline__ void stage_rc(int b, int& R, int& C) { const int st = b / 1024, sb = b % 1024, swz = sb ^ (((sb >> 9) & 1) << 5); R = (st >> 1) * 16 + swz / 64; C = (st & 1) * 32 + (swz % 64) / 2; }
__host__ __device__ __forceinline__ int perm32(int rho) { const int n = rho >> 4, i = rho & 15; return 8 * (i >> 2) + 4 * n + (i & 3); }

struct Unit { int pm, pn; };
struct Gemm { const bf16_t* A; const bf16_t* Bt; int M, N, K; };

struct StaticOrder {
    int nM, nN, nwg, G, c;
    __host__ __device__ void init(int M, int N, int G_, int c_) { nM = M / BM; nN = N / BM; nwg = nM * nN; G = G_; c = c_; }
    __host__ __device__ bool next(int i, Unit& u) const {
        const long L = (long)i * G + c; if (L >= nwg) return false;
        int wgid = (int)L; { const int q = nwg / NXCD, r = nwg % NXCD, xcd = wgid % NXCD, off = wgid / NXCD; wgid = (xcd < r ? xcd * (q + 1) : r * (q + 1) + (xcd - r) * q) + off; }
        const int nig = WGM * nN, gid = wgid / nig, fm = gid * WGM, gsz = (nM - fm) < WGM ? (nM - fm) : WGM;
        u.pm = fm + ((wgid % nig) % gsz); u.pn = (wgid % nig) / gsz; return true;
    }
    __device__ __forceinline__ void a_ready(const Unit&) const {}
    __device__ __forceinline__ void done(const Unit&) const {}
};

__device__ __forceinline__ unsigned cvt_pk_bf16(float lo, float hi) { unsigned r; asm volatile("v_cvt_pk_bf16_f32 %0, %1, %2" : "=v"(r) : "v"(lo), "v"(hi)); return r; }
template <class Epi, class Sched, bool ALIGN_EPI = false, bool SP2 = false>
__device__ __forceinline__ void gemm_phase(PG8_LAS unsigned char* lds, const Gemm g, const Sched& S, const Epi& E) {
    const int tid = threadIdx.x, wid = __builtin_amdgcn_readfirstlane(tid >> 6), lane = tid & 63, wr = wid >> 2, wc = wid & 3, fr = lane & 15, fq = lane >> 4;
    const int K = g.K, nt = K / BK;
    unsigned voffA[2], voffB[2];
#pragma unroll
    for (int i = 0; i < 2; ++i) { int R, C; stage_rc(tid * 16 + i * 8192, R, C); const int Rb = Epi::PERM ? ((R & ~31) + perm32(R & 31)) : R;
        voffA[i] = (unsigned)(R * K + C) * 2u; voffB[i] = (unsigned)(Rb * K + C) * 2u; }
    const size_t kstep = (size_t)(BK * 2);
    const size_t hstep = (size_t)HALF * K * 2;
    const size_t tstep = 2 * hstep;
    const unsigned ldsw = (unsigned)wid * 1024u;
    const int aoff = lds_byte(wr * 64 + fr, fq * 8), boff = lds_byte(wc * 32 + fr, fq * 8);
#define PG8_SA(b, h) (((b) * 2 + (h)) * HTB)
#define PG8_SB(b, h) ((4 + (b) * 2 + (h)) * HTB)
#define PG8_STAGE(bufoff, gbase, voff) do { _Pragma("unroll") for (int _i = 0; _i < 2; ++_i) \
        __builtin_amdgcn_global_load_lds((const unsigned*)((const char*)(gbase) + (voff)[_i]), (PG8_LAS unsigned*)(lds + (bufoff) + ldsw + _i * 8192), 16, 0, 0); } while (0)
#define PG8_LDA(dst, b, h) do { _Pragma("unroll") for (int m = 0; m < 4; ++m) _Pragma("unroll") for (int k = 0; k < 2; ++k) dst[m][k] = *(const PG8_LAS bf16x8*)(lds + PG8_SA(b, h) + aoff + m * 2048 + k * 1024); } while (0)
#define PG8_LDB(dst, b, h) do { _Pragma("unroll") for (int n = 0; n < 2; ++n) _Pragma("unroll") for (int k = 0; k < 2; ++k) dst[n][k] = *(const PG8_LAS bf16x8*)(lds + PG8_SB(b, h) + boff + n * 2048 + k * 1024); } while (0)
#define PG8_MMA(ai, bj, At, Bt) do { __builtin_amdgcn_s_setprio(1); _Pragma("unroll") for (int m = 0; m < 4; ++m) _Pragma("unroll") for (int n = 0; n < 2; ++n) _Pragma("unroll") for (int k = 0; k < 2; ++k) \
        acc[ai][bj][m][n] = __builtin_amdgcn_mfma_f32_16x16x32_bf16(Bt[n][k], At[m][k], acc[ai][bj][m][n], 0, 0, 0); __builtin_amdgcn_s_setprio(0); } while (0)
#define PG8_WAIT_V(n) asm volatile("s_waitcnt vmcnt(" #n ")" ::: "memory")
#define PG8_WAIT_L(n) asm volatile("s_waitcnt lgkmcnt(" #n ")" ::: "memory")
#define PG8_BAR __builtin_amdgcn_s_barrier()
#define PG8_SCHED __builtin_amdgcn_sched_barrier(0)
    Unit cur, nxt; int ui = 0;
    if (!S.next(0, cur)) return;
    f32x4 acc[2][2][4][2];
#pragma unroll
    for (int a = 0; a < 2; ++a)
#pragma unroll
        for (int b = 0; b < 2; ++b)
#pragma unroll
            for (int m = 0; m < 4; ++m)
#pragma unroll
                for (int n = 0; n < 2; ++n) acc[a][b][m][n] = (f32x4){0.f, 0.f, 0.f, 0.f};
    bf16x8 At[4][2], B0[2][2], B1[2][2];
    const char* cA = (const char*)g.A + (size_t)cur.pm * tstep; const char* cB = (const char*)g.Bt + (size_t)cur.pn * tstep;
    S.a_ready(cur);
    if constexpr (SP2) {
        PG8_STAGE(PG8_SB(0, 0), cB, voffB); PG8_STAGE(PG8_SB(0, 1), cB + hstep, voffB); PG8_STAGE(PG8_SA(0, 0), cA, voffA); PG8_STAGE(PG8_SA(0, 1), cA + hstep, voffA);
        if (wr == 1) PG8_BAR;
        PG8_WAIT_V(2); PG8_BAR;
        PG8_STAGE(PG8_SB(1, 0), cB + kstep, voffB); PG8_STAGE(PG8_SA(1, 0), cA + kstep, voffA); PG8_STAGE(PG8_SB(1, 1), cB + hstep + kstep, voffB);
        PG8_WAIT_V(6); PG8_BAR;
    } else {
        PG8_STAGE(PG8_SB(0, 0), cB, voffB); PG8_STAGE(PG8_SA(0, 0), cA, voffA); PG8_STAGE(PG8_SB(0, 1), cB + hstep, voffB); PG8_STAGE(PG8_SA(0, 1), cA + hstep, voffA);
        if (wr == 1) PG8_BAR;
        PG8_WAIT_V(4); PG8_BAR;
        PG8_STAGE(PG8_SB(1, 0), cB + kstep, voffB); PG8_STAGE(PG8_SA(1, 0), cA + kstep, voffA); PG8_STAGE(PG8_SB(1, 1), cB + hstep + kstep, voffB);
        PG8_WAIT_V(6); PG8_BAR;
    }
    for (;;) {
        const bool has_next = S.next(ui + 1, nxt);
        const char* nA = has_next ? (const char*)g.A + (size_t)nxt.pm * tstep : cA; const char* nB = has_next ? (const char*)g.Bt + (size_t)nxt.pn * tstep : cB;
        for (int t = 0; t < nt; t += 2) {
            const bool last = (t == nt - 2);
            const char* a1 = cA + (size_t)(t + 1) * kstep;
            const char* a2 = last ? nA : cA + (size_t)(t + 2) * kstep; const char* b2 = last ? nB : cB + (size_t)(t + 2) * kstep;
            const char* a3 = a2 + kstep; const char* b3 = b2 + kstep;
            if (last && has_next) S.a_ready(nxt);
            if constexpr (SP2) {
            PG8_LDB(B0, 0, 0); PG8_LDB(B1, 0, 1); PG8_SCHED; PG8_LDA(At, 0, 0); PG8_STAGE(PG8_SA(1, 1), a1 + hstep, voffA);
            PG8_WAIT_V(8); PG8_WAIT_L(0); PG8_BAR; PG8_MMA(0, 0, At, B0); PG8_MMA(0, 1, At, B1); PG8_BAR; PG8_SCHED;
            PG8_LDA(At, 0, 1); PG8_STAGE(PG8_SB(0, 0), b2, voffB); PG8_STAGE(PG8_SB(0, 1), b2 + hstep, voffB); PG8_STAGE(PG8_SA(0, 0), a2, voffA);
            PG8_WAIT_V(8); PG8_WAIT_L(0); PG8_BAR; PG8_MMA(1, 0, At, B0); PG8_MMA(1, 1, At, B1); PG8_BAR; PG8_SCHED;
            PG8_LDB(B0, 1, 0); PG8_LDB(B1, 1, 1); PG8_SCHED; PG8_LDA(At, 1, 0); PG8_STAGE(PG8_SA(0, 1), a2 + hstep, voffA);
            PG8_WAIT_V(8); PG8_WAIT_L(0); PG8_BAR; PG8_MMA(0, 0, At, B0); PG8_MMA(0, 1, At, B1); PG8_BAR; PG8_SCHED;
            PG8_LDA(At, 1, 1); PG8_STAGE(PG8_SB(1, 0), b3, voffB); PG8_STAGE(PG8_SB(1, 1), b3 + hstep, voffB); PG8_STAGE(PG8_SA(1, 0), a3, voffA);
            PG8_WAIT_V(8); PG8_WAIT_L(0); PG8_BAR; PG8_MMA(1, 0, At, B0); PG8_MMA(1, 1, At, B1); PG8_BAR; PG8_SCHED;
            } else {
            PG8_LDB(B0, 0, 0); PG8_SCHED; PG8_LDA(At, 0, 0); PG8_STAGE(PG8_SA(1, 1), a1 + hstep, voffA);
            PG8_WAIT_L(8); PG8_BAR; PG8_WAIT_L(0); PG8_MMA(0, 0, At, B0); PG8_BAR; PG8_SCHED;
            PG8_LDB(B1, 0, 1); PG8_STAGE(PG8_SB(0, 0), b2, voffB);
            PG8_BAR; PG8_WAIT_L(0); PG8_MMA(0, 1, At, B1); PG8_BAR;
            PG8_LDA(At, 0, 1); PG8_STAGE(PG8_SA(0, 0), a2, voffA);
            PG8_BAR; PG8_WAIT_L(0); PG8_MMA(1, 0, At, B0); PG8_BAR; PG8_SCHED;
            PG8_STAGE(PG8_SB(0, 1), b2 + hstep, voffB);
            PG8_WAIT_V(6); PG8_BAR; PG8_MMA(1, 1, At, B1); PG8_BAR;
            PG8_LDB(B0, 1, 0); PG8_SCHED; PG8_LDA(At, 1, 0); PG8_STAGE(PG8_SA(0, 1), a2 + hstep, voffA);
            PG8_WAIT_L(8); PG8_BAR; PG8_WAIT_L(0); PG8_MMA(0, 0, At, B0); PG8_BAR; PG8_SCHED;
            PG8_LDB(B1, 1, 1); PG8_STAGE(PG8_SB(1, 0), b3, voffB);
            PG8_BAR; PG8_WAIT_L(0); PG8_MMA(0, 1, At, B1); PG8_BAR;
            PG8_LDA(At, 1, 1); PG8_STAGE(PG8_SA(1, 0), a3, voffA);
            PG8_BAR; PG8_WAIT_L(0); PG8_MMA(1, 0, At, B0); PG8_BAR; PG8_SCHED;
            PG8_STAGE(PG8_SB(1, 1), b3 + hstep, voffB);
            PG8_WAIT_V(6); PG8_BAR; PG8_MMA(1, 1, At, B1); PG8_BAR;
            }
        }
        if constexpr (ALIGN_EPI) { if (wr == 0) PG8_BAR; }
        if constexpr (!Epi::AFTER_DRAIN) { E(acc, cur, wr, wc, fr, fq); S.done(cur); }
        if (!has_next) break;
#pragma unroll
        for (int a = 0; a < 2; ++a)
#pragma unroll
            for (int b = 0; b < 2; ++b)
#pragma unroll
                for (int m = 0; m < 4; ++m)
#pragma unroll
                    for (int n = 0; n < 2; ++n) acc[a][b][m][n] = (f32x4){0.f, 0.f, 0.f, 0.f};
        cur = nxt; cA = nA; cB = nB; ++ui;
        if constexpr (ALIGN_EPI) { if (wr == 1) PG8_BAR; }
    }
    PG8_WAIT_V(0);
    if constexpr (!ALIGN_EPI) { if (wr == 0) PG8_BAR; }
    PG8_BAR;
    if constexpr (Epi::AFTER_DRAIN) { E.fused(acc, cur, wr, wc, fr, fq, lds, wid, lane); S.done(cur); }
#undef PG8_SA
#undef PG8_SB
#undef PG8_STAGE
#undef PG8_LDA
#undef PG8_LDB
#undef PG8_MMA
#undef PG8_WAIT_V
#undef PG8_WAIT_L
#undef PG8_BAR
#undef PG8_SCHED
}
}

namespace pg8 {
typedef unsigned u32x2 __attribute__((ext_vector_type(2)));
__device__ __forceinline__ float row_rstd(const float* rs, int row) {
    const f32x4* p = (const f32x4*)(rs + (size_t)row * 16);
    const f32x4 a = p[0], b = p[1], c = p[2], d = p[3];
    const float s = ((a[0] + a[1]) + (a[2] + a[3])) + ((b[0] + b[1]) + (b[2] + b[3])) + ((c[0] + c[1]) + (c[2] + c[3])) + ((d[0] + d[1]) + (d[2] + d[3]));
    return rsqrtf(s * (1.0f / 1024.0f) + 1e-6f);
}
struct EpiProj {
    static constexpr bool PERM = true, AFTER_DRAIN = false;
    bf16_t* O; int ldc; const float* rs; int ncols_store;
    __device__ __forceinline__ void operator()(const f32x4 (&acc)[2][2][4][2], const Unit& u, int wr, int wc, int fr, int fq) const {
        const int row0 = u.pm * BM + wr * 64 + fr, col0 = u.pn * BM + wc * 32 + 8 * fq;
#pragma unroll
        for (int ai = 0; ai < 2; ++ai)
#pragma unroll
            for (int m = 0; m < 4; ++m) {
                const int row = row0 + ai * HALF + m * 16;
                const float sc = rs ? row_rstd(rs, row) : 1.0f;
                bf16_t* rowp = O + (size_t)row * ldc + col0;
#pragma unroll
                for (int bj = 0; bj < 2; ++bj) {
                    if (col0 + bj * HALF < ncols_store) {
                        const f32x4 v0 = acc[ai][bj][m][0] * sc, v1 = acc[ai][bj][m][1] * sc;
                        u32x4 w; w.x = cvt_pk_bf16(v0[0], v0[1]); w.y = cvt_pk_bf16(v0[2], v0[3]); w.z = cvt_pk_bf16(v1[0], v1[1]); w.w = cvt_pk_bf16(v1[2], v1[3]);
                        *(u32x4*)(rowp + bj * HALF) = w;
                    }
                }
            }
    }
};
struct EpiHnew {
    static constexpr bool PERM = false, AFTER_DRAIN = false;
    float* H; bf16_t* HN; float* RS;
    __device__ __forceinline__ void operator()(const f32x4 (&acc)[2][2][4][2], const Unit& u, int wr, int wc, int fr, int fq) const {
        const int row0 = u.pm * BM + wr * 64 + fr, col0 = u.pn * BM + wc * 32 + 4 * fq;
#pragma unroll
        for (int ai = 0; ai < 2; ++ai)
#pragma unroll
            for (int m = 0; m < 4; ++m) {
                const int row = row0 + ai * HALF + m * 16;
                const size_t off = (size_t)row * 1024 + col0;
                float ss = 0.f;
#pragma unroll
                for (int bj = 0; bj < 2; ++bj)
#pragma unroll
                    for (int n = 0; n < 2; ++n) {
                        const f32x4 h4 = *(const f32x4*)(H + off + bj * HALF + n * 16);
                        const f32x4 v = h4 + acc[ai][bj][m][n];
                        *(f32x4*)(H + off + bj * HALF + n * 16) = v;
                        u32x2 w; w.x = cvt_pk_bf16(v[0], v[1]); w.y = cvt_pk_bf16(v[2], v[3]);
                        *(u32x2*)(HN + off + bj * HALF + n * 16) = w;
                        ss += (v[0] * v[0] + v[1] * v[1]) + (v[2] * v[2] + v[3] * v[3]);
                    }
                ss += __shfl_xor(ss, 16); ss += __shfl_xor(ss, 32);
                if (fq == 0) RS[(size_t)row * 16 + u.pn * 4 + wc] = ss;
            }
    }
};
struct EpiPle {
    static constexpr bool PERM = false, AFTER_DRAIN = false;
    float* H; bf16_t* HB; const float* RSi; float* RSo; const bf16_t* PPb;
    __device__ __forceinline__ void operator()(const f32x4 (&acc)[2][2][4][2], const Unit& u, int wr, int wc, int fr, int fq) const {
        const int row0 = u.pm * BM + wr * 64 + fr, col0 = u.pn * BM + wc * 32 + 4 * fq;
#pragma unroll
        for (int ai = 0; ai < 2; ++ai)
#pragma unroll
            for (int m = 0; m < 4; ++m) {
                const int row = row0 + ai * HALF + m * 16;
                const size_t off = (size_t)row * 1024 + col0;
                const float sc = row_rstd(RSi, row);
                float ss = 0.f;
#pragma unroll
                for (int bj = 0; bj < 2; ++bj)
#pragma unroll
                    for (int n = 0; n < 2; ++n) {
                        const f32x4 h4 = *(const f32x4*)(H + off + bj * HALF + n * 16);
                        const u32x2 pw = *(const u32x2*)(PPb + off + bj * HALF + n * 16);
                        const f32x4 a = acc[ai][bj][m][n] * sc;
                        f32x4 v;
                        v[0] = h4[0] + fast_sigmoid(a[0]) * __uint_as_float(pw.x << 16);
                        v[1] = h4[1] + fast_sigmoid(a[1]) * __uint_as_float(pw.x & 0xffff0000u);
                        v[2] = h4[2] + fast_sigmoid(a[2]) * __uint_as_float(pw.y << 16);
                        v[3] = h4[3] + fast_sigmoid(a[3]) * __uint_as_float(pw.y & 0xffff0000u);
                        *(f32x4*)(H + off + bj * HALF + n * 16) = v;
                        if (HB) { u32x2 w; w.x = cvt_pk_bf16(v[0], v[1]); w.y = cvt_pk_bf16(v[2], v[3]); *(u32x2*)(HB + off + bj * HALF + n * 16) = w; }
                        ss += (v[0] * v[0] + v[1] * v[1]) + (v[2] * v[2] + v[3] * v[3]);
                    }
                if (RSo) {
                    ss += __shfl_xor(ss, 16); ss += __shfl_xor(ss, 32);
                    if (fq == 0) RSo[(size_t)row * 16 + u.pn * 4 + wc] = ss;
                }
            }
    }
};
}

constexpr int GEMM_LDS = 147456;
struct GemmArgs { const bf16* A; const bf16* Bt; int M, N, K, mode; bf16* O16; float* H; const float* RSi; float* RSo; const bf16* PPb; };

__global__ void __launch_bounds__(512, 2) k_gemm_phase(GemmArgs a) {
    extern __shared__ __attribute__((aligned(16))) unsigned char lds[];
    pg8::Gemm g{a.A, a.Bt, a.M, a.N, a.K};
    pg8::StaticOrder S; S.init(a.M, a.N, gridDim.x, blockIdx.x);
    LAS unsigned char* l = (LAS unsigned char*)lds;
    if (a.mode == 0) { pg8::EpiProj E{a.O16, PP, a.RSi, PP}; pg8::gemm_phase<pg8::EpiProj, pg8::StaticOrder, true, true>(l, g, S, E); }
    else if (a.mode == 1) { pg8::EpiProj E{a.O16, 1024, nullptr, 1024}; pg8::gemm_phase<pg8::EpiProj, pg8::StaticOrder, true, true>(l, g, S, E); }
    else if (a.mode == 2) { pg8::EpiHnew E{a.H, a.O16, a.RSo}; pg8::gemm_phase<pg8::EpiHnew, pg8::StaticOrder, true, true>(l, g, S, E); }
    else { pg8::EpiPle E{a.H, a.O16, a.RSi, a.RSo, a.PPb}; pg8::gemm_phase<pg8::EpiPle, pg8::StaticOrder, true, true>(l, g, S, E); }
}

__device__ __forceinline__ int map_col(int n, int remap) { return (remap && n >= SRC_NGATE_END) ? n + 104 : n; }
__global__ void __launch_bounds__(256) k_transpose_w(const float* __restrict__ W, int K, int N, bf16* __restrict__ WT, const float* __restrict__ gk, int remap) {
    __shared__ float scr_all[4][64 * 33];
    const int lane = threadIdx.x & 63, wave = threadIdx.x >> 6;
    float* scr = scr_all[wave];
    const int nblk = (N + 31) / 32, nitems = (K / 64) * nblk;
    for (int item = blockIdx.x * 4 + wave; item < nitems; item += gridDim.x * 4) {
        const int kb = item / nblk, nb = item % nblk, k0 = 64 * kb, n0 = 32 * nb;
        for (int i = 0; i < 32; ++i) {
            const int kk = 2 * i + (lane >> 5), n = n0 + (lane & 31);
            float v = (n < N) ? W[(size_t)(k0 + kk) * N + n] : 0.f;
            if (gk) v *= gk[k0 + kk];
            scr[kk * 33 + (lane & 31)] = v;
        }
        asm volatile("s_waitcnt lgkmcnt(0)" ::: "memory");
        const int c = lane & 7;
        for (int j = 0; j < 4; ++j) {
            const int nl = (lane >> 3) + 8 * j, n = n0 + nl;
            if (n < N) {
                const float* s = scr + (8 * c) * 33 + nl;
                uint4 o; o.x = pk2(s[0 * 33], s[1 * 33]); o.y = pk2(s[2 * 33], s[3 * 33]); o.z = pk2(s[4 * 33], s[5 * 33]); o.w = pk2(s[6 * 33], s[7 * 33]);
                *(uint4*)(WT + (size_t)map_col(n, remap) * K + k0 + 8 * c) = o;
            }
        }
        asm volatile("s_waitcnt lgkmcnt(0)" ::: "memory");
    }
}
__global__ void __launch_bounds__(256) k_prep_x(const float* __restrict__ x, float* __restrict__ h, bf16* __restrict__ HB, float* __restrict__ RS) {
    const int lane = threadIdx.x & 63, row = blockIdx.x * 4 + (threadIdx.x >> 6);
    const float4* xr = (const float4*)(x + (size_t)row * D_MODEL) + lane;
    float4* hr = (float4*)(h + (size_t)row * D_MODEL) + lane;
    uint2* br = (uint2*)(HB + (size_t)row * D_MODEL) + lane;
    float ss = 0.f;
#pragma unroll
    for (int j = 0; j < 4; ++j) {
        const float4 v = xr[64 * j];
        hr[64 * j] = v;
        uint2 w; w.x = pk2(v.x, v.y); w.y = pk2(v.z, v.w); br[64 * j] = w;
        ss += (v.x * v.x + v.y * v.y) + (v.z * v.z + v.w * v.w);
    }
    for (int o = 32; o > 0; o >>= 1) ss += __shfl_xor(ss, o);
    if (lane < 16) RS[(size_t)row * 16 + lane] = (lane == 0) ? ss : 0.f;
}
__global__ void k_f32_to_bf16(const float* __restrict__ src, bf16* __restrict__ dst, int n4) {
    int i = blockIdx.x * blockDim.x + threadIdx.x;
    if (i >= n4) return;
    const float4 v = ((const float4*)src)[i];
    uint2 w; w.x = pk2(v.x, v.y); w.y = pk2(v.z, v.w);
    ((uint2*)dst)[i] = w;
}
__global__ void k_tables(const float* __restrict__ hgrn_lb, float* __restrict__ lb_all, float* __restrict__ ropec, float* __restrict__ ropes) {
    int i = blockIdx.x * blockDim.x + threadIdx.x;
    if (i < HG_W) {
        float v0 = hgrn_lb[i], v1 = hgrn_lb[HG_W + i], v2 = hgrn_lb[2 * HG_W + i], v3 = hgrn_lb[3 * HG_W + i];
        float m = fmaxf(fmaxf(v0, v1), fmaxf(v2, v3));
        v0 = expf(v0 - m); v1 = expf(v1 - m); v2 = expf(v2 - m); v3 = expf(v3 - m);
        float s = v0 + v1 + v2 + v3;
        lb_all[i] = 0.f; lb_all[HG_W + i] = v1 / s; lb_all[2 * HG_W + i] = v1 / s + v2 / s; lb_all[3 * HG_W + i] = v1 / s + v2 / s + v3 / s;
    }
    if (i < SEQ * 8) {
        int t = i >> 3, j = i & 7;
        double inv = pow(500000.0, -(double)(2 * j) / 16.0);
        double ang = (double)t * inv;
        ropec[i] = (float)cos(ang);
        ropes[i] = (float)sin(ang);
    }
}
__global__ void __launch_bounds__(256) k_nsa_prep(bf16* __restrict__ P, bf16* __restrict__ QRb, const float* __restrict__ qg, const float* __restrict__ kg,
                                                 const float* __restrict__ ropec, const float* __restrict__ ropes) {
    int i = blockIdx.x * blockDim.x + threadIdx.x;
    if (i >= MROWS * 12) return;
    const int row = i / 12, u = i % 12, t = row % SEQ;
    bf16* src; const float* g;
    if (u < 8) { src = P + (size_t)row * PP + C_NQ + u * DH; g = qg; }
    else if (u < 10) { src = P + (size_t)row * PP + C_KSL + (u - 8) * DH; g = kg + 1 * DH; }
    else { src = P + (size_t)row * PP + C_KWN + (u - 10) * DH; g = kg + 2 * DH; }
    uint4 raw[8];
    float ss = 0.f;
#pragma unroll
    for (int c = 0; c < 8; ++c) {
        raw[c] = ((const uint4*)src)[c];
        const unsigned w[4] = {raw[c].x, raw[c].y, raw[c].z, raw[c].w};
#pragma unroll
        for (int k = 0; k < 4; ++k) { const float a = __uint_as_float(w[k] << 16), b = __uint_as_float(w[k] & 0xffff0000u); ss += a * a + b * b; }
    }
    const float r = rsqrtf(ss * (1.0f / DH) + RMS_EPS);
    float v01[16];
#pragma unroll
    for (int c = 0; c < 8; ++c) {
        const unsigned w[4] = {raw[c].x, raw[c].y, raw[c].z, raw[c].w};
        float v[8];
#pragma unroll
        for (int k = 0; k < 4; ++k) { v[2 * k] = __uint_as_float(w[k] << 16) * r * g[c * 8 + 2 * k]; v[2 * k + 1] = __uint_as_float(w[k] & 0xffff0000u) * r * g[c * 8 + 2 * k + 1]; }
        uint4 o; o.x = pk2(v[0], v[1]); o.y = pk2(v[2], v[3]); o.z = pk2(v[4], v[5]); o.w = pk2(v[6], v[7]);
        if (c < 2) {
#pragma unroll
            for (int k = 0; k < 8; ++k) v01[c * 8 + k] = v[k];
            if (u < 8) ((uint4*)src)[c] = o;
        } else {
            ((uint4*)src)[c] = o;
            if (u < 8) ((uint4*)(QRb + (size_t)row * NSA_W + u * DH))[c] = o;
        }
    }
    float ro[16];
#pragma unroll
    for (int j = 0; j < 8; ++j) {
        const float cs = ropec[t * 8 + j], sn = ropes[t * 8 + j];
        ro[j] = v01[j] * cs - v01[j + 8] * sn;
        ro[j + 8] = v01[j] * sn + v01[j + 8] * cs;
    }
    uint4 o0, o1;
    o0.x = pk2(ro[0], ro[1]); o0.y = pk2(ro[2], ro[3]); o0.z = pk2(ro[4], ro[5]); o0.w = pk2(ro[6], ro[7]);
    o1.x = pk2(ro[8], ro[9]); o1.y = pk2(ro[10], ro[11]); o1.z = pk2(ro[12], ro[13]); o1.w = pk2(ro[14], ro[15]);
    uint4* dst = (u < 8) ? (uint4*)(QRb + (size_t)row * NSA_W + u * DH) : (uint4*)src;
    dst[0] = o0; dst[1] = o1;
}

__global__ void __launch_bounds__(64) k_hgrn_scan(const bf16* __restrict__ Pb, const float* __restrict__ lb_l, float* __restrict__ o_raw) {
    int hv = blockIdx.x, hd = hv >> 7, lane = threadIdx.x;
    int c0 = hd * HG_DK + lane, c1 = c0 + 64;
    float lb0 = lb_l[c0], lb1 = lb_l[c1];
    float S0 = 0.f, S1 = 0.f;
    for (int t = 0; t < SEQ; ++t) {
        const bf16* pr = Pb + (size_t)t * PP;
        float fl0 = bf2f(pr[C_HF + c0]), fl1 = bf2f(pr[C_HF + c1]);
        float q0 = bf2f(pr[C_HQ + c0]), q1 = bf2f(pr[C_HQ + c1]);
        float v = bf2f(pr[C_HI + hv]);
        float f0 = lb0 + (1.f - lb0) * sigmoidf_(fl0), f1 = lb1 + (1.f - lb1) * sigmoidf_(fl1);
        float k0 = (1.f - lb0) * sigmoidf_(-fl0), k1 = (1.f - lb1) * sigmoidf_(-fl1);
        S0 = f0 * S0 + k0 * v;
        S1 = f1 * S1 + k1 * v;
        float part = q0 * S0 + q1 * S1;
        for (int o = 32; o > 0; o >>= 1) part += __shfl_xor(part, o);
        if (lane == 0) o_raw[(size_t)t * HG_W + hv] = part;
    }
}
__global__ void __launch_bounds__(512) k_hgrn_out(const float* __restrict__ o_raw, const bf16* __restrict__ Pb, const float* __restrict__ onorm_g, bf16* __restrict__ Yb) {
    __shared__ float red[8];
    int t = blockIdx.x, c = threadIdx.x;
    float v = o_raw[(size_t)t * HG_W + c];
    float ss = v * v;
    for (int o = 32; o > 0; o >>= 1) ss += __shfl_xor(ss, o);
    if ((c & 63) == 0) red[c >> 6] = ss;
    __syncthreads();
    int hd = c >> 7;
    float tot = red[hd * 2] + red[hd * 2 + 1];
    float r = rsqrtf(tot / (float)HG_DV + RMS_EPS);
    const bf16* pr = Pb + (size_t)t * PP;
    float o = v * r * onorm_g[c & 127];
    Yb[(size_t)t * D_MODEL + c] = (bf16)f2bf(o * sigmoidf_(bf2f(pr[C_HGO + c])) * siluf_(bf2f(pr[C_HZ + c])));
}
__global__ void k_cmp_hidden(const bf16* __restrict__ Pb, const float* __restrict__ pe, const float* __restrict__ w1, float* __restrict__ hid) {
    int i = blockIdx.x * blockDim.x + threadIdx.x;
    if (i >= 2 * KVH * NC * CMP_HIDDEN) return;
    int n = i % CMP_HIDDEN, c = (i / CMP_HIDDEN) % NC, g = (i / (CMP_HIDDEN * NC)) % KVH, kv = i / (CMP_HIDDEN * NC * KVH);
    int col = (kv == 0 ? C_KCM : C_VCM) + g * DH;
    const float* pek = pe + (size_t)kv * CMP_BLOCK * DH;
    const float* w = w1 + (size_t)kv * CMP_BLOCK * DH * CMP_HIDDEN;
    float acc = 0.f;
    for (int l = 0; l < CMP_BLOCK; ++l) {
        const bf16* pr = Pb + (size_t)(c * CMP_STRIDE + l) * PP + col;
        for (int j = 0; j < DH; ++j) acc = fmaf(bf2f(pr[j]) + pek[l * DH + j], w[(size_t)(l * DH + j) * CMP_HIDDEN + n], acc);
    }
    hid[i] = siluf_(acc);
}
__global__ void k_cmp_out(const float* __restrict__ hid, const float* __restrict__ w2, const float* __restrict__ kg0, float* __restrict__ kvc) {
    int i = blockIdx.x * blockDim.x + threadIdx.x;
    if (i >= 2 * KVH * NC) return;
    int kv = i / (KVH * NC);
    const float* hrow = hid + (size_t)i * CMP_HIDDEN;
    const float* w = w2 + (size_t)kv * CMP_HIDDEN * DH;
    float out[DH];
#pragma unroll
    for (int j = 0; j < DH; ++j) out[j] = 0.f;
    for (int n = 0; n < CMP_HIDDEN; ++n) {
        float hv = hrow[n];
#pragma unroll
        for (int j = 0; j < DH; ++j) out[j] = fmaf(hv, w[n * DH + j], out[j]);
    }
    float r = 1.f;
    if (kv == 0) {
        float ss = 0.f;
#pragma unroll
        for (int j = 0; j < DH; ++j) ss += out[j] * out[j];
        r = rsqrtf(ss / (float)DH + RMS_EPS);
    }
#pragma unroll
    for (int j = 0; j < DH; ++j) kvc[(size_t)i * DH + j] = (kv == 0) ? out[j] * r * kg0[j] : out[j];
}
__global__ void __launch_bounds__(64) k_cmp_attn_topk(const bf16* __restrict__ Pb, const float* __restrict__ kvc, float* __restrict__ scorebuf,
                                                      unsigned long long* __restrict__ selmask, float* __restrict__ Yn) {
    int i = blockIdx.x * blockDim.x + threadIdx.x;
    int t = i % SEQ, g = i / SEQ;
    const float* kc = kvc + (size_t)(0 * KVH + g) * NC * DH;
    const float* vc = kvc + (size_t)(1 * KVH + g) * NC * DH;
    int nv = (t >= CMP_BLOCK - 1) ? ((t - (CMP_BLOCK - 1)) / CMP_STRIDE + 1) : 0;
    if (nv > NC) nv = NC;
    float* sc = scorebuf + (size_t)i * NSB;
    for (int j = 0; j < NSB; ++j) sc[j] = 0.f;
    const bf16* pr = Pb + (size_t)t * PP;
    for (int n = 0; n < GRP; ++n) {
        const int hd = g * GRP + n;
        float q[DH];
#pragma unroll
        for (int j = 0; j < DH; ++j) q[j] = bf2f(pr[C_NQ + hd * DH + j]);
        float m = -INFINITY;
        for (int c = 0; c < nv; ++c) {
            float s = 0.f;
#pragma unroll
            for (int j = 0; j < DH; ++j) s = fmaf(q[j], kc[c * DH + j], s);
            m = fmaxf(m, s * 0.125f);
        }
        float sum = 0.f;
        for (int c = 0; c < nv; ++c) {
            float s = 0.f;
#pragma unroll
            for (int j = 0; j < DH; ++j) s = fmaf(q[j], kc[c * DH + j], s);
            sum += expf(s * 0.125f - m);
        }
        const float inv = 1.f / fmaxf(sum, 1e-30f);
        float acc[DH];
#pragma unroll
        for (int j = 0; j < DH; ++j) acc[j] = 0.f;
        for (int c = 0; c < nv; ++c) {
            float s = 0.f;
#pragma unroll
            for (int j = 0; j < DH; ++j) s = fmaf(q[j], kc[c * DH + j], s);
            const float p = expf(s * 0.125f - m) * inv;
#pragma unroll
            for (int j = 0; j < DH; ++j) acc[j] = fmaf(p, vc[c * DH + j], acc[j]);
            const int j0 = (16 * c) >> 6, j1 = (16 * c + 31) >> 6;
            if (j0 == j1) sc[j0] += p; else { sc[j0] += 0.5f * p; sc[j1] += 0.5f * p; }
        }
        const float g0 = sigmoidf_(bf2f(pr[C_NGATE + 0 * NSA_HEADS + hd]));
#pragma unroll
        for (int j = 0; j < DH; ++j) Yn[(size_t)t * NSA_W + hd * DH + j] = g0 * acc[j];
    }
    const int cur = t / SLC_BLOCK;
    for (int j = 0; j < NSB; ++j) {
        const bool forced = (j == 0) || (j == cur) || (j == cur - 1);
        const bool elig = (j <= cur);
        const float v = sc[j];
        sc[j] = forced ? 1e4f : (elig ? v : -1.0f);
    }
    unsigned long long mask = 0ull;
    for (int k = 0; k < SLC_TOPK; ++k) {
        float best = -INFINITY; int bj = 0;
        for (int j = 0; j < NSB; ++j) { float s = sc[j]; if (s > best) { best = s; bj = j; } }
        mask |= (1ull << bj);
        sc[bj] = -INFINITY;
    }
    selmask[i] = mask;
}
__global__ void __launch_bounds__(64) k_slc_attn(const bf16* __restrict__ QRb, const bf16* __restrict__ Pb, const unsigned long long* __restrict__ selmask,
                                                 float* __restrict__ Yn) {
    int i = blockIdx.x * blockDim.x + threadIdx.x;
    int t = i % SEQ, hd = i / SEQ, g = hd / GRP;
    float q[DH], acc[DH];
#pragma unroll
    for (int j = 0; j < DH; ++j) { q[j] = bf2f(QRb[(size_t)t * NSA_W + hd * DH + j]); acc[j] = 0.f; }
    unsigned long long mask = selmask[(size_t)g * SEQ + t];
    float m = -INFINITY, l = 0.f;
    for (int jb = 0; jb < NSB; ++jb) {
        if (!((mask >> jb) & 1ull)) continue;
        int k0 = jb * SLC_BLOCK;
        for (int kk = k0; kk < k0 + SLC_BLOCK && kk <= t; ++kk) {
            const bf16* kr = Pb + (size_t)kk * PP + C_KSL + g * DH;
            const bf16* vr = Pb + (size_t)kk * PP + C_VSL + g * DH;
            float s = 0.f;
#pragma unroll
            for (int j = 0; j < DH; ++j) s = fmaf(q[j], bf2f(kr[j]), s);
            s *= 0.125f;
            float mn = fmaxf(m, s);
            float a = expf(m - mn), p = expf(s - mn);
            l = l * a + p;
#pragma unroll
            for (int j = 0; j < DH; ++j) acc[j] = fmaf(p, bf2f(vr[j]), acc[j] * a);
            m = mn;
        }
    }
    float inv = 1.f / fmaxf(l, 1e-30f);
    const float g1 = sigmoidf_(bf2f(Pb[(size_t)t * PP + C_NGATE + 1 * NSA_HEADS + hd]));
#pragma unroll
    for (int j = 0; j < DH; ++j) Yn[(size_t)t * NSA_W + hd * DH + j] += g1 * acc[j] * inv;
}
__global__ void __launch_bounds__(64) k_win_attn(const bf16* __restrict__ QRb, const bf16* __restrict__ Pb, const float* __restrict__ Yn, bf16* __restrict__ Yb) {
    int i = blockIdx.x * blockDim.x + threadIdx.x;
    int t = i % SEQ, hd = i / SEQ, g = hd / GRP;
    float q[DH], acc[DH];
#pragma unroll
    for (int j = 0; j < DH; ++j) { q[j] = bf2f(QRb[(size_t)t * NSA_W + hd * DH + j]); acc[j] = 0.f; }
    float m = -INFINITY, l = 0.f;
    int kstart = t - (WINDOW - 1);
    if (kstart < 0) kstart = 0;
    for (int kk = kstart; kk <= t; ++kk) {
        const bf16* kr = Pb + (size_t)kk * PP + C_KWN + g * DH;
        const bf16* vr = Pb + (size_t)kk * PP + C_VWN + g * DH;
        float s = 0.f;
#pragma unroll
        for (int j = 0; j < DH; ++j) s = fmaf(q[j], bf2f(kr[j]), s);
        s *= 0.125f;
        float mn = fmaxf(m, s);
        float a = expf(m - mn), p = expf(s - mn);
        l = l * a + p;
#pragma unroll
        for (int j = 0; j < DH; ++j) acc[j] = fmaf(p, bf2f(vr[j]), acc[j] * a);
        m = mn;
    }
    float inv = 1.f / fmaxf(l, 1e-30f);
    const bf16* pr = Pb + (size_t)t * PP;
    const float g2 = sigmoidf_(bf2f(pr[C_NGATE + 2 * NSA_HEADS + hd]));
#pragma unroll
    for (int j = 0; j < DH; ++j) {
        const int c = hd * DH + j;
        const float o = Yn[(size_t)t * NSA_W + c] + g2 * acc[j] * inv;
        Yb[(size_t)t * D_MODEL + HG_W + c] = (bf16)f2bf(o * siluf_(bf2f(pr[C_NZ + c])));
    }
}

extern "C" void kernel_launch(void* const* d_in, const int* in_sizes, int n_in, void* d_out, int out_size, void* d_ws, size_t ws_size, hipStream_t stream) {
    const float* x = (const float*)d_in[0];
    const float* p = (const float*)d_in[1];
    const float* norm_g = (const float*)d_in[2];
    const float* w_in = (const float*)d_in[3];
    const float* hgrn_lb = (const float*)d_in[4];
    const float* hgrn_onorm_g = (const float*)d_in[5];
    const float* nsa_qnorm_g = (const float*)d_in[6];
    const float* nsa_knorm_g = (const float*)d_in[7];
    const float* cmp_pe = (const float*)d_in[8];
    const float* cmp_w1 = (const float*)d_in[9];
    const float* cmp_w2 = (const float*)d_in[10];
    const float* w_out = (const float*)d_in[11];
    const float* ple_norm_g = (const float*)d_in[12];
    const float* w_pg = (const float*)d_in[13];
    const float* w_pp = (const float*)d_in[14];
    float* h = (float*)d_out;
    unsigned char* ws = (unsigned char*)d_ws;
    constexpr size_t MiB = 1u << 20;
    bf16* WIN_T = (bf16*)(ws + 1 * MiB);
    bf16* WOUT_T = (bf16*)(ws + 10 * MiB);
    bf16* WPG_T = (bf16*)(ws + 12 * MiB);
    bf16* WPP_T = (bf16*)(ws + 14 * MiB);
    float* lb_all = (float*)(ws + 16 * MiB);
    float* ropec = lb_all + DEPTH * HG_W;
    float* ropes = ropec + SEQ * 8;
    float* RSA = (float*)(ws + 17 * MiB);
    float* RSB = (float*)(ws + 18 * MiB);
    bf16* BUF[2] = {(bf16*)(ws + 20 * MiB), (bf16*)(ws + 52 * MiB)};
    bf16* PB = (bf16*)(ws + 84 * MiB);
    bf16* QRb = (bf16*)(ws + 92 * MiB);
    bf16* P = (bf16*)(ws + 108 * MiB);
    bf16* PPb = P;
    float* misc = (float*)(ws + 248 * MiB);
    size_t off = 0;
    auto take = [&](size_t n) { float* r = misc + off; off += (n + 63) & ~(size_t)63; return r; };
    float* o_raw = take((size_t)SEQ * HG_W);
    float* Yn = take((size_t)SEQ * NSA_W);
    float* hid = take((size_t)2 * KVH * NC * CMP_HIDDEN);
    float* kvc = take((size_t)2 * KVH * NC * DH);
    float* scorebuf = take((size_t)KVH * SEQ * NSB);
    unsigned long long* selmask = (unsigned long long*)take((size_t)KVH * SEQ * 2);
    if (248 * MiB + off * 4 > ws_size) { fprintf(stderr, "workspace too small: need %zu have %zu\n", 248 * MiB + off * 4, ws_size); return; }

    static bool attr_set = false;
    if (!attr_set) { (void)hipFuncSetAttribute((const void*)k_gemm_phase, hipFuncAttributeMaxDynamicSharedMemorySize, GEMM_LDS); attr_set = true; }

    k_prep_x<<<MROWS / 4, 256, 0, stream>>>(x, h, BUF[0], RSB);
    k_tables<<<(SEQ * 8 + 255) / 256, 256, 0, stream>>>(hgrn_lb, lb_all, ropec, ropes);
    (void)hipMemsetAsync(WIN_T + (size_t)SRC_NGATE_END * D_MODEL, 0, (size_t)104 * D_MODEL * 2, stream);
    (void)hipMemsetAsync(WIN_T + (size_t)4480 * D_MODEL, 0, (size_t)128 * D_MODEL * 2, stream);

    int cur = 0;
    for (int i = 0; i < DEPTH; ++i) {
        k_transpose_w<<<512, 256, 0, stream>>>(w_in + (size_t)i * D_MODEL * IN_COLS, D_MODEL, IN_COLS, WIN_T, norm_g + i * D_MODEL, 1);
        k_transpose_w<<<256, 256, 0, stream>>>(w_out + (size_t)i * D_MODEL * D_MODEL, D_MODEL, D_MODEL, WOUT_T, nullptr, 0);
        k_transpose_w<<<256, 256, 0, stream>>>(w_pg + (size_t)i * D_MODEL * D_MODEL, D_MODEL, D_MODEL, WPG_T, ple_norm_g + i * D_MODEL, 0);
        k_transpose_w<<<128, 256, 0, stream>>>(w_pp + (size_t)i * PLE * D_MODEL, PLE, D_MODEL, WPP_T, nullptr, 0);
        k_f32_to_bf16<<<(MROWS * PLE / 4 + 255) / 256, 256, 0, stream>>>(p + (size_t)i * MROWS * PLE, PB, MROWS * PLE / 4);
        bf16* HB = BUF[cur];
        bf16* Y = BUF[cur ^ 1];
        { GemmArgs a{}; a.A = HB; a.Bt = WIN_T; a.M = MROWS; a.N = NPROJ; a.K = D_MODEL; a.mode = 0; a.O16 = P; a.RSi = RSB;
          k_gemm_phase<<<256, 512, GEMM_LDS, stream>>>(a); }
        k_nsa_prep<<<(MROWS * 12 + 255) / 256, 256, 0, stream>>>(P, QRb, nsa_qnorm_g + i * DH, nsa_knorm_g + (size_t)i * 3 * DH, ropec, ropes);
        for (int b = 0; b < BATCH; ++b) {
            const bf16* Pb = P + (size_t)b * SEQ * PP;
            bf16* Yb = Y + (size_t)b * SEQ * D_MODEL;
            const bf16* QRbb = QRb + (size_t)b * SEQ * NSA_W;
            k_hgrn_scan<<<HG_HEADS * HG_DV, 64, 0, stream>>>(Pb, lb_all + i * HG_W, o_raw);
            k_hgrn_out<<<SEQ, 512, 0, stream>>>(o_raw, Pb, hgrn_onorm_g + i * HG_DV, Yb);
            k_cmp_hidden<<<(2 * KVH * NC * CMP_HIDDEN + 255) / 256, 256, 0, stream>>>(Pb, cmp_pe + (size_t)i * 2 * CMP_BLOCK * DH,
                                                                                      cmp_w1 + (size_t)i * 2 * CMP_BLOCK * DH * CMP_HIDDEN, hid);
            k_cmp_out<<<(2 * KVH * NC + 63) / 64, 64, 0, stream>>>(hid, cmp_w2 + (size_t)i * 2 * CMP_HIDDEN * DH, nsa_knorm_g + (size_t)i * 3 * DH, kvc);
            k_cmp_attn_topk<<<KVH * SEQ / 64, 64, 0, stream>>>(Pb, kvc, scorebuf, selmask, Yn);
            k_slc_attn<<<NSA_HEADS * SEQ / 64, 64, 0, stream>>>(QRbb, Pb, selmask, Yn);
            k_win_attn<<<NSA_HEADS * SEQ / 64, 64, 0, stream>>>(QRbb, Pb, Yn, Yb);
        }
        { GemmArgs a{}; a.A = PB; a.Bt = WPP_T; a.M = MROWS; a.N = D_MODEL; a.K = PLE; a.mode = 1; a.O16 = PPb;
          k_gemm_phase<<<256, 512, GEMM_LDS, stream>>>(a); }
        { GemmArgs a{}; a.A = Y; a.Bt = WOUT_T; a.M = MROWS; a.N = D_MODEL; a.K = D_MODEL; a.mode = 2; a.O16 = HB  ; a.H = h; a.RSo = RSA;
          k_gemm_phase<<<256, 512, GEMM_LDS, stream>>>(a); }
        { GemmArgs a{}; a.A = HB; a.Bt = WPG_T; a.M = MROWS; a.N = D_MODEL; a.K = D_MODEL; a.mode = 3; a.O16 = (i + 1 < DEPTH) ? Y : nullptr; a.H = h; a.RSi = RSA;
          a.RSo = (i + 1 < DEPTH) ? RSB : nullptr; a.PPb = PPb;
          k_gemm_phase<<<256, 512, GEMM_LDS, stream>>>(a); }
        cur ^= 1;
    }
}
```

```cpp
#include <hip/hip_runtime.h>
#include <stdint.h>
#include <cstdio>

constexpr int D_MODEL = 1024, BATCH = 4, SEQ = 4096, DEPTH = 4, MROWS = BATCH * SEQ;
constexpr int HG_HEADS = 4, HG_DK = 128, HG_DV = 128, HG_W = 512;
constexpr int NSA_HEADS = 8, KVH = 2, DH = 64, GRP = 4, NSA_W = 512, KV_W = 128;
constexpr int CMP_BLOCK = 32, CMP_STRIDE = 16, CMP_HIDDEN = 128, SLC_BLOCK = 64, SLC_TOPK = 16, WINDOW = 512;
constexpr int NC = (SEQ - CMP_BLOCK) / CMP_STRIDE + 1;
constexpr int NSB = SEQ / SLC_BLOCK;
constexpr int PLE = 256;
constexpr int IN_COLS = 4376;
constexpr int NPROJ = 4608;
constexpr int PP = 4480;
constexpr float RMS_EPS = 1e-6f;
constexpr int C_HQ = 0, C_HF = 512, C_HI = 1024, C_HGO = 1536, C_HZ = 2048, C_NQ = 2560, C_KCM = 3072, C_VCM = 3200,
              C_KSL = 3328, C_VSL = 3456, C_KWN = 3584, C_VWN = 3712, C_NGATE = 3840, C_NZ = 3968;
constexpr int SRC_NGATE_END = 3864;

typedef unsigned short bf16;
#define LAS __attribute__((address_space(3)))
__device__ __forceinline__ float bf2f(bf16 v) { return __uint_as_float((unsigned)v << 16); }
__device__ __forceinline__ unsigned f2bf(float f) { unsigned u = __float_as_uint(f); return (u + 0x7fffu + ((u >> 16) & 1u)) >> 16; }
__device__ __forceinline__ unsigned pk2(float lo, float hi) { return f2bf(lo) | (f2bf(hi) << 16); }
__device__ __forceinline__ float sigmoidf_(float x) { return 1.f / (1.f + expf(-x)); }
__device__ __forceinline__ float siluf_(float x) { return x * sigmoidf_(x); }
__device__ __forceinline__ float fast_sigmoid(float x) { return __builtin_amdgcn_rcpf(1.f + __builtin_amdgcn_exp2f(-1.4426950408889634f * x)); }

namespace pg8 {
#define PG8_LAS __attribute__((address_space(3)))
typedef unsigned short bf16_t;
typedef short bf16x8 __attribute__((ext_vector_type(8)));
typedef float f32x4 __attribute__((ext_vector_type(4)));
typedef unsigned u32x4 __attribute__((ext_vector_type(4)));
constexpr int BM = 256, BK = 64, HALF = 128, HTB = HALF * BK * 2  , STAGE_BYTES = 8 * HTB, NXCD = 8, WGM = 8;

__host__ __device__ __forceinline__ int lds_byte(int r, int c) { const int st = (r >> 4) * 2 + (c >> 5), rr = r & 15, cc = c & 31, ob = rr * 64 + cc * 2; return st * 1024 + (ob ^ (((ob >> 9) & 1) << 5)); }
__host__ __device__ __forceinline__ void stage_rc(int b, int& R, int& C) { const int st = b / 1024, sb = b % 1024, swz = sb ^ (((sb >> 9) & 1) << 5); R = (st >> 1) * 16 + swz / 64; C = (st & 1) * 32 + (swz % 64) / 2; }
__host__ __device__ __forceinline__ int perm32(int rho) { const int n = rho >> 4, i = rho & 15; return 8 * (i >> 2) + 4 * n + (i & 3); }

struct Unit { int pm, pn; };
struct Gemm { const bf16_t* A; const bf16_t* Bt; int M, N, K; };

struct StaticOrder {
    int nM, nN, nwg, G, c;
    __host__ __device__ void init(int M, int N, int G_, int c_) { nM = M / BM; nN = N / BM; nwg = nM * nN; G = G_; c = c_; }
    __host__ __device__ bool next(int i, Unit& u) const {
        const long L = (long)i * G + c; if (L >= nwg) return false;
        int wgid = (int)L; { const int q = nwg / NXCD, r = nwg % NXCD, xcd = wgid % NXCD, off = wgid / NXCD; wgid = (xcd < r ? xcd * (q + 1) : r * (q + 1) + (xcd - r) * q) + off; }
        const int nig = WGM * nN, gid = wgid / nig, fm = gid * WGM, gsz = (nM - fm) < WGM ? (nM - fm) : WGM;
        u.pm = fm + ((wgid % nig) % gsz); u.pn = (wgid % nig) / gsz; return true;
    }
    __device__ __forceinline__ void a_ready(const Unit&) const {}
    __device__ __forceinline__ void done(const Unit&) const {}
};

__device__ __forceinline__ unsigned cvt_pk_bf16(float lo, float hi) { unsigned r; asm volatile("v_cvt_pk_bf16_f32 %0, %1, %2" : "=v"(r) : "v"(lo), "v"(hi)); return r; }
template <class Epi, class Sched, bool ALIGN_EPI = false, bool SP2 = false>
__device__ __forceinline__ void gemm_phase(PG8_LAS unsigned char* lds, const Gemm g, const Sched& S, const Epi& E) {
    const int tid = threadIdx.x, wid = __builtin_amdgcn_readfirstlane(tid >> 6), lane = tid & 63, wr = wid >> 2, wc = wid & 3, fr = lane & 15, fq = lane >> 4;
    const int K = g.K, nt = K / BK;
    unsigned voffA[2], voffB[2];
#pragma unroll
    for (int i = 0; i < 2; ++i) { int R, C; stage_rc(tid * 16 + i * 8192, R, C); const int Rb = Epi::PERM ? ((R & ~31) + perm32(R & 31)) : R;
        voffA[i] = (unsigned)(R * K + C) * 2u; voffB[i] = (unsigned)(Rb * K + C) * 2u; }
    const size_t kstep = (size_t)(BK * 2);
    const size_t hstep = (size_t)HALF * K * 2;
    const size_t tstep = 2 * hstep;
    const unsigned ldsw = (unsigned)wid * 1024u;
    const int aoff = lds_byte(wr * 64 + fr, fq * 8), boff = lds_byte(wc * 32 + fr, fq * 8);
#define PG8_SA(b, h) (((b) * 2 + (h)) * HTB)
#define PG8_SB(b, h) ((4 + (b) * 2 + (h)) * HTB)
#define PG8_STAGE(bufoff, gbase, voff) do { _Pragma("unroll") for (int _i = 0; _i < 2; ++_i) \
        __builtin_amdgcn_global_load_lds((const unsigned*)((const char*)(gbase) + (voff)[_i]), (PG8_LAS unsigned*)(lds + (bufoff) + ldsw + _i * 8192), 16, 0, 0); } while (0)
#define PG8_LDA(dst, b, h) do { _Pragma("unroll") for (int m = 0; m < 4; ++m) _Pragma("unroll") for (int k = 0; k < 2; ++k) dst[m][k] = *(const PG8_LAS bf16x8*)(lds + PG8_SA(b, h) + aoff + m * 2048 + k * 1024); } while (0)
#define PG8_LDB(dst, b, h) do { _Pragma("unroll") for (int n = 0; n < 2; ++n) _Pragma("unroll") for (int k = 0; k < 2; ++k) dst[n][k] = *(const PG8_LAS bf16x8*)(lds + PG8_SB(b, h) + boff + n * 2048 + k * 1024); } while (0)
#define PG8_MMA(ai, bj, At, Bt) do { __builtin_amdgcn_s_setprio(1); _Pragma("unroll") for (int m = 0; m < 4; ++m) _Pragma("unroll") for (int n = 0; n < 2; ++n) _Pragma("unroll") for (int k = 0; k < 2; ++k) \
        acc[ai][bj][m][n] = __builtin_amdgcn_mfma_f32_16x16x32_bf16(Bt[n][k], At[m][k], acc[ai][bj][m][n], 0, 0, 0); __builtin_amdgcn_s_setprio(0); } while (0)
#define PG8_WAIT_V(n) asm volatile("s_waitcnt vmcnt(" #n ")" ::: "memory")
#define PG8_WAIT_L(n) asm volatile("s_waitcnt lgkmcnt(" #n ")" ::: "memory")
#define PG8_BAR __builtin_amdgcn_s_barrier()
#define PG8_SCHED __builtin_amdgcn_sched_barrier(0)
    Unit cur, nxt; int ui = 0;
    if (!S.next(0, cur)) return;
    f32x4 acc[2][2][4][2];
#pragma unroll
    for (int a = 0; a < 2; ++a)
#pragma unroll
        for (int b = 0; b < 2; ++b)
#pragma unroll
            for (int m = 0; m < 4; ++m)
#pragma unroll
                for (int n = 0; n < 2; ++n) acc[a][b][m][n] = (f32x4){0.f, 0.f, 0.f, 0.f};
    bf16x8 At[4][2], B0[2][2], B1[2][2];
    const char* cA = (const char*)g.A + (size_t)cur.pm * tstep; const char* cB = (const char*)g.Bt + (size_t)cur.pn * tstep;
    S.a_ready(cur);
    if constexpr (SP2) {
        PG8_STAGE(PG8_SB(0, 0), cB, voffB); PG8_STAGE(PG8_SB(0, 1), cB + hstep, voffB); PG8_STAGE(PG8_SA(0, 0), cA, voffA); PG8_STAGE(PG8_SA(0, 1), cA + hstep, voffA);
        if (wr == 1) PG8_BAR;
        PG8_WAIT_V(2); PG8_BAR;
        PG8_STAGE(PG8_SB(1, 0), cB + kstep, voffB); PG8_STAGE(PG8_SA(1, 0), cA + kstep, voffA); PG8_STAGE(PG8_SB(1, 1), cB + hstep + kstep, voffB);
        PG8_WAIT_V(6); PG8_BAR;
    } else {
        PG8_STAGE(PG8_SB(0, 0), cB, voffB); PG8_STAGE(PG8_SA(0, 0), cA, voffA); PG8_STAGE(PG8_SB(0, 1), cB + hstep, voffB); PG8_STAGE(PG8_SA(0, 1), cA + hstep, voffA);
        if (wr == 1) PG8_BAR;
        PG8_WAIT_V(4); PG8_BAR;
        PG8_STAGE(PG8_SB(1, 0), cB + kstep, voffB); PG8_STAGE(PG8_SA(1, 0), cA + kstep, voffA); PG8_STAGE(PG8_SB(1, 1), cB + hstep + kstep, voffB);
        PG8_WAIT_V(6); PG8_BAR;
    }
    for (;;) {
        const bool has_next = S.next(ui + 1, nxt);
        const char* nA = has_next ? (const char*)g.A + (size_t)nxt.pm * tstep : cA; const char* nB = has_next ? (const char*)g.Bt + (size_t)nxt.pn * tstep : cB;
        for (int t = 0; t < nt; t += 2) {
            const bool last = (t == nt - 2);
            const char* a1 = cA + (size_t)(t + 1) * kstep;
            const char* a2 = last ? nA : cA + (size_t)(t + 2) * kstep; const char* b2 = last ? nB : cB + (size_t)(t + 2) * kstep;
            const char* a3 = a2 + kstep; const char* b3 = b2 + kstep;
            if (last && has_next) S.a_ready(nxt);
            if constexpr (SP2) {
            PG8_LDB(B0, 0, 0); PG8_LDB(B1, 0, 1); PG8_SCHED; PG8_LDA(At, 0, 0); PG8_STAGE(PG8_SA(1, 1), a1 + hstep, voffA);
            PG8_WAIT_V(8); PG8_WAIT_L(0); PG8_BAR; PG8_MMA(0, 0, At, B0); PG8_MMA(0, 1, At, B1); PG8_BAR; PG8_SCHED;
            PG8_LDA(At, 0, 1); PG8_STAGE(PG8_SB(0, 0), b2, voffB); PG8_STAGE(PG8_SB(0, 1), b2 + hstep, voffB); PG8_STAGE(PG8_SA(0, 0), a2, voffA);
            PG8_WAIT_V(8); PG8_WAIT_L(0); PG8_BAR; PG8_MMA(1, 0, At, B0); PG8_MMA(1, 1, At, B1); PG8_BAR; PG8_SCHED;
            PG8_LDB(B0, 1, 0); PG8_LDB(B1, 1, 1); PG8_SCHED; PG8_LDA(At, 1, 0); PG8_STAGE(PG8_SA(0, 1), a2 + hstep, voffA);
            PG8_WAIT_V(8); PG8_WAIT_L(0); PG8_BAR; PG8_MMA(0, 0, At, B0); PG8_MMA(0, 1, At, B1); PG8_BAR; PG8_SCHED;
            PG8_LDA(At, 1, 1); PG8_STAGE(PG8_SB(1, 0), b3, voffB); PG8_STAGE(PG8_SB(1, 1), b3 + hstep, voffB); PG8_STAGE(PG8_SA(1, 0), a3, voffA);
            PG8_WAIT_V(8); PG8_WAIT_L(0); PG8_BAR; PG8_MMA(1, 0, At, B0); PG8_MMA(1, 1, At, B1); PG8_BAR; PG8_SCHED;
            } else {
            PG8_LDB(B0, 0, 0); PG8_SCHED; PG8_LDA(At, 0, 0); PG8_STAGE(PG8_SA(1, 1), a1 + hstep, voffA);
            PG8_WAIT_L(8); PG8_BAR; PG8_WAIT_L(0); PG8_MMA(0, 0, At, B0); PG8_BAR; PG8_SCHED;
            PG8_LDB(B1, 0, 1); PG8_STAGE(PG8_SB(0, 0), b2, voffB);
            PG8_BAR; PG8_WAIT_L(0); PG8_MMA(0, 1, At, B1); PG8_BAR;
            PG8_LDA(At, 0, 1); PG8_STAGE(PG8_SA(0, 0), a2, voffA);
            PG8_BAR; PG8_WAIT_L(0); PG8_MMA(1, 0, At, B0); PG8_BAR; PG8_SCHED;
            PG8_STAGE(PG8_SB(0, 1), b2 + hstep, voffB);
            PG8_WAIT_V(6); PG8_BAR; PG8_MMA(1, 1, At, B1); PG8_BAR;
            PG8_LDB(B0, 1, 0); PG8_SCHED; PG8_LDA(At, 1, 0); PG8_STAGE(PG8_SA(0, 1), a2 + hstep, voffA);
            PG8_WAIT_L(8); PG8_BAR; PG8_WAIT_L(0); PG8_MMA(0, 0, At, B0); PG8_BAR; PG8_SCHED;
            PG8_LDB(B1, 1, 1); PG8_STAGE(PG8_SB(1, 0), b3, voffB);
            PG8_BAR; PG8_WAIT_L(0); PG8_MMA(0, 1, At, B1); PG8_BAR;
            PG8_LDA(At, 1, 1); PG8_STAGE(PG8_SA(1, 0), a3, voffA);
            PG8_BAR; PG8_WAIT_L(0); PG8_MMA(1, 0, At, B0); PG8_BAR; PG8_SCHED;
            PG8_STAGE(PG8_SB(1, 1), b3 + hstep, voffB);
            PG8_WAIT_V(6); PG8_BAR; PG8_MMA(1, 1, At, B1); PG8_BAR;
            }
        }
        if constexpr (ALIGN_EPI) { if (wr == 0) PG8_BAR; }
        if constexpr (!Epi::AFTER_DRAIN) { E(acc, cur, wr, wc, fr, fq); S.done(cur); }
        if (!has_next) break;
#pragma unroll
        for (int a = 0; a < 2; ++a)
#pragma unroll
            for (int b = 0; b < 2; ++b)
#pragma unroll
                for (int m = 0; m < 4; ++m)
#pragma unroll
                    for (int n = 0; n < 2; ++n) acc[a][b][m][n] = (f32x4){0.f, 0.f, 0.f, 0.f};
        cur = nxt; cA = nA; cB = nB; ++ui;
        if constexpr (ALIGN_EPI) { if (wr == 1) PG8_BAR; }
    }
    PG8_WAIT_V(0);
    if constexpr (!ALIGN_EPI) { if (wr == 0) PG8_BAR; }
    PG8_BAR;
    if constexpr (Epi::AFTER_DRAIN) { E.fused(acc, cur, wr, wc, fr, fq, lds, wid, lane); S.done(cur); }
#undef PG8_SA
#undef PG8_SB
#undef PG8_STAGE
#undef PG8_LDA
#undef PG8_LDB
#undef PG8_MMA
#undef PG8_WAIT_V
#undef PG8_WAIT_L
#undef PG8_BAR
#undef PG8_SCHED
}
}

namespace pg8 {
typedef unsigned u32x2 __attribute__((ext_vector_type(2)));
__device__ __forceinline__ float row_rstd(const float* rs, int row) {
    const f32x4* p = (const f32x4*)(rs + (size_t)row * 16);
    const f32x4 a = p[0], b = p[1], c = p[2], d = p[3];
    const float s = ((a[0] + a[1]) + (a[2] + a[3])) + ((b[0] + b[1]) + (b[2] + b[3])) + ((c[0] + c[1]) + (c[2] + c[3])) + ((d[0] + d[1]) + (d[2] + d[3]));
    return rsqrtf(s * (1.0f / 1024.0f) + 1e-6f);
}
struct EpiProj {
    static constexpr bool PERM = true, AFTER_DRAIN = false;
    bf16_t* O; int ldc; const float* rs; int ncols_store;
    __device__ __forceinline__ void operator()(const f32x4 (&acc)[2][2][4][2], const Unit& u, int wr, int wc, int fr, int fq) const {
        const int row0 = u.pm * BM + wr * 64 + fr, col0 = u.pn * BM + wc * 32 + 8 * fq;
#pragma unroll
        for (int ai = 0; ai < 2; ++ai)
#pragma unroll
            for (int m = 0; m < 4; ++m) {
                const int row = row0 + ai * HALF + m * 16;
                const float sc = rs ? row_rstd(rs, row) : 1.0f;
                bf16_t* rowp = O + (size_t)row * ldc + col0;
#pragma unroll
                for (int bj = 0; bj < 2; ++bj) {
                    if (col0 + bj * HALF < ncols_store) {
                        const f32x4 v0 = acc[ai][bj][m][0] * sc, v1 = acc[ai][bj][m][1] * sc;
                        u32x4 w; w.x = cvt_pk_bf16(v0[0], v0[1]); w.y = cvt_pk_bf16(v0[2], v0[3]); w.z = cvt_pk_bf16(v1[0], v1[1]); w.w = cvt_pk_bf16(v1[2], v1[3]);
                        *(u32x4*)(rowp + bj * HALF) = w;
                    }
                }
            }
    }
};
struct EpiHnew {
    static constexpr bool PERM = false, AFTER_DRAIN = false;
    float* H; bf16_t* HN; float* RS;
    __device__ __forceinline__ void operator()(const f32x4 (&acc)[2][2][4][2], const Unit& u, int wr, int wc, int fr, int fq) const {
        const int row0 = u.pm * BM + wr * 64 + fr, col0 = u.pn * BM + wc * 32 + 4 * fq;
#pragma unroll
        for (int ai = 0; ai < 2; ++ai)
#pragma unroll
            for (int m = 0; m < 4; ++m) {
                const int row = row0 + ai * HALF + m * 16;
                const size_t off = (size_t)row * 1024 + col0;
                float ss = 0.f;
#pragma unroll
                for (int bj = 0; bj < 2; ++bj)
#pragma unroll
                    for (int n = 0; n < 2; ++n) {
                        const f32x4 h4 = *(const f32x4*)(H + off + bj * HALF + n * 16);
                        const f32x4 v = h4 + acc[ai][bj][m][n];
                        *(f32x4*)(H + off + bj * HALF + n * 16) = v;
                        u32x2 w; w.x = cvt_pk_bf16(v[0], v[1]); w.y = cvt_pk_bf16(v[2], v[3]);
                        *(u32x2*)(HN + off + bj * HALF + n * 16) = w;
                        ss += (v[0] * v[0] + v[1] * v[1]) + (v[2] * v[2] + v[3] * v[3]);
                    }
                ss += __shfl_xor(ss, 16); ss += __shfl_xor(ss, 32);
                if (fq == 0) RS[(size_t)row * 16 + u.pn * 4 + wc] = ss;
            }
    }
};
struct EpiPle {
    static constexpr bool PERM = false, AFTER_DRAIN = false;
    float* H; bf16_t* HB; const float* RSi; float* RSo; const bf16_t* PPb;
    __device__ __forceinline__ void operator()(const f32x4 (&acc)[2][2][4][2], const Unit& u, int wr, int wc, int fr, int fq) const {
        const int row0 = u.pm * BM + wr * 64 + fr, col0 = u.pn * BM + wc * 32 + 4 * fq;
#pragma unroll
        for (int ai = 0; ai < 2; ++ai)
#pragma unroll
            for (int m = 0; m < 4; ++m) {
                const int row = row0 + ai * HALF + m * 16;
                const size_t off = (size_t)row * 1024 + col0;
                const float sc = row_rstd(RSi, row);
                float ss = 0.f;
#pragma unroll
                for (int bj = 0; bj < 2; ++bj)
#pragma unroll
                    for (int n = 0; n < 2; ++n) {
                        const f32x4 h4 = *(const f32x4*)(H + off + bj * HALF + n * 16);
                        const u32x2 pw = *(const u32x2*)(PPb + off + bj * HALF + n * 16);
                        const f32x4 a = acc[ai][bj][m][n] * sc;
                        f32x4 v;
                        v[0] = h4[0] + fast_sigmoid(a[0]) * __uint_as_float(pw.x << 16);
                        v[1] = h4[1] + fast_sigmoid(a[1]) * __uint_as_float(pw.x & 0xffff0000u);
                        v[2] = h4[2] + fast_sigmoid(a[2]) * __uint_as_float(pw.y << 16);
                        v[3] = h4[3] + fast_sigmoid(a[3]) * __uint_as_float(pw.y & 0xffff0000u);
                        *(f32x4*)(H + off + bj * HALF + n * 16) = v;
                        if (HB) { u32x2 w; w.x = cvt_pk_bf16(v[0], v[1]); w.y = cvt_pk_bf16(v[2], v[3]); *(u32x2*)(HB + off + bj * HALF + n * 16) = w; }
                        ss += (v[0] * v[0] + v[1] * v[1]) + (v[2] * v[2] + v[3] * v[3]);
                    }
                if (RSo) {
                    ss += __shfl_xor(ss, 16); ss += __shfl_xor(ss, 32);
                    if (fq == 0) RSo[(size_t)row * 16 + u.pn * 4 + wc] = ss;
                }
            }
    }
};
}

constexpr int GEMM_LDS = 147456;
struct GemmArgs { const bf16* A; const bf16* Bt; int M, N, K, mode; bf16* O16; float* H; const float* RSi; float* RSo; const bf16* PPb; };

__global__ void __launch_bounds__(512, 2) k_gemm_phase(GemmArgs a) {
    extern __shared__ __attribute__((aligned(16))) unsigned char lds[];
    pg8::Gemm g{a.A, a.Bt, a.M, a.N, a.K};
    pg8::StaticOrder S; S.init(a.M, a.N, gridDim.x, blockIdx.x);
    LAS unsigned char* l = (LAS unsigned char*)lds;
    if (a.mode == 0) { pg8::EpiProj E{a.O16, PP, a.RSi, PP}; pg8::gemm_phase<pg8::EpiProj, pg8::StaticOrder, true, true>(l, g, S, E); }
    else if (a.mode == 1) { pg8::EpiProj E{a.O16, 1024, nullptr, 1024}; pg8::gemm_phase<pg8::EpiProj, pg8::StaticOrder, true, true>(l, g, S, E); }
    else if (a.mode == 2) { pg8::EpiHnew E{a.H, a.O16, a.RSo}; pg8::gemm_phase<pg8::EpiHnew, pg8::StaticOrder, true, true>(l, g, S, E); }
    else { pg8::EpiPle E{a.H, a.O16, a.RSi, a.RSo, a.PPb}; pg8::gemm_phase<pg8::EpiPle, pg8::StaticOrder, true, true>(l, g, S, E); }
}

__device__ __forceinline__ int map_col(int n, int remap) { return (remap && n >= SRC_NGATE_END) ? n + 104 : n; }
__global__ void __launch_bounds__(256) k_transpose_w(const float* __restrict__ W, int K, int N, bf16* __restrict__ WT, const float* __restrict__ gk, int remap) {
    __shared__ float scr_all[4][64 * 33];
    const int lane = threadIdx.x & 63, wave = threadIdx.x >> 6;
    float* scr = scr_all[wave];
    const int nblk = (N + 31) / 32, nitems = (K / 64) * nblk;
    for (int item = blockIdx.x * 4 + wave; item < nitems; item += gridDim.x * 4) {
        const int kb = item / nblk, nb = item % nblk, k0 = 64 * kb, n0 = 32 * nb;
        for (int i = 0; i < 32; ++i) {
            const int kk = 2 * i + (lane >> 5), n = n0 + (lane & 31);
            float v = (n < N) ? W[(size_t)(k0 + kk) * N + n] : 0.f;
            if (gk) v *= gk[k0 + kk];
            scr[kk * 33 + (lane & 31)] = v;
        }
        asm volatile("s_waitcnt lgkmcnt(0)" ::: "memory");
        const int c = lane & 7;
        for (int j = 0; j < 4; ++j) {
            const int nl = (lane >> 3) + 8 * j, n = n0 + nl;
            if (n < N) {
                const float* s = scr + (8 * c) * 33 + nl;
                uint4 o; o.x = pk2(s[0 * 33], s[1 * 33]); o.y = pk2(s[2 * 33], s[3 * 33]); o.z = pk2(s[4 * 33], s[5 * 33]); o.w = pk2(s[6 * 33], s[7 * 33]);
                *(uint4*)(WT + (size_t)map_col(n, remap) * K + k0 + 8 * c) = o;
            }
        }
        asm volatile("s_waitcnt lgkmcnt(0)" ::: "memory");
    }
}
__global__ void __launch_bounds__(256) k_prep_x(const float* __restrict__ x, float* __restrict__ h, bf16* __restrict__ HB, float* __restrict__ RS) {
    const int lane = threadIdx.x & 63, row = blockIdx.x * 4 + (threadIdx.x >> 6);
    const float4* xr = (const float4*)(x + (size_t)row * D_MODEL) + lane;
    float4* hr = (float4*)(h + (size_t)row * D_MODEL) + lane;
    uint2* br = (uint2*)(HB + (size_t)row * D_MODEL) + lane;
    float ss = 0.f;
#pragma unroll
    for (int j = 0; j < 4; ++j) {
        const float4 v = xr[64 * j];
        hr[64 * j] = v;
        uint2 w; w.x = pk2(v.x, v.y); w.y = pk2(v.z, v.w); br[64 * j] = w;
        ss += (v.x * v.x + v.y * v.y) + (v.z * v.z + v.w * v.w);
    }
    for (int o = 32; o > 0; o >>= 1) ss += __shfl_xor(ss, o);
    if (lane < 16) RS[(size_t)row * 16 + lane] = (lane == 0) ? ss : 0.f;
}
__global__ void k_f32_to_bf16(const float* __restrict__ src, bf16* __restrict__ dst, int n4) {
    int i = blockIdx.x * blockDim.x + threadIdx.x;
    if (i >= n4) return;
    const float4 v = ((const float4*)src)[i];
    uint2 w; w.x = pk2(v.x, v.y); w.y = pk2(v.z, v.w);
    ((uint2*)dst)[i] = w;
}
__global__ void k_tables(const float* __restrict__ hgrn_lb, float* __restrict__ lb_all, float* __restrict__ ropec, float* __restrict__ ropes) {
    int i = blockIdx.x * blockDim.x + threadIdx.x;
    if (i < HG_W) {
        float v0 = hgrn_lb[i], v1 = hgrn_lb[HG_W + i], v2 = hgrn_lb[2 * HG_W + i], v3 = hgrn_lb[3 * HG_W + i];
        float m = fmaxf(fmaxf(v0, v1), fmaxf(v2, v3));
        v0 = expf(v0 - m); v1 = expf(v1 - m); v2 = expf(v2 - m); v3 = expf(v3 - m);
        float s = v0 + v1 + v2 + v3;
        lb_all[i] = 0.f; lb_all[HG_W + i] = v1 / s; lb_all[2 * HG_W + i] = v1 / s + v2 / s; lb_all[3 * HG_W + i] = v1 / s + v2 / s + v3 / s;
    }
    if (i < SEQ * 8) {
        int t = i >> 3, j = i & 7;
        double inv = pow(500000.0, -(double)(2 * j) / 16.0);
        double ang = (double)t * inv;
        ropec[i] = (float)cos(ang);
        ropes[i] = (float)sin(ang);
    }
}
namespace att {
using bf16x8 = __attribute__((ext_vector_type(8))) short;
using s16x4 = __attribute__((ext_vector_type(4))) short;
using f32x16 = __attribute__((ext_vector_type(16))) float;
using u32x4 = __attribute__((ext_vector_type(4))) unsigned;
constexpr int NW = 8, QBLK = 32, KVBLK = 64;
__device__ __forceinline__ int crow(int r, int hi) { return (r & 3) + 8 * (r >> 2) + 4 * hi; }
#define SBAR() __builtin_amdgcn_sched_barrier(0)
constexpr int NSLOT = 3, SLOTB = 8192;
constexpr int LDS_K = 0, LDS_V = NSLOT * SLOTB, LDS_WS = 2 * NSLOT * SLOTB, LDS_OST = LDS_WS + NW * 64 * 4, LDS_IMP = LDS_OST + NW * 4096, LDS_BYTES = LDS_IMP + 65536;
constexpr float C2 = 0.125f * 1.4426950408889634f;
__device__ __forceinline__ void glds16(const void* gsrc, unsigned lds_dst) { unsigned keep;
  asm volatile("s_mov_b32 %0, m0\n\ts_mov_b32 m0, %2\n\ts_nop 0\n\tglobal_load_lds_dwordx4 %1, off\n\ts_mov_b32 m0, %0" : "=&s"(keep) : "v"(gsrc), "s"(lds_dst) : "memory"); }
__device__ __forceinline__ float max3f(float a, float b, float c) { float r; asm("v_max3_f32 %0, %1, %2, %3" : "=v"(r) : "v"(a), "v"(b), "v"(c)); return r; }
__device__ __forceinline__ float max2f(float a, float b) { float r; asm("v_max_f32_e32 %0, %1, %2" : "=v"(r) : "v"(a), "v"(b)); return r; }
__device__ __forceinline__ float fadd_s(float a, float b) { float r; asm("v_add_f32_e32 %0, %1, %2" : "=v"(r) : "v"(a), "v"(b)); return r; }
__device__ __forceinline__ float fsub_s(float a, float b) { float r; asm("v_sub_f32_e32 %0, %1, %2" : "=v"(r) : "v"(a), "v"(b)); return r; }
typedef float f32x2_t __attribute__((ext_vector_type(2))); typedef __bf16 bf16x2_t __attribute__((ext_vector_type(2)));
__device__ __forceinline__ unsigned cvtpk_s(float lo, float hi) { f32x2_t v = {lo, hi}; bf16x2_t b = __builtin_convertvector(v, bf16x2_t); return __builtin_bit_cast(unsigned, b); }
#define WAIT_BAR(N) asm volatile("s_waitcnt vmcnt(" #N ") lgkmcnt(0)\n\ts_barrier" ::: "memory")

__device__ __forceinline__ void qkt(f32x16& p0, f32x16& p1, const char* Kslot, const bf16x8* qr, const f32x16& negm, int r32, int hi) {
  const char* kb = Kslot + hi * 1024 + r32 * 16;
#pragma unroll
  for (int d0 = 0; d0 < 4; ++d0) {
    const bf16x8 b0 = *reinterpret_cast<const bf16x8*>(kb + d0 * 2048);
    const bf16x8 b1 = *reinterpret_cast<const bf16x8*>(kb + d0 * 2048 + 512);
    if (d0 == 0) { p0 = __builtin_amdgcn_mfma_f32_32x32x16_bf16(b0, qr[0], negm, 0, 0, 0); p1 = __builtin_amdgcn_mfma_f32_32x32x16_bf16(b1, qr[0], negm, 0, 0, 0); }
    else { p0 = __builtin_amdgcn_mfma_f32_32x32x16_bf16(b0, qr[d0], p0, 0, 0, 0); p1 = __builtin_amdgcn_mfma_f32_32x32x16_bf16(b1, qr[d0], p1, 0, 0, 0); } }
}
typedef __attribute__((address_space(3))) const char* lds_cptr;
typedef short v4i16_t __attribute__((ext_vector_type(4)));
__device__ __forceinline__ void kload8(bf16x8* kf, lds_cptr kp) {
  kf[0] = *(const __attribute__((address_space(3))) bf16x8*)(kp);        kf[1] = *(const __attribute__((address_space(3))) bf16x8*)(kp + 512);
  kf[2] = *(const __attribute__((address_space(3))) bf16x8*)(kp + 2048); kf[3] = *(const __attribute__((address_space(3))) bf16x8*)(kp + 2560);
  kf[4] = *(const __attribute__((address_space(3))) bf16x8*)(kp + 4096); kf[5] = *(const __attribute__((address_space(3))) bf16x8*)(kp + 4608);
  kf[6] = *(const __attribute__((address_space(3))) bf16x8*)(kp + 6144); kf[7] = *(const __attribute__((address_space(3))) bf16x8*)(kp + 6656);
}
__device__ __forceinline__ void kload2(bf16x8* kf, lds_cptr kp, int j) { kf[2 * j] = *(const __attribute__((address_space(3))) bf16x8*)(kp + j * 2048); kf[2 * j + 1] = *(const __attribute__((address_space(3))) bf16x8*)(kp + j * 2048 + 512); }
__device__ __forceinline__ s16x4 vtr(lds_cptr p) { return __builtin_bit_cast(s16x4, __builtin_amdgcn_ds_read_tr16_b64_v4i16((__attribute__((address_space(3))) v4i16_t*)p)); }
__device__ __forceinline__ float rowmax(const f32x16& p0, const f32x16& p1) {
  float a = max3f(p0[0], p0[1], p1[0]), b = max3f(p0[2], p0[3], p1[1]); a = max3f(a, p1[2], p1[3]);
#pragma unroll
  for (int r = 4; r < 16; r += 4) { a = max3f(a, p0[r], p0[r + 1]); b = max3f(b, p0[r + 2], p0[r + 3]); a = max3f(a, p1[r], p1[r + 1]); b = max3f(b, p1[r + 2], p1[r + 3]); }
  const float m = max2f(a, b);
  auto rr = __builtin_amdgcn_permlane32_swap(__float_as_uint(m), __float_as_uint(m), false, false);
  return max2f(__uint_as_float(rr[0]), __uint_as_float(rr[1]));
}
__device__ __forceinline__ void pv(f32x16* o, int vb, bf16x8 pa0, bf16x8 pa1, bf16x8 pa2, bf16x8 pa3) {
#pragma unroll
  for (int d0 = 0; d0 < 2; ++d0) { s16x4 lo[4], hi[4];
#pragma unroll
    for (int ks = 0; ks < 4; ++ks) {
      asm volatile("ds_read_b64_tr_b16 %0,%1 offset:%c2" : "=&v"(lo[ks]) : "v"(vb), "i"(d0 * 4096 + ks * 1024) : "memory");
      asm volatile("ds_read_b64_tr_b16 %0,%1 offset:%c2" : "=&v"(hi[ks]) : "v"(vb), "i"(d0 * 4096 + ks * 1024 + 512) : "memory"); }
    asm volatile("s_waitcnt lgkmcnt(0)" ::: "memory"); SBAR();
#define PK(k) (bf16x8){lo[k][0], lo[k][1], lo[k][2], lo[k][3], hi[k][0], hi[k][1], hi[k][2], hi[k][3]}
    o[d0] = __builtin_amdgcn_mfma_f32_32x32x16_bf16(pa0, PK(0), o[d0], 0, 0, 0);
    o[d0] = __builtin_amdgcn_mfma_f32_32x32x16_bf16(pa1, PK(1), o[d0], 0, 0, 0);
    o[d0] = __builtin_amdgcn_mfma_f32_32x32x16_bf16(pa2, PK(2), o[d0], 0, 0, 0);
    o[d0] = __builtin_amdgcn_mfma_f32_32x32x16_bf16(pa3, PK(3), o[d0], 0, 0, 0);
#undef PK
  }
}
__device__ __forceinline__ void mask_gt(f32x16& p0, f32x16& p1, int thr, int hi) {
  const float NEG = -INFINITY; const int th = thr - 4 * hi;
#pragma unroll
  for (int r = 0; r < 16; ++r) { const int kc = (r & 3) + 8 * (r >> 2); if (kc > th) p0[r] = NEG; if (kc + 32 > th) p1[r] = NEG; }
}
__device__ __forceinline__ void mask_both(f32x16& p0, f32x16& p1, int tg, int tl, int hi) {
  const float NEG = -INFINITY; const int g = tg - 4 * hi, l = tl - 4 * hi;
#pragma unroll
  for (int r = 0; r < 16; ++r) { const int kc = (r & 3) + 8 * (r >> 2); if (kc > g || kc <= l) p0[r] = NEG; if (kc + 32 > g || kc + 32 <= l) p1[r] = NEG; }
}
struct AttnIO {
  bf16* P;
  const bf16* KC;
  const bf16* VC;
  bf16* Y;
  bf16* T2;
  unsigned long long* selmask;
  const float* ropec; const float* ropes;
  int pass;
};

template <int MODE, int THRL>
__device__ __forceinline__ void attn_unit(int b, int kvh, int qb, const AttnIO& io, char* shm) {
  const int tid = threadIdx.x, lane = tid & 63, r32 = lane & 31, hi = lane >> 5; const int wid = __builtin_amdgcn_readfirstlane(tid >> 6);
  const int head = kvh * 4 + (wid >> 1);
  const long rowbase = (long)b * SEQ; const int q0 = qb * 64 + (wid & 1) * 32;
  const int ql = (wid & 1) * 32 + r32;
  const int tq = qb * 64 + ql;
  const bf16* Qw = io.P + (rowbase + q0) * PP + C_NQ + head * 64;
  const bf16* Kh; const bf16* Vh; long kpitch, vpitch;
  if (MODE == 0) { Kh = io.P + rowbase * PP + C_KSL + kvh * 64; Vh = io.P + rowbase * PP + C_VSL + kvh * 64; kpitch = PP; vpitch = PP; }
  else if (MODE == 1) { Kh = io.P + rowbase * PP + C_KWN + kvh * 64; Vh = io.P + rowbase * PP + C_VWN + kvh * 64; kpitch = PP; vpitch = PP; }
  else { Kh = io.KC + (long)(b * KVH + kvh) * 256 * 64; Vh = (io.pass == 0) ? io.VC + (long)(b * KVH + kvh) * 256 * 64 : io.VC; kpitch = 64; vpitch = 64; }
  const int NTr = (MODE == 0) ? qb + 1 : (MODE == 1) ? ((qb < 8 ? qb : 8) + 1) : 4;
  const int NT = (NTr < 4) ? 4 : ((NTr + 1) & ~1);
#define MEMTILE(i) ((MODE == 0) ? ((i) < qb ? (i) : qb) : (MODE == 1) ? ((qb - (i)) > 0 ? (qb - (i)) : 0) : (i))
  const unsigned lds0 = (unsigned)(uintptr_t)shm;
  float* wsf = (float*)(shm + LDS_WS) + wid * 64;
  const bf16* ksrc = Kh + (long)lane * kpitch + wid * 8;
  const bf16* vsrc = Vh + (long)(16 * (wid & 3) + (lane >> 2)) * vpitch + (wid >> 2) * 32 + (lane & 3) * 8;
  const unsigned kdst = lds0 + LDS_K + wid * 1024, vdst = lds0 + LDS_V + wid * 1024;
#define DMA_K(t, slot) glds16(ksrc + (long)MEMTILE(t) * KVBLK * kpitch, (unsigned)__builtin_amdgcn_readfirstlane(kdst + (slot)))
#define DMA_V(t, slot) glds16(vsrc + (long)MEMTILE(t) * KVBLK * vpitch, (unsigned)__builtin_amdgcn_readfirstlane(vdst + (slot)))
  const int vb0 = (int)(lds0 + LDS_V) + ((lane >> 4) & 1) * 32 + (lane & 3) * 8 + (4 * hi + ((lane & 15) >> 2)) * 64;
  const char* Kbase = shm + LDS_K; bf16x8 kf[8];
  const lds_cptr shm3 = (lds_cptr)shm; const lds_cptr kp0 = shm3 + LDS_K + hi * 1024 + r32 * 16; const lds_cptr vp0 = shm3 + LDS_V + ((lane >> 4) & 1) * 32 + (lane & 3) * 8 + (4 * hi + ((lane & 15) >> 2)) * 64;
  DMA_K(0, 0); DMA_V(0, 0); DMA_K(1, SLOTB);
  bf16x8 qr[4];
#pragma unroll
  for (int d0 = 0; d0 < 4; ++d0) qr[d0] = *reinterpret_cast<const bf16x8*>(&Qw[(long)r32 * PP + d0 * 16 + hi * 8]);
  if (MODE != 2) {
    const u32x4 own = __builtin_bit_cast(u32x4, qr[0]);
    u32x4 par;
#pragma unroll
    for (int k = 0; k < 4; ++k) { auto rr = __builtin_amdgcn_permlane32_swap(own[k], own[k], false, false); par[k] = hi ? rr[0] : rr[1]; }
    const float4 c0 = *(const float4*)(io.ropec + (size_t)tq * 8), c1 = *(const float4*)(io.ropec + (size_t)tq * 8 + 4);
    const float4 s0 = *(const float4*)(io.ropes + (size_t)tq * 8), s1 = *(const float4*)(io.ropes + (size_t)tq * 8 + 4);
    const float cs[8] = {c0.x, c0.y, c0.z, c0.w, c1.x, c1.y, c1.z, c1.w}, sn[8] = {s0.x, s0.y, s0.z, s0.w, s1.x, s1.y, s1.z, s1.w};
    const float sg = hi ? 1.f : -1.f;
    u32x4 res;
#pragma unroll
    for (int k = 0; k < 4; ++k) {
      const float oa = __uint_as_float(own[k] << 16), ob = __uint_as_float(own[k] & 0xffff0000u);
      const float pa = __uint_as_float(par[k] << 16), pb = __uint_as_float(par[k] & 0xffff0000u);
      res[k] = cvtpk_s(oa * cs[2 * k] + sg * pa * sn[2 * k], ob * cs[2 * k + 1] + sg * pb * sn[2 * k + 1]);
    }
    qr[0] = __builtin_bit_cast(bf16x8, res);
  }
  unsigned mlo = 0xffffffffu, mhi_ = 0xffffffffu;
  if (MODE == 0) { const unsigned long long mk = io.selmask[(size_t)(b * KVH + kvh) * SEQ + tq]; mlo = (unsigned)mk; mhi_ = (unsigned)(mk >> 32); }
  int cmaxc = 0; if (MODE == 2) { cmaxc = (tq - 31) >> 4; if (cmaxc < 0) cmaxc = 0; }
  float mhat = 0.f, l_reg = 0.f; f32x16 o[2]; o[0] = f32x16{}; o[1] = f32x16{}; f32x16 negm = f32x16{}; asm volatile("" : "+v"(negm));
#define BMASK(P0, P1, t) do { \
    if (MODE == 0) { if ((t) >= qb) mask_gt(P0, P1, tq - 64 * (t), hi); } \
    else if (MODE == 1) { mask_both(P0, P1, ((t) == 0) ? ql : 1000, ((t) > qb) ? 1000 : ql + 64 * (t) - 512, hi); } \
    else { mask_gt(P0, P1, cmaxc - 64 * (t), hi); } } while (0)
#define NEGSEL(t) do { if (MODE == 0) { const int ti_ = ((t) < qb) ? (t) : qb; const unsigned w_ = (ti_ < 32) ? mlo : mhi_; const bool on_ = (w_ >> (ti_ & 31)) & 1u; \
      const float nm_ = on_ ? -mhat : -INFINITY; _Pragma("unroll") for (int r = 0; r < 16; ++r) negm[r] = nm_; asm volatile("" : "+v"(negm)); } } while (0)
  bool resc = false;
#define START(P0, P1) do { const float rm = rowmax(P0, P1); resc = false; \
    { const float dl = rm; mhat = fadd_s(mhat, dl); \
      _Pragma("unroll") for (int r = 0; r < 16; ++r) { P0[r] = fsub_s(P0[r], dl); P1[r] = fsub_s(P1[r], dl); } \
      _Pragma("unroll") for (int r = 0; r < 16; ++r) negm[r] = -mhat; asm volatile("" : "+v"(negm)); } \
    _Pragma("unroll") for (int r = 0; r < 16; ++r) P0[r] = __builtin_amdgcn_exp2f(P0[r]); } while (0)
#define RESC() do { if (resc) { asm volatile("s_waitcnt lgkmcnt(0)" ::: "memory"); \
      _Pragma("unroll") for (int d_ = 0; d_ < 2; ++d_) _Pragma("unroll") for (int r = 0; r < 16; ++r) o[d_][r] *= wsf[crow(r, hi)]; } } while (0)
  f32x16 pA0, pA1, pB0, pB1;
  int sl_prev = 0, sl_cur = 0, sl_next = SLOTB;
#define ROT() do { sl_prev = sl_cur; sl_cur = sl_next; sl_next = (sl_next == (NSLOT - 1) * SLOTB) ? 0 : sl_next + SLOTB; } while (0)
  DMA_K(2, 2 * SLOTB);
  WAIT_BAR(3);
  qkt(pA0, pA1, Kbase, qr, negm, r32, hi); asm volatile("s_nop 15\n\ts_nop 7" : "+v"(pA0), "+v"(pA1)); BMASK(pA0, pA1, 0);
  START(pA0, pA1);
  _Pragma("unroll") for (int r = 0; r < 16; ++r) pA1[r] = __builtin_amdgcn_exp2f(pA1[r]);
  WAIT_BAR(0);
  DMA_K(3, 0); DMA_V(1, SLOTB);
  ROT();
  kload8(kf, kp0 + sl_cur);
  WAIT_BAR(2);
  s16x4 vlo[8], vhi[8]; u32x4 pw0, pw1, pw2, pw3;
#define PKW(P, B) cvtpk_s(P[B], P[B + 1])
#define PAF(k) __builtin_bit_cast(bf16x8, pw##k)
#define VFR(i) (bf16x8){vlo[i][0], vlo[i][1], vlo[i][2], vlo[i][3], vhi[i][0], vhi[i][1], vhi[i][2], vhi[i][3]}
#define PIN(x) asm volatile("" : "+v"(x))
#define MX3(a, b, c) __builtin_fmaxf(__builtin_fmaxf((a), (b)), (c))
#define GAPA(MF, A0, A1, A2, A3, W0, W1, PW) do { MF; sacc += A0; sacc += A1; sacc += A2; sacc += A3; PIN(sacc); W0; W1; PIN(PW); SBAR(); } while (0)
#define EX(v) __builtin_amdgcn_exp2f(v)
#define GAPB(MF, X, B) do { MF; X[B] = EX(X[B]); X[B + 1] = EX(X[B + 1]); X[B + 2] = EX(X[B + 2]); X[B + 3] = EX(X[B + 3]); PIN(X); SBAR(); } while (0)
#define VRD(i) do { vlo[i] = vtr(vp_ + (((i) >> 2) * 4096 + ((i) & 3) * 1024)); vhi[i] = vtr(vp_ + (((i) >> 2) * 4096 + ((i) & 3) * 1024 + 512)); } while (0)
#define KRD(G, j) do { if (G) { kload2(kf, kp0 + sl_next, j); SBAR(); } } while (0)
#define STEP(C0, C1, P0, P1, t, GK, GV, GL, BAND) do { SBAR(); \
    NEGSEL(t); SBAR(); \
    const lds_cptr vp_ = vp0 + sl_prev; \
    VRD(0); SBAR(); float sacc = (P0[0] + P0[1]); \
    GAPA(C0 = __builtin_amdgcn_mfma_f32_32x32x16_bf16(kf[0], qr[0], negm, 0, 0, 0), P0[2], P0[3], P0[4], P0[5],     pw0[0] = PKW(P0, 0), pw0[1] = PKW(P0, 2), pw0); \
    VRD(4); SBAR(); GAPA(C1 = __builtin_amdgcn_mfma_f32_32x32x16_bf16(kf[1], qr[0], negm, 0, 0, 0), P0[6], P0[7], P0[8], P0[9],     pw0[2] = PKW(P0, 4), pw0[3] = PKW(P0, 6), pw0); \
    VRD(1); SBAR(); GAPA(C0 = __builtin_amdgcn_mfma_f32_32x32x16_bf16(kf[2], qr[1], C0, 0, 0, 0),   P0[10], P0[11], P0[12], P0[13], pw1[0] = PKW(P0, 8), pw1[1] = PKW(P0, 10), pw1); \
    VRD(5); SBAR(); GAPA(C1 = __builtin_amdgcn_mfma_f32_32x32x16_bf16(kf[3], qr[1], C1, 0, 0, 0),   P0[14], P0[15], P1[0], P1[1],   pw1[2] = PKW(P0, 12), pw1[3] = PKW(P0, 14), pw1); \
    VRD(2); SBAR(); GAPA(C0 = __builtin_amdgcn_mfma_f32_32x32x16_bf16(kf[4], qr[2], C0, 0, 0, 0),   P1[2], P1[3], P1[4], P1[5],     pw2[0] = PKW(P1, 0), pw2[1] = PKW(P1, 2), pw2); \
    VRD(6); SBAR(); GAPA(C1 = __builtin_amdgcn_mfma_f32_32x32x16_bf16(kf[5], qr[2], C1, 0, 0, 0),   P1[6], P1[7], P1[8], P1[9],     pw2[2] = PKW(P1, 4), pw2[3] = PKW(P1, 6), pw2); \
    VRD(3); SBAR(); GAPA(C0 = __builtin_amdgcn_mfma_f32_32x32x16_bf16(kf[6], qr[3], C0, 0, 0, 0),   P1[10], P1[11], P1[12], P1[13], pw3[0] = PKW(P1, 8), pw3[1] = PKW(P1, 10), pw3); \
    VRD(7); SBAR(); GAPA(C1 = __builtin_amdgcn_mfma_f32_32x32x16_bf16(kf[7], qr[3], C1, 0, 0, 0),   P1[14], P1[15], 0.f, 0.f,       pw3[2] = PKW(P1, 12), pw3[3] = PKW(P1, 14), pw3); \
    l_reg += sacc; \
    if (GK) { DMA_K((t) + 3, sl_cur); } if (GV) { DMA_V((t) + 1, sl_next); } \
    if (BAND) { BMASK(C0, C1, t); } \
    { float a = MX3(C0[0], C0[1], C1[0]), b = MX3(C0[2], C0[3], C1[1]); a = MX3(a, C1[2], C1[3]); \
      _Pragma("unroll") for (int r = 4; r < 16; r += 4) { a = MX3(a, C0[r], C0[r + 1]); b = MX3(b, C0[r + 2], C0[r + 3]); a = MX3(a, C1[r], C1[r + 1]); b = MX3(b, C1[r + 2], C1[r + 3]); } \
      float rm = __builtin_fmaxf(a, b); { auto rr = __builtin_amdgcn_permlane32_swap(__float_as_uint(rm), __float_as_uint(rm), false, false); rm = __builtin_fmaxf(__uint_as_float(rr[0]), __uint_as_float(rr[1])); } \
      resc = false; \
      if (__builtin_expect(__any(rm > (float)THRL), 0)) { const float dl = __builtin_fmaxf(rm, 0.f); mhat += dl; \
        _Pragma("unroll") for (int r = 0; r < 16; ++r) { C0[r] -= dl; C1[r] -= dl; } \
        _Pragma("unroll") for (int r = 0; r < 16; ++r) negm[r] = -mhat; asm volatile("" : "+v"(negm)); \
        const float f = __builtin_amdgcn_exp2f(-dl); l_reg *= f; if (hi == 0) wsf[r32] = f; resc = true; } } \
    SBAR(); \
    GAPB(o[0] = __builtin_amdgcn_mfma_f32_32x32x16_bf16(PAF(0), VFR(0), o[0], 0, 0, 0), C0, 0); \
    GAPB(o[1] = __builtin_amdgcn_mfma_f32_32x32x16_bf16(PAF(0), VFR(4), o[1], 0, 0, 0), C0, 4); \
    KRD(GL, 0); GAPB(o[0] = __builtin_amdgcn_mfma_f32_32x32x16_bf16(PAF(1), VFR(1), o[0], 0, 0, 0), C0, 8); \
    KRD(GL, 1); GAPB(o[1] = __builtin_amdgcn_mfma_f32_32x32x16_bf16(PAF(1), VFR(5), o[1], 0, 0, 0), C0, 12); \
    KRD(GL, 2); GAPB(o[0] = __builtin_amdgcn_mfma_f32_32x32x16_bf16(PAF(2), VFR(2), o[0], 0, 0, 0), C1, 0); \
    KRD(GL, 3); GAPB(o[1] = __builtin_amdgcn_mfma_f32_32x32x16_bf16(PAF(2), VFR(6), o[1], 0, 0, 0), C1, 4); \
    GAPB(o[0] = __builtin_amdgcn_mfma_f32_32x32x16_bf16(PAF(3), VFR(3), o[0], 0, 0, 0), C1, 8); \
    GAPB(o[1] = __builtin_amdgcn_mfma_f32_32x32x16_bf16(PAF(3), VFR(7), o[1], 0, 0, 0), C1, 12); \
    } while (0)
  int t = 1;
#pragma nounroll
  for (; t + 5 < NT; t += 2) {
    STEP(pB0, pB1, pA0, pA1, t, true, true, true, false);     WAIT_BAR(2); RESC(); ROT();
    STEP(pA0, pA1, pB0, pB1, t + 1, true, true, true, false); WAIT_BAR(2); RESC(); ROT();
  }
#define ENDW(tt) do { if ((tt) + 3 < NT) { WAIT_BAR(2); } else if ((tt) + 2 < NT) { WAIT_BAR(1); } else { WAIT_BAR(0); } } while (0)
#pragma nounroll
  for (; t + 1 < NT; t += 2) {
    STEP(pB0, pB1, pA0, pA1, t, (t + 3 < NT), (t + 1 < NT), (t + 1 < NT), true);       ENDW(t);     RESC(); ROT();
    STEP(pA0, pA1, pB0, pB1, t + 1, (t + 4 < NT), (t + 2 < NT), (t + 2 < NT), true);   ENDW(t + 1); RESC(); ROT();
  }
  STEP(pB0, pB1, pA0, pA1, NT - 1, false, false, false, true); RESC();
  { float sacc = pB0[0] + pB0[1]; _Pragma("unroll") for (int r = 2; r < 16; ++r) sacc += pB0[r]; _Pragma("unroll") for (int r = 0; r < 16; ++r) sacc += pB1[r]; l_reg += sacc;
    pw0 = (u32x4){PKW(pB0, 0), PKW(pB0, 2), PKW(pB0, 4), PKW(pB0, 6)}; pw1 = (u32x4){PKW(pB0, 8), PKW(pB0, 10), PKW(pB0, 12), PKW(pB0, 14)}; pw2 = (u32x4){PKW(pB1, 0), PKW(pB1, 2), PKW(pB1, 4), PKW(pB1, 6)}; pw3 = (u32x4){PKW(pB1, 8), PKW(pB1, 10), PKW(pB1, 12), PKW(pB1, 14)};
    SBAR(); pv(o, vb0 + sl_cur, PAF(0), PAF(1), PAF(2), PAF(3)); }
#undef PKW
#undef PAF
#undef VFR
#undef PIN
#undef MX3
#undef GAPA
#undef GAPB
#undef EX
#undef VRD
#undef KRD
#undef STEP
#undef ENDW
  { auto rr = __builtin_amdgcn_permlane32_swap(__float_as_uint(l_reg), __float_as_uint(l_reg), false, false); l_reg = __uint_as_float(rr[0]) + __uint_as_float(rr[1]); }
  if (hi == 0) wsf[32 + r32] = l_reg; asm volatile("s_waitcnt lgkmcnt(0)" ::: "memory");
  float rli[16];
#pragma unroll
  for (int r = 0; r < 16; ++r) rli[r] = __builtin_amdgcn_rcpf(wsf[32 + crow(r, hi)]);
  if (MODE == 2 && io.pass == 1) {
    float* imp = (float*)(shm + LDS_IMP) + ((wid >> 1) * 64 + (wid & 1) * 32) * 64;
#pragma unroll
    for (int r = 0; r < 16; ++r) { const int orow = crow(r, hi); const bool valid = (qb * 64 + (wid & 1) * 32 + orow) >= 31;
#pragma unroll
      for (int d0 = 0; d0 < 2; ++d0) imp[orow * 64 + d0 * 32 + r32] = valid ? o[d0][r] * rli[r] : 0.f; }
    asm volatile("s_waitcnt lgkmcnt(0)\n\ts_barrier" ::: "memory");
    const float* impb = (const float*)(shm + LDS_IMP);
    for (int k = 0; k < 8; ++k) {
      const int tl = wid * 8 + k, tt = qb * 64 + tl, cur = qb;
      float s = (impb[(0 * 64 + tl) * 64 + lane] + impb[(1 * 64 + tl) * 64 + lane]) + (impb[(2 * 64 + tl) * 64 + lane] + impb[(3 * 64 + tl) * 64 + lane]);
      const bool forced = (lane == 0) || (lane == cur) || (lane == cur - 1);
      s = forced ? 1e4f : ((lane <= cur) ? s : -1.0f);
      int rank = 0;
#pragma unroll
      for (int i = 0; i < 64; ++i) { const float si = __builtin_bit_cast(float, __builtin_amdgcn_readlane(__builtin_bit_cast(int, s), i)); rank += (si > s || (si == s && i < lane)) ? 1 : 0; }
      const unsigned long long m = __ballot(rank < 16);
      if (lane == 0) io.selmask[(size_t)(b * KVH + kvh) * SEQ + tt] = m;
    }
  } else {
    bf16* stg = (bf16*)(shm + LDS_OST) + wid * 2048;
#pragma unroll
    for (int r = 0; r < 16; ++r) { const int orow = crow(r, hi);
#pragma unroll
      for (int d0 = 0; d0 < 2; ++d0) stg[orow * 64 + d0 * 32 + r32] = (bf16)f2bf(o[d0][r] * rli[r]); }
    asm volatile("s_waitcnt lgkmcnt(0)" ::: "memory");
#pragma unroll
    for (int i = 0; i < 4; ++i) { const int row = i * 8 + (lane >> 3), ch = lane & 7;
      const u32x4 v = *(const u32x4*)(stg + row * 64 + ch * 8);
      const size_t grow = (size_t)(rowbase + q0 + row);
      const int tok = q0 + row;
      const bf16* pr = io.P + grow * PP;
      float ov[8];
#pragma unroll
      for (int k = 0; k < 4; ++k) { ov[2 * k] = __uint_as_float(v[k] << 16); ov[2 * k + 1] = __uint_as_float(v[k] & 0xffff0000u); }
      if (MODE == 2) {
        const float g0 = (tok >= 31) ? fast_sigmoid(bf2f(pr[C_NGATE + 0 * NSA_HEADS + head])) : 0.f;
        u32x4 w;
#pragma unroll
        for (int k = 0; k < 4; ++k) w[k] = cvtpk_s(g0 * ov[2 * k], g0 * ov[2 * k + 1]);
        *(u32x4*)(io.Y + grow * D_MODEL + HG_W + head * 64 + ch * 8) = w;
      } else if (MODE == 1) {
        const float g2 = fast_sigmoid(bf2f(pr[C_NGATE + 2 * NSA_HEADS + head]));
        u32x4 w;
#pragma unroll
        for (int k = 0; k < 4; ++k) w[k] = cvtpk_s(g2 * ov[2 * k], g2 * ov[2 * k + 1]);
        *(u32x4*)(io.T2 + grow * NSA_W + head * 64 + ch * 8) = w;
      } else {
        const float g1 = fast_sigmoid(bf2f(pr[C_NGATE + 1 * NSA_HEADS + head]));
        const u32x4 t1 = *(const u32x4*)(io.Y + grow * D_MODEL + HG_W + head * 64 + ch * 8);
        const u32x4 t2 = *(const u32x4*)(io.T2 + grow * NSA_W + head * 64 + ch * 8);
        const u32x4 nz = *(const u32x4*)(pr + C_NZ + head * 64 + ch * 8);
        u32x4 w;
#pragma unroll
        for (int k = 0; k < 4; ++k) {
          const float za = __uint_as_float(nz[k] << 16), zb = __uint_as_float(nz[k] & 0xffff0000u);
          const float ya = (__uint_as_float(t1[k] << 16) + __uint_as_float(t2[k] << 16) + g1 * ov[2 * k]) * za * fast_sigmoid(za);
          const float yb = (__uint_as_float(t1[k] & 0xffff0000u) + __uint_as_float(t2[k] & 0xffff0000u) + g1 * ov[2 * k + 1]) * zb * fast_sigmoid(zb);
          w[k] = cvtpk_s(ya, yb);
        }
        *(u32x4*)(io.Y + grow * D_MODEL + HG_W + head * 64 + ch * 8) = w;
      }
    }
  }
  asm volatile("s_waitcnt lgkmcnt(0)\n\ts_barrier" ::: "memory");
#undef DMA_K
#undef DMA_V
#undef MEMTILE
#undef BMASK
#undef NEGSEL
#undef START
#undef RESC
#undef ROT
}
#undef SBAR
#undef WAIT_BAR
}
__global__ void __launch_bounds__(256) k_nsa_prep(bf16* __restrict__ P, const float* __restrict__ qg, const float* __restrict__ kg,
                                                 const float* __restrict__ ropec, const float* __restrict__ ropes) {
    int i = blockIdx.x * blockDim.x + threadIdx.x;
    if (i >= MROWS * 12) return;
    const int row = i / 12, u = i % 12, t = row % SEQ;
    bf16* src; const float* g;
    if (u < 8) { src = P + (size_t)row * PP + C_NQ + u * DH; g = qg; }
    else if (u < 10) { src = P + (size_t)row * PP + C_KSL + (u - 8) * DH; g = kg + 1 * DH; }
    else { src = P + (size_t)row * PP + C_KWN + (u - 10) * DH; g = kg + 2 * DH; }
    uint4 raw[8];
    float ss = 0.f;
#pragma unroll
    for (int c = 0; c < 8; ++c) {
        raw[c] = ((const uint4*)src)[c];
        const unsigned w[4] = {raw[c].x, raw[c].y, raw[c].z, raw[c].w};
#pragma unroll
        for (int k = 0; k < 4; ++k) { const float a = __uint_as_float(w[k] << 16), b = __uint_as_float(w[k] & 0xffff0000u); ss += a * a + b * b; }
    }
    float r = rsqrtf(ss * (1.0f / DH) + RMS_EPS);
    if (u < 8) { r *= 0.125f * 1.4426950408889634f; ((uint4*)src)[0] = raw[0]; }
    float v01[16];
#pragma unroll
    for (int c = 0; c < 8; ++c) {
        const unsigned w[4] = {raw[c].x, raw[c].y, raw[c].z, raw[c].w};
        float v[8];
#pragma unroll
        for (int k = 0; k < 4; ++k) { v[2 * k] = __uint_as_float(w[k] << 16) * r * g[c * 8 + 2 * k]; v[2 * k + 1] = __uint_as_float(w[k] & 0xffff0000u) * r * g[c * 8 + 2 * k + 1]; }
        uint4 o; o.x = pk2(v[0], v[1]); o.y = pk2(v[2], v[3]); o.z = pk2(v[4], v[5]); o.w = pk2(v[6], v[7]);
        if (c < 2 && u >= 8) {
#pragma unroll
            for (int k = 0; k < 8; ++k) v01[c * 8 + k] = v[k];
        } else {
            ((uint4*)src)[c] = o;
        }
    }
    if (u < 8) return;
    float ro[16];
#pragma unroll
    for (int j = 0; j < 8; ++j) {
        const float cs = ropec[t * 8 + j], sn = ropes[t * 8 + j];
        ro[j] = v01[j] * cs - v01[j + 8] * sn;
        ro[j + 8] = v01[j] * sn + v01[j + 8] * cs;
    }
    uint4 o0, o1;
    o0.x = pk2(ro[0], ro[1]); o0.y = pk2(ro[2], ro[3]); o0.z = pk2(ro[4], ro[5]); o0.w = pk2(ro[6], ro[7]);
    o1.x = pk2(ro[8], ro[9]); o1.y = pk2(ro[10], ro[11]); o1.z = pk2(ro[12], ro[13]); o1.w = pk2(ro[14], ro[15]);
    uint4* dst = (uint4*)src;
    dst[0] = o0; dst[1] = o1;
}

__global__ void __launch_bounds__(64) k_hgrn_scan(const bf16* __restrict__ Pb, const float* __restrict__ lb_l, float* __restrict__ o_raw) {
    int hv = blockIdx.x, hd = hv >> 7, lane = threadIdx.x;
    int c0 = hd * HG_DK + lane, c1 = c0 + 64;
    float lb0 = lb_l[c0], lb1 = lb_l[c1];
    float S0 = 0.f, S1 = 0.f;
    for (int t = 0; t < SEQ; ++t) {
        const bf16* pr = Pb + (size_t)t * PP;
        float fl0 = bf2f(pr[C_HF + c0]), fl1 = bf2f(pr[C_HF + c1]);
        float q0 = bf2f(pr[C_HQ + c0]), q1 = bf2f(pr[C_HQ + c1]);
        float v = bf2f(pr[C_HI + hv]);
        float f0 = lb0 + (1.f - lb0) * sigmoidf_(fl0), f1 = lb1 + (1.f - lb1) * sigmoidf_(fl1);
        float k0 = (1.f - lb0) * sigmoidf_(-fl0), k1 = (1.f - lb1) * sigmoidf_(-fl1);
        S0 = f0 * S0 + k0 * v;
        S1 = f1 * S1 + k1 * v;
        float part = q0 * S0 + q1 * S1;
        for (int o = 32; o > 0; o >>= 1) part += __shfl_xor(part, o);
        if (lane == 0) o_raw[(size_t)t * HG_W + hv] = part;
    }
}
__global__ void __launch_bounds__(512) k_hgrn_out(const float* __restrict__ o_raw, const bf16* __restrict__ Pb, const float* __restrict__ onorm_g, bf16* __restrict__ Yb) {
    __shared__ float red[8];
    int t = blockIdx.x, c = threadIdx.x;
    float v = o_raw[(size_t)t * HG_W + c];
    float ss = v * v;
    for (int o = 32; o > 0; o >>= 1) ss += __shfl_xor(ss, o);
    if ((c & 63) == 0) red[c >> 6] = ss;
    __syncthreads();
    int hd = c >> 7;
    float tot = red[hd * 2] + red[hd * 2 + 1];
    float r = rsqrtf(tot / (float)HG_DV + RMS_EPS);
    const bf16* pr = Pb + (size_t)t * PP;
    float o = v * r * onorm_g[c & 127];
    Yb[(size_t)t * D_MODEL + c] = (bf16)f2bf(o * sigmoidf_(bf2f(pr[C_HGO + c])) * siluf_(bf2f(pr[C_HZ + c])));
}
__global__ void k_cmp_hidden(const bf16* __restrict__ Pb, const float* __restrict__ pe, const float* __restrict__ w1, float* __restrict__ hid) {
    int i = blockIdx.x * blockDim.x + threadIdx.x;
    if (i >= 2 * KVH * NC * CMP_HIDDEN) return;
    int n = i % CMP_HIDDEN, c = (i / CMP_HIDDEN) % NC, g = (i / (CMP_HIDDEN * NC)) % KVH, kv = i / (CMP_HIDDEN * NC * KVH);
    int col = (kv == 0 ? C_KCM : C_VCM) + g * DH;
    const float* pek = pe + (size_t)kv * CMP_BLOCK * DH;
    const float* w = w1 + (size_t)kv * CMP_BLOCK * DH * CMP_HIDDEN;
    float acc = 0.f;
    for (int l = 0; l < CMP_BLOCK; ++l) {
        const bf16* pr = Pb + (size_t)(c * CMP_STRIDE + l) * PP + col;
        for (int j = 0; j < DH; ++j) acc = fmaf(bf2f(pr[j]) + pek[l * DH + j], w[(size_t)(l * DH + j) * CMP_HIDDEN + n], acc);
    }
    hid[i] = siluf_(acc);
}
__global__ void k_cmp_out(const float* __restrict__ hid, const float* __restrict__ w2, const float* __restrict__ kg0, float* __restrict__ kvc, bf16* __restrict__ KCb, bf16* __restrict__ VCb) {
    int i = blockIdx.x * blockDim.x + threadIdx.x;
    if (i >= 2 * KVH * NC) return;
    int kv = i / (KVH * NC);
    const float* hrow = hid + (size_t)i * CMP_HIDDEN;
    const float* w = w2 + (size_t)kv * CMP_HIDDEN * DH;
    float out[DH];
#pragma unroll
    for (int j = 0; j < DH; ++j) out[j] = 0.f;
    for (int n = 0; n < CMP_HIDDEN; ++n) {
        float hv = hrow[n];
#pragma unroll
        for (int j = 0; j < DH; ++j) out[j] = fmaf(hv, w[n * DH + j], out[j]);
    }
    float r = 1.f;
    if (kv == 0) {
        float ss = 0.f;
#pragma unroll
        for (int j = 0; j < DH; ++j) ss += out[j] * out[j];
        r = rsqrtf(ss / (float)DH + RMS_EPS);
    }
    const int g_ = (i / NC) % KVH, cc_ = i % NC;
    bf16* dst = (kv == 0 ? KCb : VCb) + ((size_t)g_ * 256 + cc_) * DH;
#pragma unroll
    for (int j = 0; j < DH; ++j) { const float v = (kv == 0) ? out[j] * r * kg0[j] : out[j]; kvc[(size_t)i * DH + j] = v; dst[j] = (bf16)f2bf(v); }
}
__global__ void k_cmp_consts(bf16* __restrict__ OV, bf16* __restrict__ KC, bf16* __restrict__ VC) {
    int i = blockIdx.x * blockDim.x + threadIdx.x;
    if (i < 256 * 64) {
        const int c = i >> 6, j = i & 63;
        float v = 0.f;
        if (c < NC) { const int j0 = (16 * c) >> 6, j1 = (16 * c + 31) >> 6; if (j0 == j1) v = (j == j0) ? 1.f : 0.f; else v = (j == j0 || j == j1) ? 0.5f : 0.f; }
        OV[i] = (bf16)f2bf(v);
    }
    if (i < BATCH * KVH * 64) { const int bg = i >> 6, j = i & 63; KC[((size_t)bg * 256 + 255) * 64 + j] = 0; VC[((size_t)bg * 256 + 255) * 64 + j] = 0; }
}
constexpr int ATT_LDS = 149504 + 256;
template <int MODE>
__global__ void __launch_bounds__(512, 2) k_attn(att::AttnIO io) {
    extern __shared__ __attribute__((aligned(16))) unsigned char lds[];
    const int c = blockIdx.x, bk = c >> 5, s = c & 31;
    att::attn_unit<MODE, 8>(bk >> 1, bk & 1, 63 - s, io, (char*)lds);
    att::attn_unit<MODE, 8>(bk >> 1, bk & 1, s, io, (char*)lds);
}
extern "C" void kernel_launch(void* const* d_in, const int* in_sizes, int n_in, void* d_out, int out_size, void* d_ws, size_t ws_size, hipStream_t stream) {
    const float* x = (const float*)d_in[0];
    const float* p = (const float*)d_in[1];
    const float* norm_g = (const float*)d_in[2];
    const float* w_in = (const float*)d_in[3];
    const float* hgrn_lb = (const float*)d_in[4];
    const float* hgrn_onorm_g = (const float*)d_in[5];
    const float* nsa_qnorm_g = (const float*)d_in[6];
    const float* nsa_knorm_g = (const float*)d_in[7];
    const float* cmp_pe = (const float*)d_in[8];
    const float* cmp_w1 = (const float*)d_in[9];
    const float* cmp_w2 = (const float*)d_in[10];
    const float* w_out = (const float*)d_in[11];
    const float* ple_norm_g = (const float*)d_in[12];
    const float* w_pg = (const float*)d_in[13];
    const float* w_pp = (const float*)d_in[14];
    float* h = (float*)d_out;
    unsigned char* ws = (unsigned char*)d_ws;
    constexpr size_t MiB = 1u << 20;
    bf16* WIN_T = (bf16*)(ws + 1 * MiB);
    bf16* WOUT_T = (bf16*)(ws + 10 * MiB);
    bf16* WPG_T = (bf16*)(ws + 12 * MiB);
    bf16* WPP_T = (bf16*)(ws + 14 * MiB);
    float* lb_all = (float*)(ws + 16 * MiB);
    float* ropec = lb_all + DEPTH * HG_W;
    float* ropes = ropec + SEQ * 8;
    float* RSA = (float*)(ws + 17 * MiB);
    float* RSB = (float*)(ws + 18 * MiB);
    bf16* BUF[2] = {(bf16*)(ws + 20 * MiB), (bf16*)(ws + 52 * MiB)};
    bf16* PB = (bf16*)(ws + 84 * MiB);
    bf16* T2 = (bf16*)(ws + 92 * MiB);
    bf16* P = (bf16*)(ws + 108 * MiB);
    bf16* PPb = P;
    float* misc = (float*)(ws + 248 * MiB);
    size_t off = 0;
    auto take = [&](size_t n) { float* r = misc + off; off += (n + 63) & ~(size_t)63; return r; };
    float* o_raw = take((size_t)SEQ * HG_W);
    float* hid = take((size_t)2 * KVH * NC * CMP_HIDDEN);
    float* kvc = take((size_t)2 * KVH * NC * DH);
    unsigned long long* selmask = (unsigned long long*)take((size_t)BATCH * KVH * SEQ * 2);
    bf16* KC = (bf16*)take((size_t)BATCH * KVH * 256 * 64 / 2);
    bf16* VC = (bf16*)take((size_t)BATCH * KVH * 256 * 64 / 2);
    bf16* OV = (bf16*)take((size_t)256 * 64 / 2);
    if (248 * MiB + off * 4 > ws_size) { fprintf(stderr, "workspace too small: need %zu have %zu\n", 248 * MiB + off * 4, ws_size); return; }

    static bool attr_set = false;
    if (!attr_set) {
        (void)hipFuncSetAttribute((const void*)k_gemm_phase, hipFuncAttributeMaxDynamicSharedMemorySize, GEMM_LDS);
        (void)hipFuncSetAttribute((const void*)k_attn<0>, hipFuncAttributeMaxDynamicSharedMemorySize, ATT_LDS);
        (void)hipFuncSetAttribute((const void*)k_attn<1>, hipFuncAttributeMaxDynamicSharedMemorySize, ATT_LDS);
        (void)hipFuncSetAttribute((const void*)k_attn<2>, hipFuncAttributeMaxDynamicSharedMemorySize, ATT_LDS);
        attr_set = true;
    }

    k_prep_x<<<MROWS / 4, 256, 0, stream>>>(x, h, BUF[0], RSB);
    k_tables<<<(SEQ * 8 + 255) / 256, 256, 0, stream>>>(hgrn_lb, lb_all, ropec, ropes);
    k_cmp_consts<<<64, 256, 0, stream>>>(OV, KC, VC);
    (void)hipMemsetAsync(WIN_T + (size_t)SRC_NGATE_END * D_MODEL, 0, (size_t)104 * D_MODEL * 2, stream);
    (void)hipMemsetAsync(WIN_T + (size_t)4480 * D_MODEL, 0, (size_t)128 * D_MODEL * 2, stream);

    int cur = 0;
    for (int i = 0; i < DEPTH; ++i) {
        k_transpose_w<<<512, 256, 0, stream>>>(w_in + (size_t)i * D_MODEL * IN_COLS, D_MODEL, IN_COLS, WIN_T, norm_g + i * D_MODEL, 1);
        k_transpose_w<<<256, 256, 0, stream>>>(w_out + (size_t)i * D_MODEL * D_MODEL, D_MODEL, D_MODEL, WOUT_T, nullptr, 0);
        k_transpose_w<<<256, 256, 0, stream>>>(w_pg + (size_t)i * D_MODEL * D_MODEL, D_MODEL, D_MODEL, WPG_T, ple_norm_g + i * D_MODEL, 0);
        k_transpose_w<<<128, 256, 0, stream>>>(w_pp + (size_t)i * PLE * D_MODEL, PLE, D_MODEL, WPP_T, nullptr, 0);
        k_f32_to_bf16<<<(MROWS * PLE / 4 + 255) / 256, 256, 0, stream>>>(p + (size_t)i * MROWS * PLE, PB, MROWS * PLE / 4);
        bf16* HB = BUF[cur];
        bf16* Y = BUF[cur ^ 1];
        { GemmArgs a{}; a.A = HB; a.Bt = WIN_T; a.M = MROWS; a.N = NPROJ; a.K = D_MODEL; a.mode = 0; a.O16 = P; a.RSi = RSB;
          k_gemm_phase<<<256, 512, GEMM_LDS, stream>>>(a); }
        k_nsa_prep<<<(MROWS * 12 + 255) / 256, 256, 0, stream>>>(P, nsa_qnorm_g + i * DH, nsa_knorm_g + (size_t)i * 3 * DH, ropec, ropes);
        for (int b = 0; b < BATCH; ++b) {
            const bf16* Pb = P + (size_t)b * SEQ * PP;
            bf16* Yb = Y + (size_t)b * SEQ * D_MODEL;
            k_hgrn_scan<<<HG_HEADS * HG_DV, 64, 0, stream>>>(Pb, lb_all + i * HG_W, o_raw);
            k_hgrn_out<<<SEQ, 512, 0, stream>>>(o_raw, Pb, hgrn_onorm_g + i * HG_DV, Yb);
            k_cmp_hidden<<<(2 * KVH * NC * CMP_HIDDEN + 255) / 256, 256, 0, stream>>>(Pb, cmp_pe + (size_t)i * 2 * CMP_BLOCK * DH,
                                                                                      cmp_w1 + (size_t)i * 2 * CMP_BLOCK * DH * CMP_HIDDEN, hid);
            k_cmp_out<<<(2 * KVH * NC + 63) / 64, 64, 0, stream>>>(hid, cmp_w2 + (size_t)i * 2 * CMP_HIDDEN * DH, nsa_knorm_g + (size_t)i * 3 * DH, kvc,
                                                                  KC + (size_t)b * KVH * 256 * 64, VC + (size_t)b * KVH * 256 * 64);
        }
        att::AttnIO io{}; io.P = P; io.KC = KC; io.VC = VC; io.Y = Y; io.T2 = T2; io.selmask = selmask; io.ropec = ropec; io.ropes = ropes; io.pass = 0;
        k_attn<2><<<256, 512, ATT_LDS, stream>>>(io);
        { att::AttnIO io1 = io; io1.VC = OV; io1.pass = 1; k_attn<2><<<256, 512, ATT_LDS, stream>>>(io1); }
        k_attn<1><<<256, 512, ATT_LDS, stream>>>(io);
        k_attn<0><<<256, 512, ATT_LDS, stream>>>(io);
        { GemmArgs a{}; a.A = PB; a.Bt = WPP_T; a.M = MROWS; a.N = D_MODEL; a.K = PLE; a.mode = 1; a.O16 = PPb;
          k_gemm_phase<<<256, 512, GEMM_LDS, stream>>>(a); }
        { GemmArgs a{}; a.A = Y; a.Bt = WOUT_T; a.M = MROWS; a.N = D_MODEL; a.K = D_MODEL; a.mode = 2; a.O16 = HB; a.H = h; a.RSo = RSA;
          k_gemm_phase<<<256, 512, GEMM_LDS, stream>>>(a); }
        { GemmArgs a{}; a.A = HB; a.Bt = WPG_T; a.M = MROWS; a.N = D_MODEL; a.K = D_MODEL; a.mode = 3; a.O16 = (i + 1 < DEPTH) ? Y : nullptr; a.H = h; a.RSi = RSA;
          a.RSo = (i + 1 < DEPTH) ? RSB : nullptr; a.PPb = PPb;
          k_gemm_phase<<<256, 512, GEMM_LDS, stream>>>(a); }
        cur ^= 1;
    }
}
```

```cpp
#include <hip/hip_runtime.h>
#include <stdint.h>
#include <cstdio>

constexpr int D_MODEL = 1024, BATCH = 4, SEQ = 4096, DEPTH = 4, MROWS = BATCH * SEQ;
constexpr int HG_HEADS = 4, HG_DK = 128, HG_DV = 128, HG_W = 512;
constexpr int NSA_HEADS = 8, KVH = 2, DH = 64, GRP = 4, NSA_W = 512, KV_W = 128;
constexpr int CMP_BLOCK = 32, CMP_STRIDE = 16, CMP_HIDDEN = 128, SLC_BLOCK = 64, SLC_TOPK = 16, WINDOW = 512;
constexpr int NC = (SEQ - CMP_BLOCK) / CMP_STRIDE + 1;
constexpr int NSB = SEQ / SLC_BLOCK;
constexpr int PLE = 256;
constexpr int IN_COLS = 4376;
constexpr int NPROJ = 4608;
constexpr int PP = 4480;
constexpr float RMS_EPS = 1e-6f;
constexpr int C_HQ = 0, C_HF = 512, C_HI = 1024, C_HGO = 1536, C_HZ = 2048, C_NQ = 2560, C_KCM = 3072, C_VCM = 3200,
              C_KSL = 3328, C_VSL = 3456, C_KWN = 3584, C_VWN = 3712, C_NGATE = 3840, C_NZ = 3968;
constexpr int SRC_NGATE_END = 3864;

typedef unsigned short bf16;
#define LAS __attribute__((address_space(3)))
__device__ __forceinline__ float bf2f(bf16 v) { return __uint_as_float((unsigned)v << 16); }
__device__ __forceinline__ unsigned f2bf(float f) { unsigned u = __float_as_uint(f); return (u + 0x7fffu + ((u >> 16) & 1u)) >> 16; }
__device__ __forceinline__ unsigned pk2(float lo, float hi) { return f2bf(lo) | (f2bf(hi) << 16); }
__device__ __forceinline__ float sigmoidf_(float x) { return 1.f / (1.f + expf(-x)); }
__device__ __forceinline__ float siluf_(float x) { return x * sigmoidf_(x); }
__device__ __forceinline__ float fast_sigmoid(float x) { return __builtin_amdgcn_rcpf(1.f + __builtin_amdgcn_exp2f(-1.4426950408889634f * x)); }

namespace pg8 {
#define PG8_LAS __attribute__((address_space(3)))
typedef unsigned short bf16_t;
typedef short bf16x8 __attribute__((ext_vector_type(8)));
typedef float f32x4 __attribute__((ext_vector_type(4)));
typedef unsigned u32x4 __attribute__((ext_vector_type(4)));
constexpr int BM = 256, BK = 64, HALF = 128, HTB = HALF * BK * 2  , STAGE_BYTES = 8 * HTB, NXCD = 8, WGM = 8;

__host__ __device__ __forceinline__ int lds_byte(int r, int c) { const int st = (r >> 4) * 2 + (c >> 5), rr = r & 15, cc = c & 31, ob = rr * 64 + cc * 2; return st * 1024 + (ob ^ (((ob >> 9) & 1) << 5)); }
__host__ __device__ __forceinline__ void stage_rc(int b, int& R, int& C) { const int st = b / 1024, sb = b % 1024, swz = sb ^ (((sb >> 9) & 1) << 5); R = (st >> 1) * 16 + swz / 64; C = (st & 1) * 32 + (swz % 64) / 2; }
__host__ __device__ __forceinline__ int perm32(int rho) { const int n = rho >> 4, i = rho & 15; return 8 * (i >> 2) + 4 * n + (i & 3); }

struct Unit { int pm, pn; };
struct Gemm { const bf16_t* A; const bf16_t* Bt; int M, N, K; };

struct StaticOrder {
    int nM, nN, nwg, G, c;
    __host__ __device__ void init(int M, int N, int G_, int c_) { nM = M / BM; nN = N / BM; nwg = nM * nN; G = G_; c = c_; }
    __host__ __device__ bool next(int i, Unit& u) const {
        const long L = (long)i * G + c; if (L >= nwg) return false;
        int wgid = (int)L; { const int q = nwg / NXCD, r = nwg % NXCD, xcd = wgid % NXCD, off = wgid / NXCD; wgid = (xcd < r ? xcd * (q + 1) : r * (q + 1) + (xcd - r) * q) + off; }
        const int nig = WGM * nN, gid = wgid / nig, fm = gid * WGM, gsz = (nM - fm) < WGM ? (nM - fm) : WGM;
        u.pm = fm + ((wgid % nig) % gsz); u.pn = (wgid % nig) / gsz; return true;
    }
    __device__ __forceinline__ void a_ready(const Unit&) const {}
    __device__ __forceinline__ void done(const Unit&) const {}
};

__device__ __forceinline__ unsigned cvt_pk_bf16(float lo, float hi) { unsigned r; asm volatile("v_cvt_pk_bf16_f32 %0, %1, %2" : "=v"(r) : "v"(lo), "v"(hi)); return r; }
template <class Epi, class Sched, bool ALIGN_EPI = false, bool SP2 = false>
__device__ __forceinline__ void gemm_phase(PG8_LAS unsigned char* lds, const Gemm g, const Sched& S, const Epi& E) {
    const int tid = threadIdx.x, wid = __builtin_amdgcn_readfirstlane(tid >> 6), lane = tid & 63, wr = wid >> 2, wc = wid & 3, fr = lane & 15, fq = lane >> 4;
    const int K = g.K, nt = K / BK;
    unsigned voffA[2], voffB[2];
#pragma unroll
    for (int i = 0; i < 2; ++i) { int R, C; stage_rc(tid * 16 + i * 8192, R, C); const int Rb = Epi::PERM ? ((R & ~31) + perm32(R & 31)) : R;
        voffA[i] = (unsigned)(R * K + C) * 2u; voffB[i] = (unsigned)(Rb * K + C) * 2u; }
    const size_t kstep = (size_t)(BK * 2);
    const size_t hstep = (size_t)HALF * K * 2;
    const size_t tstep = 2 * hstep;
    const unsigned ldsw = (unsigned)wid * 1024u;
    const int aoff = lds_byte(wr * 64 + fr, fq * 8), boff = lds_byte(wc * 32 + fr, fq * 8);
#define PG8_SA(b, h) (((b) * 2 + (h)) * HTB)
#define PG8_SB(b, h) ((4 + (b) * 2 + (h)) * HTB)
#define PG8_STAGE(bufoff, gbase, voff) do { _Pragma("unroll") for (int _i = 0; _i < 2; ++_i) \
        __builtin_amdgcn_global_load_lds((const unsigned*)((const char*)(gbase) + (voff)[_i]), (PG8_LAS unsigned*)(lds + (bufoff) + ldsw + _i * 8192), 16, 0, 0); } while (0)
#define PG8_LDA(dst, b, h) do { _Pragma("unroll") for (int m = 0; m < 4; ++m) _Pragma("unroll") for (int k = 0; k < 2; ++k) dst[m][k] = *(const PG8_LAS bf16x8*)(lds + PG8_SA(b, h) + aoff + m * 2048 + k * 1024); } while (0)
#define PG8_LDB(dst, b, h) do { _Pragma("unroll") for (int n = 0; n < 2; ++n) _Pragma("unroll") for (int k = 0; k < 2; ++k) dst[n][k] = *(const PG8_LAS bf16x8*)(lds + PG8_SB(b, h) + boff + n * 2048 + k * 1024); } while (0)
#define PG8_MMA(ai, bj, At, Bt) do { __builtin_amdgcn_s_setprio(1); _Pragma("unroll") for (int m = 0; m < 4; ++m) _Pragma("unroll") for (int n = 0; n < 2; ++n) _Pragma("unroll") for (int k = 0; k < 2; ++k) \
        acc[ai][bj][m][n] = __builtin_amdgcn_mfma_f32_16x16x32_bf16(Bt[n][k], At[m][k], acc[ai][bj][m][n], 0, 0, 0); __builtin_amdgcn_s_setprio(0); } while (0)
#define PG8_WAIT_V(n) asm volatile("s_waitcnt vmcnt(" #n ")" ::: "memory")
#define PG8_WAIT_L(n) asm volatile("s_waitcnt lgkmcnt(" #n ")" ::: "memory")
#define PG8_BAR __builtin_amdgcn_s_barrier()
#define PG8_SCHED __builtin_amdgcn_sched_barrier(0)
    Unit cur, nxt; int ui = 0;
    if (!S.next(0, cur)) return;
    f32x4 acc[2][2][4][2];
#pragma unroll
    for (int a = 0; a < 2; ++a)
#pragma unroll
        for (int b = 0; b < 2; ++b)
#pragma unroll
            for (int m = 0; m < 4; ++m)
#pragma unroll
                for (int n = 0; n < 2; ++n) acc[a][b][m][n] = (f32x4){0.f, 0.f, 0.f, 0.f};
    bf16x8 At[4][2], B0[2][2], B1[2][2];
    const char* cA = (const char*)g.A + (size_t)cur.pm * tstep; const char* cB = (const char*)g.Bt + (size_t)cur.pn * tstep;
    S.a_ready(cur);
    if constexpr (SP2) {
        PG8_STAGE(PG8_SB(0, 0), cB, voffB); PG8_STAGE(PG8_SB(0, 1), cB + hstep, voffB); PG8_STAGE(PG8_SA(0, 0), cA, voffA); PG8_STAGE(PG8_SA(0, 1), cA + hstep, voffA);
        if (wr == 1) PG8_BAR;
        PG8_WAIT_V(2); PG8_BAR;
        PG8_STAGE(PG8_SB(1, 0), cB + kstep, voffB); PG8_STAGE(PG8_SA(1, 0), cA + kstep, voffA); PG8_STAGE(PG8_SB(1, 1), cB + hstep + kstep, voffB);
        PG8_WAIT_V(6); PG8_BAR;
    } else {
        PG8_STAGE(PG8_SB(0, 0), cB, voffB); PG8_STAGE(PG8_SA(0, 0), cA, voffA); PG8_STAGE(PG8_SB(0, 1), cB + hstep, voffB); PG8_STAGE(PG8_SA(0, 1), cA + hstep, voffA);
        if (wr == 1) PG8_BAR;
        PG8_WAIT_V(4); PG8_BAR;
        PG8_STAGE(PG8_SB(1, 0), cB + kstep, voffB); PG8_STAGE(PG8_SA(1, 0), cA + kstep, voffA); PG8_STAGE(PG8_SB(1, 1), cB + hstep + kstep, voffB);
        PG8_WAIT_V(6); PG8_BAR;
    }
    for (;;) {
        const bool has_next = S.next(ui + 1, nxt);
        const char* nA = has_next ? (const char*)g.A + (size_t)nxt.pm * tstep : cA; const char* nB = has_next ? (const char*)g.Bt + (size_t)nxt.pn * tstep : cB;
        for (int t = 0; t < nt; t += 2) {
            const bool last = (t == nt - 2);
            const char* a1 = cA + (size_t)(t + 1) * kstep;
            const char* a2 = last ? nA : cA + (size_t)(t + 2) * kstep; const char* b2 = last ? nB : cB + (size_t)(t + 2) * kstep;
            const char* a3 = a2 + kstep; const char* b3 = b2 + kstep;
            if (last && has_next) S.a_ready(nxt);
            if constexpr (SP2) {
            PG8_LDB(B0, 0, 0); PG8_LDB(B1, 0, 1); PG8_SCHED; PG8_LDA(At, 0, 0); PG8_STAGE(PG8_SA(1, 1), a1 + hstep, voffA);
            PG8_WAIT_V(8); PG8_WAIT_L(0); PG8_BAR; PG8_MMA(0, 0, At, B0); PG8_MMA(0, 1, At, B1); PG8_BAR; PG8_SCHED;
            PG8_LDA(At, 0, 1); PG8_STAGE(PG8_SB(0, 0), b2, voffB); PG8_STAGE(PG8_SB(0, 1), b2 + hstep, voffB); PG8_STAGE(PG8_SA(0, 0), a2, voffA);
            PG8_WAIT_V(8); PG8_WAIT_L(0); PG8_BAR; PG8_MMA(1, 0, At, B0); PG8_MMA(1, 1, At, B1); PG8_BAR; PG8_SCHED;
            PG8_LDB(B0, 1, 0); PG8_LDB(B1, 1, 1); PG8_SCHED; PG8_LDA(At, 1, 0); PG8_STAGE(PG8_SA(0, 1), a2 + hstep, voffA);
            PG8_WAIT_V(8); PG8_WAIT_L(0); PG8_BAR; PG8_MMA(0, 0, At, B0); PG8_MMA(0, 1, At, B1); PG8_BAR; PG8_SCHED;
            PG8_LDA(At, 1, 1); PG8_STAGE(PG8_SB(1, 0), b3, voffB); PG8_STAGE(PG8_SB(1, 1), b3 + hstep, voffB); PG8_STAGE(PG8_SA(1, 0), a3, voffA);
            PG8_WAIT_V(8); PG8_WAIT_L(0); PG8_BAR; PG8_MMA(1, 0, At, B0); PG8_MMA(1, 1, At, B1); PG8_BAR; PG8_SCHED;
            } else {
            PG8_LDB(B0, 0, 0); PG8_SCHED; PG8_LDA(At, 0, 0); PG8_STAGE(PG8_SA(1, 1), a1 + hstep, voffA);
            PG8_WAIT_L(8); PG8_BAR; PG8_WAIT_L(0); PG8_MMA(0, 0, At, B0); PG8_BAR; PG8_SCHED;
            PG8_LDB(B1, 0, 1); PG8_STAGE(PG8_SB(0, 0), b2, voffB);
            PG8_BAR; PG8_WAIT_L(0); PG8_MMA(0, 1, At, B1); PG8_BAR;
            PG8_LDA(At, 0, 1); PG8_STAGE(PG8_SA(0, 0), a2, voffA);
            PG8_BAR; PG8_WAIT_L(0); PG8_MMA(1, 0, At, B0); PG8_BAR; PG8_SCHED;
            PG8_STAGE(PG8_SB(0, 1), b2 + hstep, voffB);
            PG8_WAIT_V(6); PG8_BAR; PG8_MMA(1, 1, At, B1); PG8_BAR;
            PG8_LDB(B0, 1, 0); PG8_SCHED; PG8_LDA(At, 1, 0); PG8_STAGE(PG8_SA(0, 1), a2 + hstep, voffA);
            PG8_WAIT_L(8); PG8_BAR; PG8_WAIT_L(0); PG8_MMA(0, 0, At, B0); PG8_BAR; PG8_SCHED;
            PG8_LDB(B1, 1, 1); PG8_STAGE(PG8_SB(1, 0), b3, voffB);
            PG8_BAR; PG8_WAIT_L(0); PG8_MMA(0, 1, At, B1); PG8_BAR;
            PG8_LDA(At, 1, 1); PG8_STAGE(PG8_SA(1, 0), a3, voffA);
            PG8_BAR; PG8_WAIT_L(0); PG8_MMA(1, 0, At, B0); PG8_BAR; PG8_SCHED;
            PG8_STAGE(PG8_SB(1, 1), b3 + hstep, voffB);
            PG8_WAIT_V(6); PG8_BAR; PG8_MMA(1, 1, At, B1); PG8_BAR;
            }
        }
        if constexpr (ALIGN_EPI) { if (wr == 0) PG8_BAR; }
        if constexpr (!Epi::AFTER_DRAIN) { E(acc, cur, wr, wc, fr, fq); S.done(cur); }
        if (!has_next) break;
#pragma unroll
        for (int a = 0; a < 2; ++a)
#pragma unroll
            for (int b = 0; b < 2; ++b)
#pragma unroll
                for (int m = 0; m < 4; ++m)
#pragma unroll
                    for (int n = 0; n < 2; ++n) acc[a][b][m][n] = (f32x4){0.f, 0.f, 0.f, 0.f};
        cur = nxt; cA = nA; cB = nB; ++ui;
        if constexpr (ALIGN_EPI) { if (wr == 1) PG8_BAR; }
    }
    PG8_WAIT_V(0);
    if constexpr (!ALIGN_EPI) { if (wr == 0) PG8_BAR; }
    PG8_BAR;
    if constexpr (Epi::AFTER_DRAIN) { E.fused(acc, cur, wr, wc, fr, fq, lds, wid, lane); S.done(cur); }
#undef PG8_SA
#undef PG8_SB
#undef PG8_STAGE
#undef PG8_LDA
#undef PG8_LDB
#undef PG8_MMA
#undef PG8_WAIT_V
#undef PG8_WAIT_L
#undef PG8_BAR
#undef PG8_SCHED
}
}

namespace pg8 {
typedef unsigned u32x2 __attribute__((ext_vector_type(2)));
__device__ __forceinline__ float row_rstd(const float* rs, int row) {
    const f32x4* p = (const f32x4*)(rs + (size_t)row * 16);
    const f32x4 a = p[0], b = p[1], c = p[2], d = p[3];
    const float s = ((a[0] + a[1]) + (a[2] + a[3])) + ((b[0] + b[1]) + (b[2] + b[3])) + ((c[0] + c[1]) + (c[2] + c[3])) + ((d[0] + d[1]) + (d[2] + d[3]));
    return rsqrtf(s * (1.0f / 1024.0f) + 1e-6f);
}
struct EpiProj {
    static constexpr bool PERM = true, AFTER_DRAIN = false;
    bf16_t* O; int ldc; const float* rs; int ncols_store;
    __device__ __forceinline__ void operator()(const f32x4 (&acc)[2][2][4][2], const Unit& u, int wr, int wc, int fr, int fq) const {
        const int row0 = u.pm * BM + wr * 64 + fr, col0 = u.pn * BM + wc * 32 + 8 * fq;
#pragma unroll
        for (int ai = 0; ai < 2; ++ai)
#pragma unroll
            for (int m = 0; m < 4; ++m) {
                const int row = row0 + ai * HALF + m * 16;
                const float sc = rs ? row_rstd(rs, row) : 1.0f;
                bf16_t* rowp = O + (size_t)row * ldc + col0;
#pragma unroll
                for (int bj = 0; bj < 2; ++bj) {
                    if (col0 + bj * HALF < ncols_store) {
                        const f32x4 v0 = acc[ai][bj][m][0] * sc, v1 = acc[ai][bj][m][1] * sc;
                        u32x4 w; w.x = cvt_pk_bf16(v0[0], v0[1]); w.y = cvt_pk_bf16(v0[2], v0[3]); w.z = cvt_pk_bf16(v1[0], v1[1]); w.w = cvt_pk_bf16(v1[2], v1[3]);
                        *(u32x4*)(rowp + bj * HALF) = w;
                    }
                }
            }
    }
};
struct EpiHnew {
    static constexpr bool PERM = false, AFTER_DRAIN = false;
    float* H; bf16_t* HN; float* RS;
    __device__ __forceinline__ void operator()(const f32x4 (&acc)[2][2][4][2], const Unit& u, int wr, int wc, int fr, int fq) const {
        const int row0 = u.pm * BM + wr * 64 + fr, col0 = u.pn * BM + wc * 32 + 4 * fq;
#pragma unroll
        for (int ai = 0; ai < 2; ++ai)
#pragma unroll
            for (int m = 0; m < 4; ++m) {
                const int row = row0 + ai * HALF + m * 16;
                const size_t off = (size_t)row * 1024 + col0;
                float ss = 0.f;
#pragma unroll
                for (int bj = 0; bj < 2; ++bj)
#pragma unroll
                    for (int n = 0; n < 2; ++n) {
                        const f32x4 h4 = *(const f32x4*)(H + off + bj * HALF + n * 16);
                        const f32x4 v = h4 + acc[ai][bj][m][n];
                        *(f32x4*)(H + off + bj * HALF + n * 16) = v;
                        u32x2 w; w.x = cvt_pk_bf16(v[0], v[1]); w.y = cvt_pk_bf16(v[2], v[3]);
                        *(u32x2*)(HN + off + bj * HALF + n * 16) = w;
                        ss += (v[0] * v[0] + v[1] * v[1]) + (v[2] * v[2] + v[3] * v[3]);
                    }
                ss += __shfl_xor(ss, 16); ss += __shfl_xor(ss, 32);
                if (fq == 0) RS[(size_t)row * 16 + u.pn * 4 + wc] = ss;
            }
    }
};
struct EpiPle {
    static constexpr bool PERM = false, AFTER_DRAIN = false;
    float* H; bf16_t* HB; const float* RSi; float* RSo; const bf16_t* PPb;
    __device__ __forceinline__ void operator()(const f32x4 (&acc)[2][2][4][2], const Unit& u, int wr, int wc, int fr, int fq) const {
        const int row0 = u.pm * BM + wr * 64 + fr, col0 = u.pn * BM + wc * 32 + 4 * fq;
#pragma unroll
        for (int ai = 0; ai < 2; ++ai)
#pragma unroll
            for (int m = 0; m < 4; ++m) {
                const int row = row0 + ai * HALF + m * 16;
                const size_t off = (size_t)row * 1024 + col0;
                const float sc = row_rstd(RSi, row);
                float ss = 0.f;
#pragma unroll
                for (int bj = 0; bj < 2; ++bj)
#pragma unroll
                    for (int n = 0; n < 2; ++n) {
                        const f32x4 h4 = *(const f32x4*)(H + off + bj * HALF + n * 16);
                        const u32x2 pw = *(const u32x2*)(PPb + off + bj * HALF + n * 16);
                        const f32x4 a = acc[ai][bj][m][n] * sc;
                        f32x4 v;
                        v[0] = h4[0] + fast_sigmoid(a[0]) * __uint_as_float(pw.x << 16);
                        v[1] = h4[1] + fast_sigmoid(a[1]) * __uint_as_float(pw.x & 0xffff0000u);
                        v[2] = h4[2] + fast_sigmoid(a[2]) * __uint_as_float(pw.y << 16);
                        v[3] = h4[3] + fast_sigmoid(a[3]) * __uint_as_float(pw.y & 0xffff0000u);
                        *(f32x4*)(H + off + bj * HALF + n * 16) = v;
                        if (HB) { u32x2 w; w.x = cvt_pk_bf16(v[0], v[1]); w.y = cvt_pk_bf16(v[2], v[3]); *(u32x2*)(HB + off + bj * HALF + n * 16) = w; }
                        ss += (v[0] * v[0] + v[1] * v[1]) + (v[2] * v[2] + v[3] * v[3]);
                    }
                if (RSo) {
                    ss += __shfl_xor(ss, 16); ss += __shfl_xor(ss, 32);
                    if (fq == 0) RSo[(size_t)row * 16 + u.pn * 4 + wc] = ss;
                }
            }
    }
};
}

constexpr int GEMM_LDS = 147456;
struct GemmArgs { const bf16* A; const bf16* Bt; int M, N, K, mode; bf16* O16; float* H; const float* RSi; float* RSo; const bf16* PPb; };

__global__ void __launch_bounds__(512, 2) k_gemm_phase(GemmArgs a) {
    extern __shared__ __attribute__((aligned(16))) unsigned char lds[];
    pg8::Gemm g{a.A, a.Bt, a.M, a.N, a.K};
    pg8::StaticOrder S; S.init(a.M, a.N, gridDim.x, blockIdx.x);
    LAS unsigned char* l = (LAS unsigned char*)lds;
    if (a.mode == 0) { pg8::EpiProj E{a.O16, PP, a.RSi, PP}; pg8::gemm_phase<pg8::EpiProj, pg8::StaticOrder, true, true>(l, g, S, E); }
    else if (a.mode == 1) { pg8::EpiProj E{a.O16, 1024, nullptr, 1024}; pg8::gemm_phase<pg8::EpiProj, pg8::StaticOrder, true, true>(l, g, S, E); }
    else if (a.mode == 2) { pg8::EpiHnew E{a.H, a.O16, a.RSo}; pg8::gemm_phase<pg8::EpiHnew, pg8::StaticOrder, true, true>(l, g, S, E); }
    else { pg8::EpiPle E{a.H, a.O16, a.RSi, a.RSo, a.PPb}; pg8::gemm_phase<pg8::EpiPle, pg8::StaticOrder, true, true>(l, g, S, E); }
}

__device__ __forceinline__ int map_col(int n, int remap) { return (remap && n >= SRC_NGATE_END) ? n + 104 : n; }
__global__ void __launch_bounds__(256) k_transpose_w(const float* __restrict__ W, int K, int N, bf16* __restrict__ WT, const float* __restrict__ gk, int remap) {
    __shared__ float scr_all[4][64 * 33];
    const int lane = threadIdx.x & 63, wave = threadIdx.x >> 6;
    float* scr = scr_all[wave];
    const int nblk = (N + 31) / 32, nitems = (K / 64) * nblk;
    for (int item = blockIdx.x * 4 + wave; item < nitems; item += gridDim.x * 4) {
        const int kb = item / nblk, nb = item % nblk, k0 = 64 * kb, n0 = 32 * nb;
        for (int i = 0; i < 32; ++i) {
            const int kk = 2 * i + (lane >> 5), n = n0 + (lane & 31);
            float v = (n < N) ? W[(size_t)(k0 + kk) * N + n] : 0.f;
            if (gk) v *= gk[k0 + kk];
            scr[kk * 33 + (lane & 31)] = v;
        }
        asm volatile("s_waitcnt lgkmcnt(0)" ::: "memory");
        const int c = lane & 7;
        for (int j = 0; j < 4; ++j) {
            const int nl = (lane >> 3) + 8 * j, n = n0 + nl;
            if (n < N) {
                const float* s = scr + (8 * c) * 33 + nl;
                uint4 o; o.x = pk2(s[0 * 33], s[1 * 33]); o.y = pk2(s[2 * 33], s[3 * 33]); o.z = pk2(s[4 * 33], s[5 * 33]); o.w = pk2(s[6 * 33], s[7 * 33]);
                *(uint4*)(WT + (size_t)map_col(n, remap) * K + k0 + 8 * c) = o;
            }
        }
        asm volatile("s_waitcnt lgkmcnt(0)" ::: "memory");
    }
}
__global__ void __launch_bounds__(256) k_prep_x(const float* __restrict__ x, float* __restrict__ h, bf16* __restrict__ HB, float* __restrict__ RS) {
    const int lane = threadIdx.x & 63, row = blockIdx.x * 4 + (threadIdx.x >> 6);
    const float4* xr = (const float4*)(x + (size_t)row * D_MODEL) + lane;
    float4* hr = (float4*)(h + (size_t)row * D_MODEL) + lane;
    uint2* br = (uint2*)(HB + (size_t)row * D_MODEL) + lane;
    float ss = 0.f;
#pragma unroll
    for (int j = 0; j < 4; ++j) {
        const float4 v = xr[64 * j];
        hr[64 * j] = v;
        uint2 w; w.x = pk2(v.x, v.y); w.y = pk2(v.z, v.w); br[64 * j] = w;
        ss += (v.x * v.x + v.y * v.y) + (v.z * v.z + v.w * v.w);
    }
    for (int o = 32; o > 0; o >>= 1) ss += __shfl_xor(ss, o);
    if (lane < 16) RS[(size_t)row * 16 + lane] = (lane == 0) ? ss : 0.f;
}
__global__ void k_f32_to_bf16(const float* __restrict__ src, bf16* __restrict__ dst, int n4) {
    int i = blockIdx.x * blockDim.x + threadIdx.x;
    if (i >= n4) return;
    const float4 v = ((const float4*)src)[i];
    uint2 w; w.x = pk2(v.x, v.y); w.y = pk2(v.z, v.w);
    ((uint2*)dst)[i] = w;
}
__global__ void k_tables(const float* __restrict__ hgrn_lb, float* __restrict__ lb_all, float* __restrict__ ropec, float* __restrict__ ropes) {
    int i = blockIdx.x * blockDim.x + threadIdx.x;
    if (i < HG_W) {
        float v0 = hgrn_lb[i], v1 = hgrn_lb[HG_W + i], v2 = hgrn_lb[2 * HG_W + i], v3 = hgrn_lb[3 * HG_W + i];
        float m = fmaxf(fmaxf(v0, v1), fmaxf(v2, v3));
        v0 = expf(v0 - m); v1 = expf(v1 - m); v2 = expf(v2 - m); v3 = expf(v3 - m);
        float s = v0 + v1 + v2 + v3;
        lb_all[i] = 0.f; lb_all[HG_W + i] = v1 / s; lb_all[2 * HG_W + i] = v1 / s + v2 / s; lb_all[3 * HG_W + i] = v1 / s + v2 / s + v3 / s;
    }
    if (i < SEQ * 8) {
        int t = i >> 3, j = i & 7;
        double inv = pow(500000.0, -(double)(2 * j) / 16.0);
        double ang = (double)t * inv;
        ropec[i] = (float)cos(ang);
        ropes[i] = (float)sin(ang);
    }
}
namespace att {
using bf16x8 = __attribute__((ext_vector_type(8))) short;
using s16x4 = __attribute__((ext_vector_type(4))) short;
using f32x16 = __attribute__((ext_vector_type(16))) float;
using u32x4 = __attribute__((ext_vector_type(4))) unsigned;
constexpr int NW = 8, QBLK = 32, KVBLK = 64;
__device__ __forceinline__ int crow(int r, int hi) { return (r & 3) + 8 * (r >> 2) + 4 * hi; }
#define SBAR() __builtin_amdgcn_sched_barrier(0)
constexpr int NSLOT = 3, SLOTB = 8192;
constexpr int LDS_K = 0, LDS_V = NSLOT * SLOTB, LDS_WS = 2 * NSLOT * SLOTB, LDS_OST = LDS_WS + NW * 64 * 4, LDS_IMP = LDS_OST + NW * 4096, LDS_BYTES = LDS_IMP + 65536;
constexpr float C2 = 0.125f * 1.4426950408889634f;
__device__ __forceinline__ void glds16(const void* gsrc, unsigned lds_dst) { unsigned keep;
  asm volatile("s_mov_b32 %0, m0\n\ts_mov_b32 m0, %2\n\ts_nop 0\n\tglobal_load_lds_dwordx4 %1, off\n\ts_mov_b32 m0, %0" : "=&s"(keep) : "v"(gsrc), "s"(lds_dst) : "memory"); }
__device__ __forceinline__ float max3f(float a, float b, float c) { float r; asm("v_max3_f32 %0, %1, %2, %3" : "=v"(r) : "v"(a), "v"(b), "v"(c)); return r; }
__device__ __forceinline__ float max2f(float a, float b) { float r; asm("v_max_f32_e32 %0, %1, %2" : "=v"(r) : "v"(a), "v"(b)); return r; }
__device__ __forceinline__ float fadd_s(float a, float b) { float r; asm("v_add_f32_e32 %0, %1, %2" : "=v"(r) : "v"(a), "v"(b)); return r; }
__device__ __forceinline__ float fsub_s(float a, float b) { float r; asm("v_sub_f32_e32 %0, %1, %2" : "=v"(r) : "v"(a), "v"(b)); return r; }
typedef float f32x2_t __attribute__((ext_vector_type(2))); typedef __bf16 bf16x2_t __attribute__((ext_vector_type(2)));
__device__ __forceinline__ unsigned cvtpk_s(float lo, float hi) { f32x2_t v = {lo, hi}; bf16x2_t b = __builtin_convertvector(v, bf16x2_t); return __builtin_bit_cast(unsigned, b); }
#define WAIT_BAR(N) asm volatile("s_waitcnt vmcnt(" #N ") lgkmcnt(0)\n\ts_barrier" ::: "memory")

__device__ __forceinline__ void qkt(f32x16& p0, f32x16& p1, const char* Kslot, const bf16x8* qr, const f32x16& negm, int r32, int hi) {
  const char* kb = Kslot + hi * 1024 + r32 * 16;
#pragma unroll
  for (int d0 = 0; d0 < 4; ++d0) {
    const bf16x8 b0 = *reinterpret_cast<const bf16x8*>(kb + d0 * 2048);
    const bf16x8 b1 = *reinterpret_cast<const bf16x8*>(kb + d0 * 2048 + 512);
    if (d0 == 0) { p0 = __builtin_amdgcn_mfma_f32_32x32x16_bf16(b0, qr[0], negm, 0, 0, 0); p1 = __builtin_amdgcn_mfma_f32_32x32x16_bf16(b1, qr[0], negm, 0, 0, 0); }
    else { p0 = __builtin_amdgcn_mfma_f32_32x32x16_bf16(b0, qr[d0], p0, 0, 0, 0); p1 = __builtin_amdgcn_mfma_f32_32x32x16_bf16(b1, qr[d0], p1, 0, 0, 0); } }
}
typedef __attribute__((address_space(3))) const char* lds_cptr;
typedef short v4i16_t __attribute__((ext_vector_type(4)));
__device__ __forceinline__ void kload8(bf16x8* kf, lds_cptr kp) {
  kf[0] = *(const __attribute__((address_space(3))) bf16x8*)(kp);        kf[1] = *(const __attribute__((address_space(3))) bf16x8*)(kp + 512);
  kf[2] = *(const __attribute__((address_space(3))) bf16x8*)(kp + 2048); kf[3] = *(const __attribute__((address_space(3))) bf16x8*)(kp + 2560);
  kf[4] = *(const __attribute__((address_space(3))) bf16x8*)(kp + 4096); kf[5] = *(const __attribute__((address_space(3))) bf16x8*)(kp + 4608);
  kf[6] = *(const __attribute__((address_space(3))) bf16x8*)(kp + 6144); kf[7] = *(const __attribute__((address_space(3))) bf16x8*)(kp + 6656);
}
__device__ __forceinline__ void kload2(bf16x8* kf, lds_cptr kp, int j) { kf[2 * j] = *(const __attribute__((address_space(3))) bf16x8*)(kp + j * 2048); kf[2 * j + 1] = *(const __attribute__((address_space(3))) bf16x8*)(kp + j * 2048 + 512); }
__device__ __forceinline__ s16x4 vtr(lds_cptr p) { return __builtin_bit_cast(s16x4, __builtin_amdgcn_ds_read_tr16_b64_v4i16((__attribute__((address_space(3))) v4i16_t*)p)); }
__device__ __forceinline__ float rowmax(const f32x16& p0, const f32x16& p1) {
  float a = max3f(p0[0], p0[1], p1[0]), b = max3f(p0[2], p0[3], p1[1]); a = max3f(a, p1[2], p1[3]);
#pragma unroll
  for (int r = 4; r < 16; r += 4) { a = max3f(a, p0[r], p0[r + 1]); b = max3f(b, p0[r + 2], p0[r + 3]); a = max3f(a, p1[r], p1[r + 1]); b = max3f(b, p1[r + 2], p1[r + 3]); }
  const float m = max2f(a, b);
  auto rr = __builtin_amdgcn_permlane32_swap(__float_as_uint(m), __float_as_uint(m), false, false);
  return max2f(__uint_as_float(rr[0]), __uint_as_float(rr[1]));
}
__device__ __forceinline__ void pv(f32x16* o, int vb, bf16x8 pa0, bf16x8 pa1, bf16x8 pa2, bf16x8 pa3) {
#pragma unroll
  for (int d0 = 0; d0 < 2; ++d0) { s16x4 lo[4], hi[4];
#pragma unroll
    for (int ks = 0; ks < 4; ++ks) {
      asm volatile("ds_read_b64_tr_b16 %0,%1 offset:%c2" : "=&v"(lo[ks]) : "v"(vb), "i"(d0 * 4096 + ks * 1024) : "memory");
      asm volatile("ds_read_b64_tr_b16 %0,%1 offset:%c2" : "=&v"(hi[ks]) : "v"(vb), "i"(d0 * 4096 + ks * 1024 + 512) : "memory"); }
    asm volatile("s_waitcnt lgkmcnt(0)" ::: "memory"); SBAR();
#define PK(k) (bf16x8){lo[k][0], lo[k][1], lo[k][2], lo[k][3], hi[k][0], hi[k][1], hi[k][2], hi[k][3]}
    o[d0] = __builtin_amdgcn_mfma_f32_32x32x16_bf16(pa0, PK(0), o[d0], 0, 0, 0);
    o[d0] = __builtin_amdgcn_mfma_f32_32x32x16_bf16(pa1, PK(1), o[d0], 0, 0, 0);
    o[d0] = __builtin_amdgcn_mfma_f32_32x32x16_bf16(pa2, PK(2), o[d0], 0, 0, 0);
    o[d0] = __builtin_amdgcn_mfma_f32_32x32x16_bf16(pa3, PK(3), o[d0], 0, 0, 0);
#undef PK
  }
}
__device__ __forceinline__ void mask_gt(f32x16& p0, f32x16& p1, int thr, int hi) {
  const float NEG = -INFINITY; const int th = thr - 4 * hi;
#pragma unroll
  for (int r = 0; r < 16; ++r) { const int kc = (r & 3) + 8 * (r >> 2); if (kc > th) p0[r] = NEG; if (kc + 32 > th) p1[r] = NEG; }
}
__device__ __forceinline__ void mask_both(f32x16& p0, f32x16& p1, int tg, int tl, int hi) {
  const float NEG = -INFINITY; const int g = tg - 4 * hi, l = tl - 4 * hi;
#pragma unroll
  for (int r = 0; r < 16; ++r) { const int kc = (r & 3) + 8 * (r >> 2); if (kc > g || kc <= l) p0[r] = NEG; if (kc + 32 > g || kc + 32 <= l) p1[r] = NEG; }
}
struct AttnIO {
  bf16* P;
  const bf16* KC;
  const bf16* VC;
  bf16* Y;
  bf16* T2;
  unsigned long long* selmask;
  const float* ropec; const float* ropes;
  int pass;
};

template <int MODE, int THRL>
__device__ __forceinline__ void attn_unit(int b, int kvh, int qb, const AttnIO& io, char* shm) {
  const int tid = threadIdx.x, lane = tid & 63, r32 = lane & 31, hi = lane >> 5; const int wid = __builtin_amdgcn_readfirstlane(tid >> 6);
  const int head = kvh * 4 + (wid >> 1);
  const long rowbase = (long)b * SEQ; const int q0 = qb * 64 + (wid & 1) * 32;
  const int ql = (wid & 1) * 32 + r32;
  const int tq = qb * 64 + ql;
  const bf16* Qw = io.P + (rowbase + q0) * PP + C_NQ + head * 64;
  const bf16* Kh; const bf16* Vh; long kpitch, vpitch;
  if (MODE == 0) { Kh = io.P + rowbase * PP + C_KSL + kvh * 64; Vh = io.P + rowbase * PP + C_VSL + kvh * 64; kpitch = PP; vpitch = PP; }
  else if (MODE == 1) { Kh = io.P + rowbase * PP + C_KWN + kvh * 64; Vh = io.P + rowbase * PP + C_VWN + kvh * 64; kpitch = PP; vpitch = PP; }
  else { Kh = io.KC + (long)(b * KVH + kvh) * 256 * 64; Vh = (io.pass == 0) ? io.VC + (long)(b * KVH + kvh) * 256 * 64 : io.VC; kpitch = 64; vpitch = 64; }
  const int NTr = (MODE == 0) ? qb + 1 : (MODE == 1) ? ((qb < 8 ? qb : 8) + 1) : 4;
  const int NT = (NTr < 4) ? 4 : ((NTr + 1) & ~1);
#define MEMTILE(i) ((MODE == 0) ? ((i) < qb ? (i) : qb) : (MODE == 1) ? ((qb - (i)) > 0 ? (qb - (i)) : 0) : (i))
  const unsigned lds0 = (unsigned)(uintptr_t)shm;
  float* wsf = (float*)(shm + LDS_WS) + wid * 64;
  const bf16* ksrc = Kh + (long)lane * kpitch + wid * 8;
  const bf16* vsrc = Vh + (long)(16 * (wid & 3) + (lane >> 2)) * vpitch + (wid >> 2) * 32 + (lane & 3) * 8;
  const unsigned kdst = lds0 + LDS_K + wid * 1024, vdst = lds0 + LDS_V + wid * 1024;
#define DMA_K(t, slot) glds16(ksrc + (long)MEMTILE(t) * KVBLK * kpitch, (unsigned)__builtin_amdgcn_readfirstlane(kdst + (slot)))
#define DMA_V(t, slot) glds16(vsrc + (long)MEMTILE(t) * KVBLK * vpitch, (unsigned)__builtin_amdgcn_readfirstlane(vdst + (slot)))
  const int vb0 = (int)(lds0 + LDS_V) + ((lane >> 4) & 1) * 32 + (lane & 3) * 8 + (4 * hi + ((lane & 15) >> 2)) * 64;
  const char* Kbase = shm + LDS_K; bf16x8 kf[8];
  const lds_cptr shm3 = (lds_cptr)shm; const lds_cptr kp0 = shm3 + LDS_K + hi * 1024 + r32 * 16; const lds_cptr vp0 = shm3 + LDS_V + ((lane >> 4) & 1) * 32 + (lane & 3) * 8 + (4 * hi + ((lane & 15) >> 2)) * 64;
  DMA_K(0, 0); DMA_V(0, 0); DMA_K(1, SLOTB);
  bf16x8 qr[4];
#pragma unroll
  for (int d0 = 0; d0 < 4; ++d0) qr[d0] = *reinterpret_cast<const bf16x8*>(&Qw[(long)r32 * PP + d0 * 16 + hi * 8]);
  if (MODE != 2) {
    const u32x4 own = __builtin_bit_cast(u32x4, qr[0]);
    u32x4 par;
#pragma unroll
    for (int k = 0; k < 4; ++k) { auto rr = __builtin_amdgcn_permlane32_swap(own[k], own[k], false, false); par[k] = hi ? rr[0] : rr[1]; }
    const float4 c0 = *(const float4*)(io.ropec + (size_t)tq * 8), c1 = *(const float4*)(io.ropec + (size_t)tq * 8 + 4);
    const float4 s0 = *(const float4*)(io.ropes + (size_t)tq * 8), s1 = *(const float4*)(io.ropes + (size_t)tq * 8 + 4);
    const float cs[8] = {c0.x, c0.y, c0.z, c0.w, c1.x, c1.y, c1.z, c1.w}, sn[8] = {s0.x, s0.y, s0.z, s0.w, s1.x, s1.y, s1.z, s1.w};
    const float sg = hi ? 1.f : -1.f;
    u32x4 res;
#pragma unroll
    for (int k = 0; k < 4; ++k) {
      const float oa = __uint_as_float(own[k] << 16), ob = __uint_as_float(own[k] & 0xffff0000u);
      const float pa = __uint_as_float(par[k] << 16), pb = __uint_as_float(par[k] & 0xffff0000u);
      res[k] = cvtpk_s(oa * cs[2 * k] + sg * pa * sn[2 * k], ob * cs[2 * k + 1] + sg * pb * sn[2 * k + 1]);
    }
    qr[0] = __builtin_bit_cast(bf16x8, res);
  }
  unsigned mlo = 0xffffffffu, mhi_ = 0xffffffffu;
  if (MODE == 0) { const unsigned long long mk = io.selmask[(size_t)(b * KVH + kvh) * SEQ + tq]; mlo = (unsigned)mk; mhi_ = (unsigned)(mk >> 32); }
  int cmaxc = 0; if (MODE == 2) { cmaxc = (tq - 31) >> 4; if (cmaxc < 0) cmaxc = 0; }
  float mhat = 0.f, l_reg = 0.f; f32x16 o[2]; o[0] = f32x16{}; o[1] = f32x16{}; f32x16 negm = f32x16{}; asm volatile("" : "+v"(negm));
#define BMASK(P0, P1, t) do { \
    if (MODE == 0) { if ((t) >= qb) mask_gt(P0, P1, tq - 64 * (t), hi); } \
    else if (MODE == 1) { mask_both(P0, P1, ((t) == 0) ? ql : 1000, ((t) > qb) ? 1000 : ql + 64 * (t) - 512, hi); } \
    else { mask_gt(P0, P1, cmaxc - 64 * (t), hi); } } while (0)
#define NEGSEL(t) do { if (MODE == 0) { const int ti_ = ((t) < qb) ? (t) : qb; const unsigned w_ = (ti_ < 32) ? mlo : mhi_; const bool on_ = (w_ >> (ti_ & 31)) & 1u; \
      const float nm_ = on_ ? -mhat : -INFINITY; _Pragma("unroll") for (int r = 0; r < 16; ++r) negm[r] = nm_; asm volatile("" : "+v"(negm)); } } while (0)
  bool resc = false;
#define START(P0, P1) do { const float rm = rowmax(P0, P1); resc = false; \
    { const float dl = rm; mhat = fadd_s(mhat, dl); \
      _Pragma("unroll") for (int r = 0; r < 16; ++r) { P0[r] = fsub_s(P0[r], dl); P1[r] = fsub_s(P1[r], dl); } \
      _Pragma("unroll") for (int r = 0; r < 16; ++r) negm[r] = -mhat; asm volatile("" : "+v"(negm)); } \
    _Pragma("unroll") for (int r = 0; r < 16; ++r) P0[r] = __builtin_amdgcn_exp2f(P0[r]); } while (0)
#define RESC() do { if (resc) { asm volatile("s_waitcnt lgkmcnt(0)" ::: "memory"); \
      _Pragma("unroll") for (int d_ = 0; d_ < 2; ++d_) _Pragma("unroll") for (int r = 0; r < 16; ++r) o[d_][r] *= wsf[crow(r, hi)]; } } while (0)
  f32x16 pA0, pA1, pB0, pB1;
  int sl_prev = 0, sl_cur = 0, sl_next = SLOTB;
#define ROT() do { sl_prev = sl_cur; sl_cur = sl_next; sl_next = (sl_next == (NSLOT - 1) * SLOTB) ? 0 : sl_next + SLOTB; } while (0)
  DMA_K(2, 2 * SLOTB);
  WAIT_BAR(3);
  qkt(pA0, pA1, Kbase, qr, negm, r32, hi); asm volatile("s_nop 15\n\ts_nop 7" : "+v"(pA0), "+v"(pA1)); BMASK(pA0, pA1, 0);
  START(pA0, pA1);
  _Pragma("unroll") for (int r = 0; r < 16; ++r) pA1[r] = __builtin_amdgcn_exp2f(pA1[r]);
  WAIT_BAR(0);
  DMA_K(3, 0); DMA_V(1, SLOTB);
  ROT();
  kload8(kf, kp0 + sl_cur);
  WAIT_BAR(2);
  s16x4 vlo[8], vhi[8]; u32x4 pw0, pw1, pw2, pw3;
#define PKW(P, B) cvtpk_s(P[B], P[B + 1])
#define PAF(k) __builtin_bit_cast(bf16x8, pw##k)
#define VFR(i) (bf16x8){vlo[i][0], vlo[i][1], vlo[i][2], vlo[i][3], vhi[i][0], vhi[i][1], vhi[i][2], vhi[i][3]}
#define PIN(x) asm volatile("" : "+v"(x))
#define MX3(a, b, c) __builtin_fmaxf(__builtin_fmaxf((a), (b)), (c))
#define GAPA(MF, A0, A1, A2, A3, W0, W1, PW) do { MF; sacc += A0; sacc += A1; sacc += A2; sacc += A3; PIN(sacc); W0; W1; PIN(PW); SBAR(); } while (0)
#define EX(v) __builtin_amdgcn_exp2f(v)
#define GAPB(MF, X, B) do { MF; X[B] = EX(X[B]); X[B + 1] = EX(X[B + 1]); X[B + 2] = EX(X[B + 2]); X[B + 3] = EX(X[B + 3]); PIN(X); SBAR(); } while (0)
#define VRD(i) do { vlo[i] = vtr(vp_ + (((i) >> 2) * 4096 + ((i) & 3) * 1024)); vhi[i] = vtr(vp_ + (((i) >> 2) * 4096 + ((i) & 3) * 1024 + 512)); } while (0)
#define KRD(G, j) do { if (G) { kload2(kf, kp0 + sl_next, j); SBAR(); } } while (0)
#define STEP(C0, C1, P0, P1, t, GK, GV, GL, BAND) do { SBAR(); \
    NEGSEL(t); SBAR(); \
    const lds_cptr vp_ = vp0 + sl_prev; \
    VRD(0); SBAR(); float sacc = (P0[0] + P0[1]); \
    GAPA(C0 = __builtin_amdgcn_mfma_f32_32x32x16_bf16(kf[0], qr[0], negm, 0, 0, 0), P0[2], P0[3], P0[4], P0[5],     pw0[0] = PKW(P0, 0), pw0[1] = PKW(P0, 2), pw0); \
    VRD(4); SBAR(); GAPA(C1 = __builtin_amdgcn_mfma_f32_32x32x16_bf16(kf[1], qr[0], negm, 0, 0, 0), P0[6], P0[7], P0[8], P0[9],     pw0[2] = PKW(P0, 4), pw0[3] = PKW(P0, 6), pw0); \
    VRD(1); SBAR(); GAPA(C0 = __builtin_amdgcn_mfma_f32_32x32x16_bf16(kf[2], qr[1], C0, 0, 0, 0),   P0[10], P0[11], P0[12], P0[13], pw1[0] = PKW(P0, 8), pw1[1] = PKW(P0, 10), pw1); \
    VRD(5); SBAR(); GAPA(C1 = __builtin_amdgcn_mfma_f32_32x32x16_bf16(kf[3], qr[1], C1, 0, 0, 0),   P0[14], P0[15], P1[0], P1[1],   pw1[2] = PKW(P0, 12), pw1[3] = PKW(P0, 14), pw1); \
    VRD(2); SBAR(); GAPA(C0 = __builtin_amdgcn_mfma_f32_32x32x16_bf16(kf[4], qr[2], C0, 0, 0, 0),   P1[2], P1[3], P1[4], P1[5],     pw2[0] = PKW(P1, 0), pw2[1] = PKW(P1, 2), pw2); \
    VRD(6); SBAR(); GAPA(C1 = __builtin_amdgcn_mfma_f32_32x32x16_bf16(kf[5], qr[2], C1, 0, 0, 0),   P1[6], P1[7], P1[8], P1[9],     pw2[2] = PKW(P1, 4), pw2[3] = PKW(P1, 6), pw2); \
    VRD(3); SBAR(); GAPA(C0 = __builtin_amdgcn_mfma_f32_32x32x16_bf16(kf[6], qr[3], C0, 0, 0, 0),   P1[10], P1[11], P1[12], P1[13], pw3[0] = PKW(P1, 8), pw3[1] = PKW(P1, 10), pw3); \
    VRD(7); SBAR(); GAPA(C1 = __builtin_amdgcn_mfma_f32_32x32x16_bf16(kf[7], qr[3], C1, 0, 0, 0),   P1[14], P1[15], 0.f, 0.f,       pw3[2] = PKW(P1, 12), pw3[3] = PKW(P1, 14), pw3); \
    l_reg += sacc; \
    if (GK) { DMA_K((t) + 3, sl_cur); } if (GV) { DMA_V((t) + 1, sl_next); } \
    if (BAND) { BMASK(C0, C1, t); } \
    { float a = MX3(C0[0], C0[1], C1[0]), b = MX3(C0[2], C0[3], C1[1]); a = MX3(a, C1[2], C1[3]); \
      _Pragma("unroll") for (int r = 4; r < 16; r += 4) { a = MX3(a, C0[r], C0[r + 1]); b = MX3(b, C0[r + 2], C0[r + 3]); a = MX3(a, C1[r], C1[r + 1]); b = MX3(b, C1[r + 2], C1[r + 3]); } \
      float rm = __builtin_fmaxf(a, b); { auto rr = __builtin_amdgcn_permlane32_swap(__float_as_uint(rm), __float_as_uint(rm), false, false); rm = __builtin_fmaxf(__uint_as_float(rr[0]), __uint_as_float(rr[1])); } \
      resc = false; \
      if (__builtin_expect(__any(rm > (float)THRL), 0)) { const float dl = __builtin_fmaxf(rm, 0.f); mhat += dl; \
        _Pragma("unroll") for (int r = 0; r < 16; ++r) { C0[r] -= dl; C1[r] -= dl; } \
        _Pragma("unroll") for (int r = 0; r < 16; ++r) negm[r] = -mhat; asm volatile("" : "+v"(negm)); \
        const float f = __builtin_amdgcn_exp2f(-dl); l_reg *= f; if (hi == 0) wsf[r32] = f; resc = true; } } \
    SBAR(); \
    GAPB(o[0] = __builtin_amdgcn_mfma_f32_32x32x16_bf16(PAF(0), VFR(0), o[0], 0, 0, 0), C0, 0); \
    GAPB(o[1] = __builtin_amdgcn_mfma_f32_32x32x16_bf16(PAF(0), VFR(4), o[1], 0, 0, 0), C0, 4); \
    KRD(GL, 0); GAPB(o[0] = __builtin_amdgcn_mfma_f32_32x32x16_bf16(PAF(1), VFR(1), o[0], 0, 0, 0), C0, 8); \
    KRD(GL, 1); GAPB(o[1] = __builtin_amdgcn_mfma_f32_32x32x16_bf16(PAF(1), VFR(5), o[1], 0, 0, 0), C0, 12); \
    KRD(GL, 2); GAPB(o[0] = __builtin_amdgcn_mfma_f32_32x32x16_bf16(PAF(2), VFR(2), o[0], 0, 0, 0), C1, 0); \
    KRD(GL, 3); GAPB(o[1] = __builtin_amdgcn_mfma_f32_32x32x16_bf16(PAF(2), VFR(6), o[1], 0, 0, 0), C1, 4); \
    GAPB(o[0] = __builtin_amdgcn_mfma_f32_32x32x16_bf16(PAF(3), VFR(3), o[0], 0, 0, 0), C1, 8); \
    GAPB(o[1] = __builtin_amdgcn_mfma_f32_32x32x16_bf16(PAF(3), VFR(7), o[1], 0, 0, 0), C1, 12); \
    } while (0)
  int t = 1;
#pragma nounroll
  for (; t + 5 < NT; t += 2) {
    STEP(pB0, pB1, pA0, pA1, t, true, true, true, false);     WAIT_BAR(2); RESC(); ROT();
    STEP(pA0, pA1, pB0, pB1, t + 1, true, true, true, false); WAIT_BAR(2); RESC(); ROT();
  }
#define ENDW(tt) do { if ((tt) + 3 < NT) { WAIT_BAR(2); } else if ((tt) + 2 < NT) { WAIT_BAR(1); } else { WAIT_BAR(0); } } while (0)
#pragma nounroll
  for (; t + 1 < NT; t += 2) {
    STEP(pB0, pB1, pA0, pA1, t, (t + 3 < NT), (t + 1 < NT), (t + 1 < NT), true);       ENDW(t);     RESC(); ROT();
    STEP(pA0, pA1, pB0, pB1, t + 1, (t + 4 < NT), (t + 2 < NT), (t + 2 < NT), true);   ENDW(t + 1); RESC(); ROT();
  }
  STEP(pB0, pB1, pA0, pA1, NT - 1, false, false, false, true); RESC();
  { float sacc = pB0[0] + pB0[1]; _Pragma("unroll") for (int r = 2; r < 16; ++r) sacc += pB0[r]; _Pragma("unroll") for (int r = 0; r < 16; ++r) sacc += pB1[r]; l_reg += sacc;
    pw0 = (u32x4){PKW(pB0, 0), PKW(pB0, 2), PKW(pB0, 4), PKW(pB0, 6)}; pw1 = (u32x4){PKW(pB0, 8), PKW(pB0, 10), PKW(pB0, 12), PKW(pB0, 14)}; pw2 = (u32x4){PKW(pB1, 0), PKW(pB1, 2), PKW(pB1, 4), PKW(pB1, 6)}; pw3 = (u32x4){PKW(pB1, 8), PKW(pB1, 10), PKW(pB1, 12), PKW(pB1, 14)};
    SBAR(); pv(o, vb0 + sl_cur, PAF(0), PAF(1), PAF(2), PAF(3)); }
#undef PKW
#undef PAF
#undef VFR
#undef PIN
#undef MX3
#undef GAPA
#undef GAPB
#undef EX
#undef VRD
#undef KRD
#undef STEP
#undef ENDW
  { auto rr = __builtin_amdgcn_permlane32_swap(__float_as_uint(l_reg), __float_as_uint(l_reg), false, false); l_reg = __uint_as_float(rr[0]) + __uint_as_float(rr[1]); }
  if (hi == 0) wsf[32 + r32] = l_reg; asm volatile("s_waitcnt lgkmcnt(0)" ::: "memory");
  float rli[16];
#pragma unroll
  for (int r = 0; r < 16; ++r) rli[r] = __builtin_amdgcn_rcpf(wsf[32 + crow(r, hi)]);
  if (MODE == 2 && io.pass == 1) {
    float* imp = (float*)(shm + LDS_IMP) + ((wid >> 1) * 64 + (wid & 1) * 32) * 64;
#pragma unroll
    for (int r = 0; r < 16; ++r) { const int orow = crow(r, hi); const bool valid = (qb * 64 + (wid & 1) * 32 + orow) >= 31;
#pragma unroll
      for (int d0 = 0; d0 < 2; ++d0) imp[orow * 64 + d0 * 32 + r32] = valid ? o[d0][r] * rli[r] : 0.f; }
    asm volatile("s_waitcnt lgkmcnt(0)\n\ts_barrier" ::: "memory");
    const float* impb = (const float*)(shm + LDS_IMP);
    for (int k = 0; k < 8; ++k) {
      const int tl = wid * 8 + k, tt = qb * 64 + tl, cur = qb;
      float s = (impb[(0 * 64 + tl) * 64 + lane] + impb[(1 * 64 + tl) * 64 + lane]) + (impb[(2 * 64 + tl) * 64 + lane] + impb[(3 * 64 + tl) * 64 + lane]);
      const bool forced = (lane == 0) || (lane == cur) || (lane == cur - 1);
      s = forced ? 1e4f : ((lane <= cur) ? s : -1.0f);
      int rank = 0;
#pragma unroll
      for (int i = 0; i < 64; ++i) { const float si = __builtin_bit_cast(float, __builtin_amdgcn_readlane(__builtin_bit_cast(int, s), i)); rank += (si > s || (si == s && i < lane)) ? 1 : 0; }
      const unsigned long long m = __ballot(rank < 16);
      if (lane == 0) io.selmask[(size_t)(b * KVH + kvh) * SEQ + tt] = m;
    }
  } else {
    bf16* stg = (bf16*)(shm + LDS_OST) + wid * 2048;
#pragma unroll
    for (int r = 0; r < 16; ++r) { const int orow = crow(r, hi);
#pragma unroll
      for (int d0 = 0; d0 < 2; ++d0) stg[orow * 64 + d0 * 32 + r32] = (bf16)f2bf(o[d0][r] * rli[r]); }
    asm volatile("s_waitcnt lgkmcnt(0)" ::: "memory");
#pragma unroll
    for (int i = 0; i < 4; ++i) { const int row = i * 8 + (lane >> 3), ch = lane & 7;
      const u32x4 v = *(const u32x4*)(stg + row * 64 + ch * 8);
      const size_t grow = (size_t)(rowbase + q0 + row);
      const int tok = q0 + row;
      const bf16* pr = io.P + grow * PP;
      float ov[8];
#pragma unroll
      for (int k = 0; k < 4; ++k) { ov[2 * k] = __uint_as_float(v[k] << 16); ov[2 * k + 1] = __uint_as_float(v[k] & 0xffff0000u); }
      if (MODE == 2) {
        const float g0 = (tok >= 31) ? fast_sigmoid(bf2f(pr[C_NGATE + 0 * NSA_HEADS + head])) : 0.f;
        u32x4 w;
#pragma unroll
        for (int k = 0; k < 4; ++k) w[k] = cvtpk_s(g0 * ov[2 * k], g0 * ov[2 * k + 1]);
        *(u32x4*)(io.Y + grow * D_MODEL + HG_W + head * 64 + ch * 8) = w;
      } else if (MODE == 1) {
        const float g2 = fast_sigmoid(bf2f(pr[C_NGATE + 2 * NSA_HEADS + head]));
        u32x4 w;
#pragma unroll
        for (int k = 0; k < 4; ++k) w[k] = cvtpk_s(g2 * ov[2 * k], g2 * ov[2 * k + 1]);
        *(u32x4*)(io.T2 + grow * NSA_W + head * 64 + ch * 8) = w;
      } else {
        const float g1 = fast_sigmoid(bf2f(pr[C_NGATE + 1 * NSA_HEADS + head]));
        const u32x4 t1 = *(const u32x4*)(io.Y + grow * D_MODEL + HG_W + head * 64 + ch * 8);
        const u32x4 t2 = *(const u32x4*)(io.T2 + grow * NSA_W + head * 64 + ch * 8);
        const u32x4 nz = *(const u32x4*)(pr + C_NZ + head * 64 + ch * 8);
        u32x4 w;
#pragma unroll
        for (int k = 0; k < 4; ++k) {
          const float za = __uint_as_float(nz[k] << 16), zb = __uint_as_float(nz[k] & 0xffff0000u);
          const float ya = (__uint_as_float(t1[k] << 16) + __uint_as_float(t2[k] << 16) + g1 * ov[2 * k]) * za * fast_sigmoid(za);
          const float yb = (__uint_as_float(t1[k] & 0xffff0000u) + __uint_as_float(t2[k] & 0xffff0000u) + g1 * ov[2 * k + 1]) * zb * fast_sigmoid(zb);
          w[k] = cvtpk_s(ya, yb);
        }
        *(u32x4*)(io.Y + grow * D_MODEL + HG_W + head * 64 + ch * 8) = w;
      }
    }
  }
  asm volatile("s_waitcnt lgkmcnt(0)\n\ts_barrier" ::: "memory");
#undef DMA_K
#undef DMA_V
#undef MEMTILE
#undef BMASK
#undef NEGSEL
#undef START
#undef RESC
#undef ROT
}
#undef SBAR
#undef WAIT_BAR
}
namespace hg {
using bf16x8 = __attribute__((ext_vector_type(8))) short;
using f32x16 = __attribute__((ext_vector_type(16))) float;
constexpr int HG_NS = 4, HG_NG = SEQ / (64 * HG_NS);
constexpr int RS = 272;
constexpr int TS = 144;
constexpr int L_QD = 0, L_QR = L_QD + 64 * RS, L_KR = L_QR + 64 * RS, L_KDT = L_KR + 64 * RS, L_VT = L_KDT + 128 * TS, L_A = L_VT + 128 * TS,
              L_ST = L_A + 64 * TS, L_OST = L_ST + 128 * RS, L_BL = L_OST + 64 * RS, L_END = L_BL + 512;
__device__ __forceinline__ int crow(int r, int hi) { return (r & 3) + 8 * (r >> 2) + 4 * hi; }
__device__ __forceinline__ bf16x8 ldsfrag(const char* base, int row, int stride, int kbyte) { return *(const bf16x8*)(base + row * stride + kbyte); }
#define HG_MFMA(a, b, c) __builtin_amdgcn_mfma_f32_32x32x16_bf16(a, b, c, 0, 0, 0)

struct HgIO {
  const bf16* P; bf16* Y; const float* lb_l; const float* onorm_g;
  float* SLOC;
  float* DGL;
};

template <bool FULL>
__device__ __forceinline__ void chunk_prep(const HgIO& io, char* lds, size_t row, int h, int wid, int lane, const float* lbv, float* dgl) {
  const bf16* pr = io.P + row * PP;
  const uint4 f0 = *(const uint4*)(pr + C_HF + h * 128 + 16 * wid), f1 = *(const uint4*)(pr + C_HF + h * 128 + 16 * wid + 8);
  const uint4 v0 = *(const uint4*)(pr + C_HI + h * 128 + 16 * wid), v1 = *(const uint4*)(pr + C_HI + h * 128 + 16 * wid + 8);
  uint4 q0 = make_uint4(0, 0, 0, 0), q1 = q0;
  if (FULL) { q0 = *(const uint4*)(pr + C_HQ + h * 128 + 16 * wid); q1 = *(const uint4*)(pr + C_HQ + h * 128 + 16 * wid + 8); }
  const unsigned fw[8] = {f0.x, f0.y, f0.z, f0.w, f1.x, f1.y, f1.z, f1.w};
  const unsigned vw[8] = {v0.x, v0.y, v0.z, v0.w, v1.x, v1.y, v1.z, v1.w};
  const unsigned qw[8] = {q0.x, q0.y, q0.z, q0.w, q1.x, q1.y, q1.z, q1.w};
  float b[16], kk[16];
#pragma unroll
  for (int i = 0; i < 16; ++i) {
    const float fl = (i & 1) ? __uint_as_float(fw[i >> 1] & 0xffff0000u) : __uint_as_float(fw[i >> 1] << 16);
    const float sg = fast_sigmoid(fl);
    const float lb = lbv[i];
    const float f = lb + (1.f - lb) * sg;
    b[i] = __logf(f);
    kk[i] = (1.f - lb) * fast_sigmoid(-fl);
  }
#pragma unroll
  for (int o = 1; o < 64; o <<= 1) {
#pragma unroll
    for (int i = 0; i < 16; ++i) { const float t = __shfl_up(b[i], o); if (lane >= o) b[i] += t; }
  }
  float bl[16], rf[16];
#pragma unroll
  for (int i = 0; i < 16; ++i) { bl[i] = __shfl(b[i], 63); rf[i] = __shfl(b[i], 31); }
  if (lane == 63) {
    float* blp = (float*)(lds + L_BL) + 16 * wid;
#pragma unroll
    for (int i = 0; i < 16; ++i) { blp[i] = bl[i]; dgl[i] += bl[i]; }
  }
  unsigned short* kdt = (unsigned short*)(lds + L_KDT);
  unsigned short* vt = (unsigned short*)(lds + L_VT);
#pragma unroll
  for (int i = 0; i < 16; ++i) {
    const float kd = kk[i] * __expf(bl[i] - b[i]);
    kdt[(16 * wid + i) * (TS / 2) + lane] = (unsigned short)f2bf(kd);
    vt[(16 * wid + i) * (TS / 2) + lane] = (unsigned short)((i & 1) ? (vw[i >> 1] >> 16) : (vw[i >> 1] & 0xffffu));
  }
  if (FULL) {
    unsigned qd[8], qrr[8], krr[8];
#pragma unroll
    for (int i = 0; i < 16; i += 2) {
      const float qa = __uint_as_float(qw[i >> 1] << 16), qb = __uint_as_float(qw[i >> 1] & 0xffff0000u);
      qd[i >> 1] = pk2(qa * __expf(b[i]), qb * __expf(b[i + 1]));
      qrr[i >> 1] = pk2(qa * __expf(fminf(b[i] - rf[i], 80.f)), qb * __expf(fminf(b[i + 1] - rf[i + 1], 80.f)));
      krr[i >> 1] = pk2(kk[i] * __expf(fminf(rf[i] - b[i], 80.f)), kk[i + 1] * __expf(fminf(rf[i + 1] - b[i + 1], 80.f)));
    }
    uint4* dq = (uint4*)(lds + L_QD + lane * RS + 32 * wid);
    dq[0] = make_uint4(qd[0], qd[1], qd[2], qd[3]); dq[1] = make_uint4(qd[4], qd[5], qd[6], qd[7]);
    uint4* dr = (uint4*)(lds + L_QR + lane * RS + 32 * wid);
    dr[0] = make_uint4(qrr[0], qrr[1], qrr[2], qrr[3]); dr[1] = make_uint4(qrr[4], qrr[5], qrr[6], qrr[7]);
    uint4* dk = (uint4*)(lds + L_KR + lane * RS + 32 * wid);
    dk[0] = make_uint4(krr[0], krr[1], krr[2], krr[3]); dk[1] = make_uint4(krr[4], krr[5], krr[6], krr[7]);
  }
}

__device__ __forceinline__ void u_blocks(const char* lds, int wid, int l31, int hi, f32x16 (&u)[2]) {
  const int vb = wid & 3;
#pragma unroll
  for (int blk = 0; blk < 2; ++blk) {
    const int db = 2 * (wid >> 2) + blk;
    f32x16 acc = f32x16{};
#pragma unroll
    for (int ks = 0; ks < 4; ++ks) {
      const bf16x8 a = ldsfrag(lds + L_VT, vb * 32 + l31, TS, ks * 32 + hi * 16);
      const bf16x8 bb = ldsfrag(lds + L_KDT, db * 32 + l31, TS, ks * 32 + hi * 16);
      acc = HG_MFMA(a, bb, acc);
    }
    u[blk] = acc;
  }
}

__device__ __forceinline__ void hgrn_state_item(const HgIO& io, int item, char* lds) {
  const int tid = threadIdx.x, lane = tid & 63, l31 = lane & 31, hi = lane >> 5; const int wid = __builtin_amdgcn_readfirstlane(tid >> 6);
  const int bh = item / HG_NG, g = item % HG_NG, b = bh >> 2, h = bh & 3;
  float lbv[16];
#pragma unroll
  for (int i = 0; i < 16; ++i) lbv[i] = io.lb_l[h * 128 + 16 * wid + i];
  float dgl[16];
#pragma unroll
  for (int i = 0; i < 16; ++i) dgl[i] = 0.f;
  f32x16 S[2]; S[0] = f32x16{}; S[1] = f32x16{};
  for (int c = 0; c < HG_NS; ++c) {
    const size_t row = (size_t)b * SEQ + (size_t)(g * HG_NS + c) * 64 + lane;
    chunk_prep<false>(io, lds, row, h, wid, lane, lbv, dgl);
    __syncthreads();
    f32x16 u[2];
    u_blocks(lds, wid, l31, hi, u);
    const float* blp = (const float*)(lds + L_BL);
#pragma unroll
    for (int blk = 0; blk < 2; ++blk) {
      const float dec = __expf(blp[(2 * (wid >> 2) + blk) * 32 + l31]);
#pragma unroll
      for (int r = 0; r < 16; ++r) S[blk][r] = dec * S[blk][r] + u[blk][r];
    }
    __syncthreads();
  }
  float* dst = io.SLOC + ((size_t)(bh * HG_NG + g) * 8 + wid) * 2048;
#pragma unroll
  for (int blk = 0; blk < 2; ++blk)
#pragma unroll
    for (int r = 0; r < 16; ++r) dst[(blk * 16 + r) * 64 + lane] = S[blk][r];
  if (lane == 63) {
    float* dg = io.DGL + (size_t)(bh * HG_NG + g) * 128 + 16 * wid;
#pragma unroll
    for (int i = 0; i < 16; ++i) dg[i] = dgl[i];
  }
}

__device__ __forceinline__ void hgrn_scan_item(const HgIO& io, int item) {
  const int tid = threadIdx.x, bh = item >> 3, w = item & 7;
  float run[4] = {0.f, 0.f, 0.f, 0.f};
  for (int g = 0; g < HG_NG; ++g) {
    float* p = io.SLOC + ((size_t)(bh * HG_NG + g) * 8 + w) * 2048;
    const float* dg = io.DGL + (size_t)(bh * HG_NG + g) * 128;
#pragma unroll
    for (int k = 0; k < 4; ++k) {
      const int e = tid + 512 * k, blk = e >> 10, ln = e & 63;
      const int d = (2 * (w >> 2) + blk) * 32 + (ln & 31);
      const float loc = p[e];
      p[e] = run[k];
      run[k] = __expf(dg[d]) * run[k] + loc;
    }
  }
}

__device__ __forceinline__ void hgrn_out_item(const HgIO& io, int item, char* lds) {
  const int tid = threadIdx.x, lane = tid & 63, l31 = lane & 31, hi = lane >> 5; const int wid = __builtin_amdgcn_readfirstlane(tid >> 6);
  const int bh = item / HG_NG, g = item % HG_NG, b = bh >> 2, h = bh & 3;
  const int tb = wid >> 2, vb = wid & 3;
  float lbv[16];
#pragma unroll
  for (int i = 0; i < 16; ++i) lbv[i] = io.lb_l[h * 128 + 16 * wid + i];
  float dgl[16];
#pragma unroll
  for (int i = 0; i < 16; ++i) dgl[i] = 0.f;
  f32x16 S[2];
  {
    const float* src = io.SLOC + ((size_t)(bh * HG_NG + g) * 8 + wid) * 2048;
    unsigned short* st = (unsigned short*)(lds + L_ST);
#pragma unroll
    for (int blk = 0; blk < 2; ++blk)
#pragma unroll
      for (int r = 0; r < 16; ++r) {
        const float v = src[(blk * 16 + r) * 64 + lane];
        S[blk][r] = v;
        st[(vb * 32 + crow(r, hi)) * (RS / 2) + (2 * (wid >> 2) + blk) * 32 + l31] = (unsigned short)f2bf(v);
      }
  }
  for (int c = 0; c < HG_NS; ++c) {
    const size_t rowc = (size_t)b * SEQ + (size_t)(g * HG_NS + c) * 64;
    chunk_prep<true>(io, lds, rowc + lane, h, wid, lane, lbv, dgl);
    __syncthreads();
    f32x16 oacc = f32x16{};
#pragma unroll
    for (int ks = 0; ks < 8; ++ks) {
      const bf16x8 a = ldsfrag(lds + L_QD, tb * 32 + l31, RS, ks * 32 + hi * 16);
      const bf16x8 bb = ldsfrag(lds + L_ST, vb * 32 + l31, RS, ks * 32 + hi * 16);
      oacc = HG_MFMA(a, bb, oacc);
    }
    f32x16 u[2];
    u_blocks(lds, wid, l31, hi, u);
    if (wid < 3) {
      const int tb2 = (wid > 0) ? 1 : 0, sb2 = (wid == 2) ? 1 : 0;
      f32x16 a_acc = f32x16{};
#pragma unroll
      for (int ks = 0; ks < 8; ++ks) {
        const bf16x8 a = ldsfrag(lds + L_QR, tb2 * 32 + l31, RS, ks * 32 + hi * 16);
        const bf16x8 bb = ldsfrag(lds + L_KR, sb2 * 32 + l31, RS, ks * 32 + hi * 16);
        a_acc = HG_MFMA(a, bb, a_acc);
      }
      unsigned short* al = (unsigned short*)(lds + L_A);
#pragma unroll
      for (int r = 0; r < 16; ++r) {
        const int t = tb2 * 32 + crow(r, hi), s = sb2 * 32 + l31;
        al[t * (TS / 2) + s] = (unsigned short)f2bf((s <= t) ? a_acc[r] : 0.f);
      }
    }
    __syncthreads();
    for (int sb = 0; sb <= tb; ++sb) {
#pragma unroll
      for (int ks = 0; ks < 2; ++ks) {
        const bf16x8 a = ldsfrag(lds + L_A, tb * 32 + l31, TS, sb * 64 + ks * 32 + hi * 16);
        const bf16x8 bb = ldsfrag(lds + L_VT, vb * 32 + l31, TS, sb * 64 + ks * 32 + hi * 16);
        oacc = HG_MFMA(a, bb, oacc);
      }
    }
    {
      const float* blp = (const float*)(lds + L_BL);
      unsigned short* st = (unsigned short*)(lds + L_ST);
#pragma unroll
      for (int blk = 0; blk < 2; ++blk) {
        const int db = 2 * (wid >> 2) + blk;
        const float dec = __expf(blp[db * 32 + l31]);
#pragma unroll
        for (int r = 0; r < 16; ++r) {
          const float v = dec * S[blk][r] + u[blk][r];
          S[blk][r] = v;
          st[(vb * 32 + crow(r, hi)) * (RS / 2) + db * 32 + l31] = (unsigned short)f2bf(v);
        }
      }
      unsigned short* os = (unsigned short*)(lds + L_OST);
#pragma unroll
      for (int r = 0; r < 16; ++r) os[(tb * 32 + crow(r, hi)) * (RS / 2) + vb * 32 + l31] = (unsigned short)f2bf(oacc[r]);
    }
    __syncthreads();
    {
      const int t = tid >> 3, vc = tid & 7;
      const uint4 o0 = *(const uint4*)(lds + L_OST + t * RS + vc * 32), o1 = *(const uint4*)(lds + L_OST + t * RS + vc * 32 + 16);
      const unsigned ow[8] = {o0.x, o0.y, o0.z, o0.w, o1.x, o1.y, o1.z, o1.w};
      float ov[16]; float ss = 0.f;
#pragma unroll
      for (int k = 0; k < 8; ++k) { ov[2 * k] = __uint_as_float(ow[k] << 16); ov[2 * k + 1] = __uint_as_float(ow[k] & 0xffff0000u); ss += ov[2 * k] * ov[2 * k] + ov[2 * k + 1] * ov[2 * k + 1]; }
      ss += __shfl_xor(ss, 1); ss += __shfl_xor(ss, 2); ss += __shfl_xor(ss, 4);
      const float rstd = rsqrtf(ss * (1.0f / 128.0f) + RMS_EPS);
      const bf16* pr = io.P + (rowc + t) * PP;
      const uint4 g0 = *(const uint4*)(pr + C_HGO + h * 128 + vc * 16), g1 = *(const uint4*)(pr + C_HGO + h * 128 + vc * 16 + 8);
      const uint4 z0 = *(const uint4*)(pr + C_HZ + h * 128 + vc * 16), z1 = *(const uint4*)(pr + C_HZ + h * 128 + vc * 16 + 8);
      const unsigned gw[8] = {g0.x, g0.y, g0.z, g0.w, g1.x, g1.y, g1.z, g1.w};
      const unsigned zw[8] = {z0.x, z0.y, z0.z, z0.w, z1.x, z1.y, z1.z, z1.w};
      unsigned yw[8];
#pragma unroll
      for (int k = 0; k < 8; ++k) {
        const float ga = __uint_as_float(gw[k] << 16), gb = __uint_as_float(gw[k] & 0xffff0000u);
        const float za = __uint_as_float(zw[k] << 16), zb = __uint_as_float(zw[k] & 0xffff0000u);
        const float ya = ov[2 * k] * rstd * io.onorm_g[vc * 16 + 2 * k] * fast_sigmoid(ga) * za * fast_sigmoid(za);
        const float yb = ov[2 * k + 1] * rstd * io.onorm_g[vc * 16 + 2 * k + 1] * fast_sigmoid(gb) * zb * fast_sigmoid(zb);
        yw[k] = pk2(ya, yb);
      }
      uint4* yd = (uint4*)(io.Y + (rowc + t) * D_MODEL + h * 128 + vc * 16);
      yd[0] = make_uint4(yw[0], yw[1], yw[2], yw[3]); yd[1] = make_uint4(yw[4], yw[5], yw[6], yw[7]);
    }
  }
  __syncthreads();
}
#undef HG_MFMA
}
__global__ void __launch_bounds__(256) k_nsa_prep(bf16* __restrict__ P, const float* __restrict__ qg, const float* __restrict__ kg,
                                                 const float* __restrict__ ropec, const float* __restrict__ ropes) {
    int i = blockIdx.x * blockDim.x + threadIdx.x;
    if (i >= MROWS * 12) return;
    const int row = i / 12, u = i % 12, t = row % SEQ;
    bf16* src; const float* g;
    if (u < 8) { src = P + (size_t)row * PP + C_NQ + u * DH; g = qg; }
    else if (u < 10) { src = P + (size_t)row * PP + C_KSL + (u - 8) * DH; g = kg + 1 * DH; }
    else { src = P + (size_t)row * PP + C_KWN + (u - 10) * DH; g = kg + 2 * DH; }
    uint4 raw[8];
    float ss = 0.f;
#pragma unroll
    for (int c = 0; c < 8; ++c) {
        raw[c] = ((const uint4*)src)[c];
        const unsigned w[4] = {raw[c].x, raw[c].y, raw[c].z, raw[c].w};
#pragma unroll
        for (int k = 0; k < 4; ++k) { const float a = __uint_as_float(w[k] << 16), b = __uint_as_float(w[k] & 0xffff0000u); ss += a * a + b * b; }
    }
    float r = rsqrtf(ss * (1.0f / DH) + RMS_EPS);
    if (u < 8) { r *= 0.125f * 1.4426950408889634f; ((uint4*)src)[0] = raw[0]; }
    float v01[16];
#pragma unroll
    for (int c = 0; c < 8; ++c) {
        const unsigned w[4] = {raw[c].x, raw[c].y, raw[c].z, raw[c].w};
        float v[8];
#pragma unroll
        for (int k = 0; k < 4; ++k) { v[2 * k] = __uint_as_float(w[k] << 16) * r * g[c * 8 + 2 * k]; v[2 * k + 1] = __uint_as_float(w[k] & 0xffff0000u) * r * g[c * 8 + 2 * k + 1]; }
        uint4 o; o.x = pk2(v[0], v[1]); o.y = pk2(v[2], v[3]); o.z = pk2(v[4], v[5]); o.w = pk2(v[6], v[7]);
        if (c < 2 && u >= 8) {
#pragma unroll
            for (int k = 0; k < 8; ++k) v01[c * 8 + k] = v[k];
        } else {
            ((uint4*)src)[c] = o;
        }
    }
    if (u < 8) return;
    float ro[16];
#pragma unroll
    for (int j = 0; j < 8; ++j) {
        const float cs = ropec[t * 8 + j], sn = ropes[t * 8 + j];
        ro[j] = v01[j] * cs - v01[j + 8] * sn;
        ro[j + 8] = v01[j] * sn + v01[j + 8] * cs;
    }
    uint4 o0, o1;
    o0.x = pk2(ro[0], ro[1]); o0.y = pk2(ro[2], ro[3]); o0.z = pk2(ro[4], ro[5]); o0.w = pk2(ro[6], ro[7]);
    o1.x = pk2(ro[8], ro[9]); o1.y = pk2(ro[10], ro[11]); o1.z = pk2(ro[12], ro[13]); o1.w = pk2(ro[14], ro[15]);
    uint4* dst = (uint4*)src;
    dst[0] = o0; dst[1] = o1;
}

__global__ void __launch_bounds__(64) k_hgrn_scan(const bf16* __restrict__ Pb, const float* __restrict__ lb_l, float* __restrict__ o_raw) {
    int hv = blockIdx.x, hd = hv >> 7, lane = threadIdx.x;
    int c0 = hd * HG_DK + lane, c1 = c0 + 64;
    float lb0 = lb_l[c0], lb1 = lb_l[c1];
    float S0 = 0.f, S1 = 0.f;
    for (int t = 0; t < SEQ; ++t) {
        const bf16* pr = Pb + (size_t)t * PP;
        float fl0 = bf2f(pr[C_HF + c0]), fl1 = bf2f(pr[C_HF + c1]);
        float q0 = bf2f(pr[C_HQ + c0]), q1 = bf2f(pr[C_HQ + c1]);
        float v = bf2f(pr[C_HI + hv]);
        float f0 = lb0 + (1.f - lb0) * sigmoidf_(fl0), f1 = lb1 + (1.f - lb1) * sigmoidf_(fl1);
        float k0 = (1.f - lb0) * sigmoidf_(-fl0), k1 = (1.f - lb1) * sigmoidf_(-fl1);
        S0 = f0 * S0 + k0 * v;
        S1 = f1 * S1 + k1 * v;
        float part = q0 * S0 + q1 * S1;
        for (int o = 32; o > 0; o >>= 1) part += __shfl_xor(part, o);
        if (lane == 0) o_raw[(size_t)t * HG_W + hv] = part;
    }
}
__global__ void __launch_bounds__(512) k_hgrn_out(const float* __restrict__ o_raw, const bf16* __restrict__ Pb, const float* __restrict__ onorm_g, bf16* __restrict__ Yb) {
    __shared__ float red[8];
    int t = blockIdx.x, c = threadIdx.x;
    float v = o_raw[(size_t)t * HG_W + c];
    float ss = v * v;
    for (int o = 32; o > 0; o >>= 1) ss += __shfl_xor(ss, o);
    if ((c & 63) == 0) red[c >> 6] = ss;
    __syncthreads();
    int hd = c >> 7;
    float tot = red[hd * 2] + red[hd * 2 + 1];
    float r = rsqrtf(tot / (float)HG_DV + RMS_EPS);
    const bf16* pr = Pb + (size_t)t * PP;
    float o = v * r * onorm_g[c & 127];
    Yb[(size_t)t * D_MODEL + c] = (bf16)f2bf(o * sigmoidf_(bf2f(pr[C_HGO + c])) * siluf_(bf2f(pr[C_HZ + c])));
}
__global__ void k_cmp_hidden(const bf16* __restrict__ Pb, const float* __restrict__ pe, const float* __restrict__ w1, float* __restrict__ hid) {
    int i = blockIdx.x * blockDim.x + threadIdx.x;
    if (i >= 2 * KVH * NC * CMP_HIDDEN) return;
    int n = i % CMP_HIDDEN, c = (i / CMP_HIDDEN) % NC, g = (i / (CMP_HIDDEN * NC)) % KVH, kv = i / (CMP_HIDDEN * NC * KVH);
    int col = (kv == 0 ? C_KCM : C_VCM) + g * DH;
    const float* pek = pe + (size_t)kv * CMP_BLOCK * DH;
    const float* w = w1 + (size_t)kv * CMP_BLOCK * DH * CMP_HIDDEN;
    float acc = 0.f;
    for (int l = 0; l < CMP_BLOCK; ++l) {
        const bf16* pr = Pb + (size_t)(c * CMP_STRIDE + l) * PP + col;
        for (int j = 0; j < DH; ++j) acc = fmaf(bf2f(pr[j]) + pek[l * DH + j], w[(size_t)(l * DH + j) * CMP_HIDDEN + n], acc);
    }
    hid[i] = siluf_(acc);
}
__global__ void k_cmp_out(const float* __restrict__ hid, const float* __restrict__ w2, const float* __restrict__ kg0, float* __restrict__ kvc, bf16* __restrict__ KCb, bf16* __restrict__ VCb) {
    int i = blockIdx.x * blockDim.x + threadIdx.x;
    if (i >= 2 * KVH * NC) return;
    int kv = i / (KVH * NC);
    const float* hrow = hid + (size_t)i * CMP_HIDDEN;
    const float* w = w2 + (size_t)kv * CMP_HIDDEN * DH;
    float out[DH];
#pragma unroll
    for (int j = 0; j < DH; ++j) out[j] = 0.f;
    for (int n = 0; n < CMP_HIDDEN; ++n) {
        float hv = hrow[n];
#pragma unroll
        for (int j = 0; j < DH; ++j) out[j] = fmaf(hv, w[n * DH + j], out[j]);
    }
    float r = 1.f;
    if (kv == 0) {
        float ss = 0.f;
#pragma unroll
        for (int j = 0; j < DH; ++j) ss += out[j] * out[j];
        r = rsqrtf(ss / (float)DH + RMS_EPS);
    }
    const int g_ = (i / NC) % KVH, cc_ = i % NC;
    bf16* dst = (kv == 0 ? KCb : VCb) + ((size_t)g_ * 256 + cc_) * DH;
#pragma unroll
    for (int j = 0; j < DH; ++j) { const float v = (kv == 0) ? out[j] * r * kg0[j] : out[j]; kvc[(size_t)i * DH + j] = v; dst[j] = (bf16)f2bf(v); }
}
__global__ void k_cmp_consts(bf16* __restrict__ OV, bf16* __restrict__ KC, bf16* __restrict__ VC) {
    int i = blockIdx.x * blockDim.x + threadIdx.x;
    if (i < 256 * 64) {
        const int c = i >> 6, j = i & 63;
        float v = 0.f;
        if (c < NC) { const int j0 = (16 * c) >> 6, j1 = (16 * c + 31) >> 6; if (j0 == j1) v = (j == j0) ? 1.f : 0.f; else v = (j == j0 || j == j1) ? 0.5f : 0.f; }
        OV[i] = (bf16)f2bf(v);
    }
    if (i < BATCH * KVH * 64) { const int bg = i >> 6, j = i & 63; KC[((size_t)bg * 256 + 255) * 64 + j] = 0; VC[((size_t)bg * 256 + 255) * 64 + j] = 0; }
}
constexpr int ATT_LDS = 149504 + 256;
template <int MODE>
__global__ void __launch_bounds__(512, 2) k_attn(att::AttnIO io) {
    extern __shared__ __attribute__((aligned(16))) unsigned char lds[];
    const int c = blockIdx.x, bk = c >> 5, s = c & 31;
    att::attn_unit<MODE, 8>(bk >> 1, bk & 1, 63 - s, io, (char*)lds);
    att::attn_unit<MODE, 8>(bk >> 1, bk & 1, s, io, (char*)lds);
}
constexpr int HG_LDS = hg::L_END;
__global__ void __launch_bounds__(512, 2) k_hgrn_state(hg::HgIO io) {
    extern __shared__ __attribute__((aligned(16))) unsigned char lds[];
    hg::hgrn_state_item(io, blockIdx.x, (char*)lds);
}
__global__ void __launch_bounds__(512, 2) k_hgrn_scan2(hg::HgIO io) { hg::hgrn_scan_item(io, blockIdx.x); }
__global__ void __launch_bounds__(512, 2) k_hgrn_out2(hg::HgIO io) {
    extern __shared__ __attribute__((aligned(16))) unsigned char lds[];
    hg::hgrn_out_item(io, blockIdx.x, (char*)lds);
}
extern "C" void kernel_launch(void* const* d_in, const int* in_sizes, int n_in, void* d_out, int out_size, void* d_ws, size_t ws_size, hipStream_t stream) {
    const float* x = (const float*)d_in[0];
    const float* p = (const float*)d_in[1];
    const float* norm_g = (const float*)d_in[2];
    const float* w_in = (const float*)d_in[3];
    const float* hgrn_lb = (const float*)d_in[4];
    const float* hgrn_onorm_g = (const float*)d_in[5];
    const float* nsa_qnorm_g = (const float*)d_in[6];
    const float* nsa_knorm_g = (const float*)d_in[7];
    const float* cmp_pe = (const float*)d_in[8];
    const float* cmp_w1 = (const float*)d_in[9];
    const float* cmp_w2 = (const float*)d_in[10];
    const float* w_out = (const float*)d_in[11];
    const float* ple_norm_g = (const float*)d_in[12];
    const float* w_pg = (const float*)d_in[13];
    const float* w_pp = (const float*)d_in[14];
    float* h = (float*)d_out;
    unsigned char* ws = (unsigned char*)d_ws;
    constexpr size_t MiB = 1u << 20;
    bf16* WIN_T = (bf16*)(ws + 1 * MiB);
    bf16* WOUT_T = (bf16*)(ws + 10 * MiB);
    bf16* WPG_T = (bf16*)(ws + 12 * MiB);
    bf16* WPP_T = (bf16*)(ws + 14 * MiB);
    float* lb_all = (float*)(ws + 16 * MiB);
    float* ropec = lb_all + DEPTH * HG_W;
    float* ropes = ropec + SEQ * 8;
    float* RSA = (float*)(ws + 17 * MiB);
    float* RSB = (float*)(ws + 18 * MiB);
    bf16* BUF[2] = {(bf16*)(ws + 20 * MiB), (bf16*)(ws + 52 * MiB)};
    bf16* PB = (bf16*)(ws + 84 * MiB);
    bf16* T2 = (bf16*)(ws + 92 * MiB);
    bf16* P = (bf16*)(ws + 108 * MiB);
    bf16* PPb = P;
    float* misc = (float*)(ws + 248 * MiB);
    size_t off = 0;
    auto take = [&](size_t n) { float* r = misc + off; off += (n + 63) & ~(size_t)63; return r; };
    float* SLOC = take((size_t)16 * hg::HG_NG * 8 * 2048);
    float* DGL = take((size_t)16 * hg::HG_NG * 128);
    float* hid = take((size_t)2 * KVH * NC * CMP_HIDDEN);
    float* kvc = take((size_t)2 * KVH * NC * DH);
    unsigned long long* selmask = (unsigned long long*)take((size_t)BATCH * KVH * SEQ * 2);
    bf16* KC = (bf16*)take((size_t)BATCH * KVH * 256 * 64 / 2);
    bf16* VC = (bf16*)take((size_t)BATCH * KVH * 256 * 64 / 2);
    bf16* OV = (bf16*)take((size_t)256 * 64 / 2);
    if (248 * MiB + off * 4 > ws_size) { fprintf(stderr, "workspace too small: need %zu have %zu\n", 248 * MiB + off * 4, ws_size); return; }

    static bool attr_set = false;
    if (!attr_set) {
        (void)hipFuncSetAttribute((const void*)k_gemm_phase, hipFuncAttributeMaxDynamicSharedMemorySize, GEMM_LDS);
        (void)hipFuncSetAttribute((const void*)k_hgrn_state, hipFuncAttributeMaxDynamicSharedMemorySize, HG_LDS);
        (void)hipFuncSetAttribute((const void*)k_hgrn_out2, hipFuncAttributeMaxDynamicSharedMemorySize, HG_LDS);
        (void)hipFuncSetAttribute((const void*)k_attn<0>, hipFuncAttributeMaxDynamicSharedMemorySize, ATT_LDS);
        (void)hipFuncSetAttribute((const void*)k_attn<1>, hipFuncAttributeMaxDynamicSharedMemorySize, ATT_LDS);
        (void)hipFuncSetAttribute((const void*)k_attn<2>, hipFuncAttributeMaxDynamicSharedMemorySize, ATT_LDS);
        attr_set = true;
    }

    k_prep_x<<<MROWS / 4, 256, 0, stream>>>(x, h, BUF[0], RSB);
    k_tables<<<(SEQ * 8 + 255) / 256, 256, 0, stream>>>(hgrn_lb, lb_all, ropec, ropes);
    k_cmp_consts<<<64, 256, 0, stream>>>(OV, KC, VC);
    (void)hipMemsetAsync(WIN_T + (size_t)SRC_NGATE_END * D_MODEL, 0, (size_t)104 * D_MODEL * 2, stream);
    (void)hipMemsetAsync(WIN_T + (size_t)4480 * D_MODEL, 0, (size_t)128 * D_MODEL * 2, stream);

    int cur = 0;
    for (int i = 0; i < DEPTH; ++i) {
        k_transpose_w<<<512, 256, 0, stream>>>(w_in + (size_t)i * D_MODEL * IN_COLS, D_MODEL, IN_COLS, WIN_T, norm_g + i * D_MODEL, 1);
        k_transpose_w<<<256, 256, 0, stream>>>(w_out + (size_t)i * D_MODEL * D_MODEL, D_MODEL, D_MODEL, WOUT_T, nullptr, 0);
        k_transpose_w<<<256, 256, 0, stream>>>(w_pg + (size_t)i * D_MODEL * D_MODEL, D_MODEL, D_MODEL, WPG_T, ple_norm_g + i * D_MODEL, 0);
        k_transpose_w<<<128, 256, 0, stream>>>(w_pp + (size_t)i * PLE * D_MODEL, PLE, D_MODEL, WPP_T, nullptr, 0);
        k_f32_to_bf16<<<(MROWS * PLE / 4 + 255) / 256, 256, 0, stream>>>(p + (size_t)i * MROWS * PLE, PB, MROWS * PLE / 4);
        bf16* HB = BUF[cur];
        bf16* Y = BUF[cur ^ 1];
        { GemmArgs a{}; a.A = HB; a.Bt = WIN_T; a.M = MROWS; a.N = NPROJ; a.K = D_MODEL; a.mode = 0; a.O16 = P; a.RSi = RSB;
          k_gemm_phase<<<256, 512, GEMM_LDS, stream>>>(a); }
        k_nsa_prep<<<(MROWS * 12 + 255) / 256, 256, 0, stream>>>(P, nsa_qnorm_g + i * DH, nsa_knorm_g + (size_t)i * 3 * DH, ropec, ropes);
        for (int b = 0; b < BATCH; ++b) {
            const bf16* Pb = P + (size_t)b * SEQ * PP;
            k_cmp_hidden<<<(2 * KVH * NC * CMP_HIDDEN + 255) / 256, 256, 0, stream>>>(Pb, cmp_pe + (size_t)i * 2 * CMP_BLOCK * DH,
                                                                                      cmp_w1 + (size_t)i * 2 * CMP_BLOCK * DH * CMP_HIDDEN, hid);
            k_cmp_out<<<(2 * KVH * NC + 63) / 64, 64, 0, stream>>>(hid, cmp_w2 + (size_t)i * 2 * CMP_HIDDEN * DH, nsa_knorm_g + (size_t)i * 3 * DH, kvc,
                                                                  KC + (size_t)b * KVH * 256 * 64, VC + (size_t)b * KVH * 256 * 64);
        }
        { hg::HgIO hio{}; hio.P = P; hio.Y = Y; hio.lb_l = lb_all + i * HG_W; hio.onorm_g = hgrn_onorm_g + i * HG_DV; hio.SLOC = SLOC; hio.DGL = DGL;
          k_hgrn_state<<<256, 512, HG_LDS, stream>>>(hio);
          k_hgrn_scan2<<<128, 512, 0, stream>>>(hio);
          k_hgrn_out2<<<256, 512, HG_LDS, stream>>>(hio); }
        att::AttnIO io{}; io.P = P; io.KC = KC; io.VC = VC; io.Y = Y; io.T2 = T2; io.selmask = selmask; io.ropec = ropec; io.ropes = ropes; io.pass = 0;
        k_attn<2><<<256, 512, ATT_LDS, stream>>>(io);
        { att::AttnIO io1 = io; io1.VC = OV; io1.pass = 1; k_attn<2><<<256, 512, ATT_LDS, stream>>>(io1); }
        k_attn<1><<<256, 512, ATT_LDS, stream>>>(io);
        k_attn<0><<<256, 512, ATT_LDS, stream>>>(io);
        { GemmArgs a{}; a.A = PB; a.Bt = WPP_T; a.M = MROWS; a.N = D_MODEL; a.K = PLE; a.mode = 1; a.O16 = PPb;
          k_gemm_phase<<<256, 512, GEMM_LDS, stream>>>(a); }
        { GemmArgs a{}; a.A = Y; a.Bt = WOUT_T; a.M = MROWS; a.N = D_MODEL; a.K = D_MODEL; a.mode = 2; a.O16 = HB; a.H = h; a.RSo = RSA;
          k_gemm_phase<<<256, 512, GEMM_LDS, stream>>>(a); }
        { GemmArgs a{}; a.A = HB; a.Bt = WPG_T; a.M = MROWS; a.N = D_MODEL; a.K = D_MODEL; a.mode = 3; a.O16 = (i + 1 < DEPTH) ? Y : nullptr; a.H = h; a.RSi = RSA;
          a.RSo = (i + 1 < DEPTH) ? RSB : nullptr; a.PPb = PPb;
          k_gemm_phase<<<256, 512, GEMM_LDS, stream>>>(a); }
        cur ^= 1;
    }
}
```

```cpp
#include <hip/hip_runtime.h>
#include <stdint.h>
#include <cstdio>

constexpr int D_MODEL = 1024, BATCH = 4, SEQ = 4096, DEPTH = 4, MROWS = BATCH * SEQ;
constexpr int HG_HEADS = 4, HG_DK = 128, HG_DV = 128, HG_W = 512;
constexpr int NSA_HEADS = 8, KVH = 2, DH = 64, GRP = 4, NSA_W = 512, KV_W = 128;
constexpr int CMP_BLOCK = 32, CMP_STRIDE = 16, CMP_HIDDEN = 128, SLC_BLOCK = 64, SLC_TOPK = 16, WINDOW = 512;
constexpr int NC = (SEQ - CMP_BLOCK) / CMP_STRIDE + 1;
constexpr int NSB = SEQ / SLC_BLOCK;
constexpr int PLE = 256;
constexpr int IN_COLS = 4376;
constexpr int NPROJ = 4608;
constexpr int PP = 4480;
constexpr float RMS_EPS = 1e-6f;
constexpr int C_HQ = 0, C_HF = 512, C_HI = 1024, C_HGO = 1536, C_HZ = 2048, C_NQ = 2560, C_KCM = 3072, C_VCM = 3200,
              C_KSL = 3328, C_VSL = 3456, C_KWN = 3584, C_VWN = 3712, C_NGATE = 3840, C_NZ = 3968;
constexpr int SRC_NGATE_END = 3864;

typedef unsigned short bf16;
#define LAS __attribute__((address_space(3)))
__device__ __forceinline__ float bf2f(bf16 v) { return __uint_as_float((unsigned)v << 16); }
__device__ __forceinline__ unsigned f2bf(float f) { unsigned u = __float_as_uint(f); return (u + 0x7fffu + ((u >> 16) & 1u)) >> 16; }
__device__ __forceinline__ unsigned pk2(float lo, float hi) { return f2bf(lo) | (f2bf(hi) << 16); }
__device__ __forceinline__ float sigmoidf_(float x) { return 1.f / (1.f + expf(-x)); }
__device__ __forceinline__ float siluf_(float x) { return x * sigmoidf_(x); }
__device__ __forceinline__ float fast_sigmoid(float x) { return __builtin_amdgcn_rcpf(1.f + __builtin_amdgcn_exp2f(-1.4426950408889634f * x)); }

namespace pg8 {
#define PG8_LAS __attribute__((address_space(3)))
typedef unsigned short bf16_t;
typedef short bf16x8 __attribute__((ext_vector_type(8)));
typedef float f32x4 __attribute__((ext_vector_type(4)));
typedef unsigned u32x4 __attribute__((ext_vector_type(4)));
constexpr int BM = 256, BK = 64, HALF = 128, HTB = HALF * BK * 2  , STAGE_BYTES = 8 * HTB, NXCD = 8, WGM = 8;

__host__ __device__ __forceinline__ int lds_byte(int r, int c) { const int st = (r >> 4) * 2 + (c >> 5), rr = r & 15, cc = c & 31, ob = rr * 64 + cc * 2; return st * 1024 + (ob ^ (((ob >> 9) & 1) << 5)); }
__host__ __device__ __forceinline__ void stage_rc(int b, int& R, int& C) { const int st = b / 1024, sb = b % 1024, swz = sb ^ (((sb >> 9) & 1) << 5); R = (st >> 1) * 16 + swz / 64; C = (st & 1) * 32 + (swz % 64) / 2; }
__host__ __device__ __forceinline__ int perm32(int rho) { const int n = rho >> 4, i = rho & 15; return 8 * (i >> 2) + 4 * n + (i & 3); }

struct Unit { int pm, pn; };
struct Gemm { const bf16_t* A; const bf16_t* Bt; int M, N, K; };

struct StaticOrder {
    int nM, nN, nwg, G, c;
    __host__ __device__ void init(int M, int N, int G_, int c_) { nM = M / BM; nN = N / BM; nwg = nM * nN; G = G_; c = c_; }
    __host__ __device__ bool next(int i, Unit& u) const {
        const long L = (long)i * G + c; if (L >= nwg) return false;
        int wgid = (int)L; { const int q = nwg / NXCD, r = nwg % NXCD, xcd = wgid % NXCD, off = wgid / NXCD; wgid = (xcd < r ? xcd * (q + 1) : r * (q + 1) + (xcd - r) * q) + off; }
        const int nig = WGM * nN, gid = wgid / nig, fm = gid * WGM, gsz = (nM - fm) < WGM ? (nM - fm) : WGM;
        u.pm = fm + ((wgid % nig) % gsz); u.pn = (wgid % nig) / gsz; return true;
    }
    __device__ __forceinline__ void a_ready(const Unit&) const {}
    __device__ __forceinline__ void done(const Unit&) const {}
};

__device__ __forceinline__ unsigned cvt_pk_bf16(float lo, float hi) { unsigned r; asm volatile("v_cvt_pk_bf16_f32 %0, %1, %2" : "=v"(r) : "v"(lo), "v"(hi)); return r; }
template <class Epi, class Sched, bool ALIGN_EPI = false, bool SP2 = false>
__device__ __forceinline__ void gemm_phase(PG8_LAS unsigned char* lds, const Gemm g, const Sched& S, const Epi& E) {
    const int tid = threadIdx.x, wid = __builtin_amdgcn_readfirstlane(tid >> 6), lane = tid & 63, wr = wid >> 2, wc = wid & 3, fr = lane & 15, fq = lane >> 4;
    const int K = g.K, nt = K / BK;
    unsigned voffA[2], voffB[2];
#pragma unroll
    for (int i = 0; i < 2; ++i) { int R, C; stage_rc(tid * 16 + i * 8192, R, C); const int Rb = Epi::PERM ? ((R & ~31) + perm32(R & 31)) : R;
        voffA[i] = (unsigned)(R * K + C) * 2u; voffB[i] = (unsigned)(Rb * K + C) * 2u; }
    const size_t kstep = (size_t)(BK * 2);
    const size_t hstep = (size_t)HALF * K * 2;
    const size_t tstep = 2 * hstep;
    const unsigned ldsw = (unsigned)wid * 1024u;
    const int aoff = lds_byte(wr * 64 + fr, fq * 8), boff = lds_byte(wc * 32 + fr, fq * 8);
#define PG8_SA(b, h) (((b) * 2 + (h)) * HTB)
#define PG8_SB(b, h) ((4 + (b) * 2 + (h)) * HTB)
#define PG8_STAGE(bufoff, gbase, voff) do { _Pragma("unroll") for (int _i = 0; _i < 2; ++_i) \
        __builtin_amdgcn_global_load_lds((const unsigned*)((const char*)(gbase) + (voff)[_i]), (PG8_LAS unsigned*)(lds + (bufoff) + ldsw + _i * 8192), 16, 0, 0); } while (0)
#define PG8_LDA(dst, b, h) do { _Pragma("unroll") for (int m = 0; m < 4; ++m) _Pragma("unroll") for (int k = 0; k < 2; ++k) dst[m][k] = *(const PG8_LAS bf16x8*)(lds + PG8_SA(b, h) + aoff + m * 2048 + k * 1024); } while (0)
#define PG8_LDB(dst, b, h) do { _Pragma("unroll") for (int n = 0; n < 2; ++n) _Pragma("unroll") for (int k = 0; k < 2; ++k) dst[n][k] = *(const PG8_LAS bf16x8*)(lds + PG8_SB(b, h) + boff + n * 2048 + k * 1024); } while (0)
#define PG8_MMA(ai, bj, At, Bt) do { __builtin_amdgcn_s_setprio(1); _Pragma("unroll") for (int m = 0; m < 4; ++m) _Pragma("unroll") for (int n = 0; n < 2; ++n) _Pragma("unroll") for (int k = 0; k < 2; ++k) \
        acc[ai][bj][m][n] = __builtin_amdgcn_mfma_f32_16x16x32_bf16(Bt[n][k], At[m][k], acc[ai][bj][m][n], 0, 0, 0); __builtin_amdgcn_s_setprio(0); } while (0)
#define PG8_WAIT_V(n) asm volatile("s_waitcnt vmcnt(" #n ")" ::: "memory")
#define PG8_WAIT_L(n) asm volatile("s_waitcnt lgkmcnt(" #n ")" ::: "memory")
#define PG8_BAR __builtin_amdgcn_s_barrier()
#define PG8_SCHED __builtin_amdgcn_sched_barrier(0)
    Unit cur, nxt; int ui = 0;
    if (!S.next(0, cur)) return;
    f32x4 acc[2][2][4][2];
#pragma unroll
    for (int a = 0; a < 2; ++a)
#pragma unroll
        for (int b = 0; b < 2; ++b)
#pragma unroll
            for (int m = 0; m < 4; ++m)
#pragma unroll
                for (int n = 0; n < 2; ++n) acc[a][b][m][n] = (f32x4){0.f, 0.f, 0.f, 0.f};
    bf16x8 At[4][2], B0[2][2], B1[2][2];
    const char* cA = (const char*)g.A + (size_t)cur.pm * tstep; const char* cB = (const char*)g.Bt + (size_t)cur.pn * tstep;
    S.a_ready(cur);
    if constexpr (SP2) {
        PG8_STAGE(PG8_SB(0, 0), cB, voffB); PG8_STAGE(PG8_SB(0, 1), cB + hstep, voffB); PG8_STAGE(PG8_SA(0, 0), cA, voffA); PG8_STAGE(PG8_SA(0, 1), cA + hstep, voffA);
        if (wr == 1) PG8_BAR;
        PG8_WAIT_V(2); PG8_BAR;
        PG8_STAGE(PG8_SB(1, 0), cB + kstep, voffB); PG8_STAGE(PG8_SA(1, 0), cA + kstep, voffA); PG8_STAGE(PG8_SB(1, 1), cB + hstep + kstep, voffB);
        PG8_WAIT_V(6); PG8_BAR;
    } else {
        PG8_STAGE(PG8_SB(0, 0), cB, voffB); PG8_STAGE(PG8_SA(0, 0), cA, voffA); PG8_STAGE(PG8_SB(0, 1), cB + hstep, voffB); PG8_STAGE(PG8_SA(0, 1), cA + hstep, voffA);
        if (wr == 1) PG8_BAR;
        PG8_WAIT_V(4); PG8_BAR;
        PG8_STAGE(PG8_SB(1, 0), cB + kstep, voffB); PG8_STAGE(PG8_SA(1, 0), cA + kstep, voffA); PG8_STAGE(PG8_SB(1, 1), cB + hstep + kstep, voffB);
        PG8_WAIT_V(6); PG8_BAR;
    }
    for (;;) {
        const bool has_next = S.next(ui + 1, nxt);
        const char* nA = has_next ? (const char*)g.A + (size_t)nxt.pm * tstep : cA; const char* nB = has_next ? (const char*)g.Bt + (size_t)nxt.pn * tstep : cB;
        for (int t = 0; t < nt; t += 2) {
            const bool last = (t == nt - 2);
            const char* a1 = cA + (size_t)(t + 1) * kstep;
            const char* a2 = last ? nA : cA + (size_t)(t + 2) * kstep; const char* b2 = last ? nB : cB + (size_t)(t + 2) * kstep;
            const char* a3 = a2 + kstep; const char* b3 = b2 + kstep;
            if (last && has_next) S.a_ready(nxt);
            if constexpr (SP2) {
            PG8_LDB(B0, 0, 0); PG8_LDB(B1, 0, 1); PG8_SCHED; PG8_LDA(At, 0, 0); PG8_STAGE(PG8_SA(1, 1), a1 + hstep, voffA);
            PG8_WAIT_V(8); PG8_WAIT_L(0); PG8_BAR; PG8_MMA(0, 0, At, B0); PG8_MMA(0, 1, At, B1); PG8_BAR; PG8_SCHED;
            PG8_LDA(At, 0, 1); PG8_STAGE(PG8_SB(0, 0), b2, voffB); PG8_STAGE(PG8_SB(0, 1), b2 + hstep, voffB); PG8_STAGE(PG8_SA(0, 0), a2, voffA);
            PG8_WAIT_V(8); PG8_WAIT_L(0); PG8_BAR; PG8_MMA(1, 0, At, B0); PG8_MMA(1, 1, At, B1); PG8_BAR; PG8_SCHED;
            PG8_LDB(B0, 1, 0); PG8_LDB(B1, 1, 1); PG8_SCHED; PG8_LDA(At, 1, 0); PG8_STAGE(PG8_SA(0, 1), a2 + hstep, voffA);
            PG8_WAIT_V(8); PG8_WAIT_L(0); PG8_BAR; PG8_MMA(0, 0, At, B0); PG8_MMA(0, 1, At, B1); PG8_BAR; PG8_SCHED;
            PG8_LDA(At, 1, 1); PG8_STAGE(PG8_SB(1, 0), b3, voffB); PG8_STAGE(PG8_SB(1, 1), b3 + hstep, voffB); PG8_STAGE(PG8_SA(1, 0), a3, voffA);
            PG8_WAIT_V(8); PG8_WAIT_L(0); PG8_BAR; PG8_MMA(1, 0, At, B0); PG8_MMA(1, 1, At, B1); PG8_BAR; PG8_SCHED;
            } else {
            PG8_LDB(B0, 0, 0); PG8_SCHED; PG8_LDA(At, 0, 0); PG8_STAGE(PG8_SA(1, 1), a1 + hstep, voffA);
            PG8_WAIT_L(8); PG8_BAR; PG8_WAIT_L(0); PG8_MMA(0, 0, At, B0); PG8_BAR; PG8_SCHED;
            PG8_LDB(B1, 0, 1); PG8_STAGE(PG8_SB(0, 0), b2, voffB);
            PG8_BAR; PG8_WAIT_L(0); PG8_MMA(0, 1, At, B1); PG8_BAR;
            PG8_LDA(At, 0, 1); PG8_STAGE(PG8_SA(0, 0), a2, voffA);
            PG8_BAR; PG8_WAIT_L(0); PG8_MMA(1, 0, At, B0); PG8_BAR; PG8_SCHED;
            PG8_STAGE(PG8_SB(0, 1), b2 + hstep, voffB);
            PG8_WAIT_V(6); PG8_BAR; PG8_MMA(1, 1, At, B1); PG8_BAR;
            PG8_LDB(B0, 1, 0); PG8_SCHED; PG8_LDA(At, 1, 0); PG8_STAGE(PG8_SA(0, 1), a2 + hstep, voffA);
            PG8_WAIT_L(8); PG8_BAR; PG8_WAIT_L(0); PG8_MMA(0, 0, At, B0); PG8_BAR; PG8_SCHED;
            PG8_LDB(B1, 1, 1); PG8_STAGE(PG8_SB(1, 0), b3, voffB);
            PG8_BAR; PG8_WAIT_L(0); PG8_MMA(0, 1, At, B1); PG8_BAR;
            PG8_LDA(At, 1, 1); PG8_STAGE(PG8_SA(1, 0), a3, voffA);
            PG8_BAR; PG8_WAIT_L(0); PG8_MMA(1, 0, At, B0); PG8_BAR; PG8_SCHED;
            PG8_STAGE(PG8_SB(1, 1), b3 + hstep, voffB);
            PG8_WAIT_V(6); PG8_BAR; PG8_MMA(1, 1, At, B1); PG8_BAR;
            }
        }
        if constexpr (ALIGN_EPI) { if (wr == 0) PG8_BAR; }
        if constexpr (!Epi::AFTER_DRAIN) { E(acc, cur, wr, wc, fr, fq); S.done(cur); }
        if (!has_next) break;
#pragma unroll
        for (int a = 0; a < 2; ++a)
#pragma unroll
            for (int b = 0; b < 2; ++b)
#pragma unroll
                for (int m = 0; m < 4; ++m)
#pragma unroll
                    for (int n = 0; n < 2; ++n) acc[a][b][m][n] = (f32x4){0.f, 0.f, 0.f, 0.f};
        cur = nxt; cA = nA; cB = nB; ++ui;
        if constexpr (ALIGN_EPI) { if (wr == 1) PG8_BAR; }
    }
    PG8_WAIT_V(0);
    if constexpr (!ALIGN_EPI) { if (wr == 0) PG8_BAR; }
    PG8_BAR;
    if constexpr (Epi::AFTER_DRAIN) { E.fused(acc, cur, wr, wc, fr, fq, lds, wid, lane); S.done(cur); }
#undef PG8_SA
#undef PG8_SB
#undef PG8_STAGE
#undef PG8_LDA
#undef PG8_LDB
#undef PG8_MMA
#undef PG8_WAIT_V
#undef PG8_WAIT_L
#undef PG8_BAR
#undef PG8_SCHED
}
}

namespace pg8 {
typedef unsigned u32x2 __attribute__((ext_vector_type(2)));
__device__ __forceinline__ float row_rstd(const float* rs, int row) {
    const f32x4* p = (const f32x4*)(rs + (size_t)row * 16);
    const f32x4 a = p[0], b = p[1], c = p[2], d = p[3];
    const float s = ((a[0] + a[1]) + (a[2] + a[3])) + ((b[0] + b[1]) + (b[2] + b[3])) + ((c[0] + c[1]) + (c[2] + c[3])) + ((d[0] + d[1]) + (d[2] + d[3]));
    return rsqrtf(s * (1.0f / 1024.0f) + 1e-6f);
}
struct EpiProj {
    static constexpr bool PERM = true, AFTER_DRAIN = false;
    bf16_t* O; int ldc; const float* rs; int ncols_store;
    __device__ __forceinline__ void operator()(const f32x4 (&acc)[2][2][4][2], const Unit& u, int wr, int wc, int fr, int fq) const {
        const int row0 = u.pm * BM + wr * 64 + fr, col0 = u.pn * BM + wc * 32 + 8 * fq;
#pragma unroll
        for (int ai = 0; ai < 2; ++ai)
#pragma unroll
            for (int m = 0; m < 4; ++m) {
                const int row = row0 + ai * HALF + m * 16;
                const float sc = rs ? row_rstd(rs, row) : 1.0f;
                bf16_t* rowp = O + (size_t)row * ldc + col0;
#pragma unroll
                for (int bj = 0; bj < 2; ++bj) {
                    if (col0 + bj * HALF < ncols_store) {
                        const f32x4 v0 = acc[ai][bj][m][0] * sc, v1 = acc[ai][bj][m][1] * sc;
                        u32x4 w; w.x = cvt_pk_bf16(v0[0], v0[1]); w.y = cvt_pk_bf16(v0[2], v0[3]); w.z = cvt_pk_bf16(v1[0], v1[1]); w.w = cvt_pk_bf16(v1[2], v1[3]);
                        *(u32x4*)(rowp + bj * HALF) = w;
                    }
                }
            }
    }
};
struct EpiHnew {
    static constexpr bool PERM = false, AFTER_DRAIN = false;
    float* H; bf16_t* HN; float* RS;
    __device__ __forceinline__ void operator()(const f32x4 (&acc)[2][2][4][2], const Unit& u, int wr, int wc, int fr, int fq) const {
        const int row0 = u.pm * BM + wr * 64 + fr, col0 = u.pn * BM + wc * 32 + 4 * fq;
#pragma unroll
        for (int ai = 0; ai < 2; ++ai)
#pragma unroll
            for (int m = 0; m < 4; ++m) {
                const int row = row0 + ai * HALF + m * 16;
                const size_t off = (size_t)row * 1024 + col0;
                float ss = 0.f;
#pragma unroll
                for (int bj = 0; bj < 2; ++bj)
#pragma unroll
                    for (int n = 0; n < 2; ++n) {
                        const f32x4 h4 = *(const f32x4*)(H + off + bj * HALF + n * 16);
                        const f32x4 v = h4 + acc[ai][bj][m][n];
                        *(f32x4*)(H + off + bj * HALF + n * 16) = v;
                        u32x2 w; w.x = cvt_pk_bf16(v[0], v[1]); w.y = cvt_pk_bf16(v[2], v[3]);
                        *(u32x2*)(HN + off + bj * HALF + n * 16) = w;
                        ss += (v[0] * v[0] + v[1] * v[1]) + (v[2] * v[2] + v[3] * v[3]);
                    }
                ss += __shfl_xor(ss, 16); ss += __shfl_xor(ss, 32);
                if (fq == 0) RS[(size_t)row * 16 + u.pn * 4 + wc] = ss;
            }
    }
};
struct EpiPle {
    static constexpr bool PERM = false, AFTER_DRAIN = false;
    float* H; bf16_t* HB; const float* RSi; float* RSo; const bf16_t* PPb;
    __device__ __forceinline__ void operator()(const f32x4 (&acc)[2][2][4][2], const Unit& u, int wr, int wc, int fr, int fq) const {
        const int row0 = u.pm * BM + wr * 64 + fr, col0 = u.pn * BM + wc * 32 + 4 * fq;
#pragma unroll
        for (int ai = 0; ai < 2; ++ai)
#pragma unroll
            for (int m = 0; m < 4; ++m) {
                const int row = row0 + ai * HALF + m * 16;
                const size_t off = (size_t)row * 1024 + col0;
                const float sc = row_rstd(RSi, row);
                float ss = 0.f;
#pragma unroll
                for (int bj = 0; bj < 2; ++bj)
#pragma unroll
                    for (int n = 0; n < 2; ++n) {
                        const f32x4 h4 = *(const f32x4*)(H + off + bj * HALF + n * 16);
                        const u32x2 pw = *(const u32x2*)(PPb + off + bj * HALF + n * 16);
                        const f32x4 a = acc[ai][bj][m][n] * sc;
                        f32x4 v;
                        v[0] = h4[0] + fast_sigmoid(a[0]) * __uint_as_float(pw.x << 16);
                        v[1] = h4[1] + fast_sigmoid(a[1]) * __uint_as_float(pw.x & 0xffff0000u);
                        v[2] = h4[2] + fast_sigmoid(a[2]) * __uint_as_float(pw.y << 16);
                        v[3] = h4[3] + fast_sigmoid(a[3]) * __uint_as_float(pw.y & 0xffff0000u);
                        *(f32x4*)(H + off + bj * HALF + n * 16) = v;
                        if (HB) { u32x2 w; w.x = cvt_pk_bf16(v[0], v[1]); w.y = cvt_pk_bf16(v[2], v[3]); *(u32x2*)(HB + off + bj * HALF + n * 16) = w; }
                        ss += (v[0] * v[0] + v[1] * v[1]) + (v[2] * v[2] + v[3] * v[3]);
                    }
                if (RSo) {
                    ss += __shfl_xor(ss, 16); ss += __shfl_xor(ss, 32);
                    if (fq == 0) RSo[(size_t)row * 16 + u.pn * 4 + wc] = ss;
                }
            }
    }
};
}

constexpr int GEMM_LDS = 147456;
struct GemmArgs { const bf16* A; const bf16* Bt; int M, N, K, mode; bf16* O16; float* H; const float* RSi; float* RSo; const bf16* PPb; };

__global__ void __launch_bounds__(512, 2) k_gemm_phase(GemmArgs a) {
    extern __shared__ __attribute__((aligned(16))) unsigned char lds[];
    pg8::Gemm g{a.A, a.Bt, a.M, a.N, a.K};
    pg8::StaticOrder S; S.init(a.M, a.N, gridDim.x, blockIdx.x);
    LAS unsigned char* l = (LAS unsigned char*)lds;
    if (a.mode == 0) { pg8::EpiProj E{a.O16, PP, a.RSi, PP}; pg8::gemm_phase<pg8::EpiProj, pg8::StaticOrder, true, true>(l, g, S, E); }
    else if (a.mode == 1) { pg8::EpiProj E{a.O16, 1024, nullptr, 1024}; pg8::gemm_phase<pg8::EpiProj, pg8::StaticOrder, true, true>(l, g, S, E); }
    else if (a.mode == 2) { pg8::EpiHnew E{a.H, a.O16, a.RSo}; pg8::gemm_phase<pg8::EpiHnew, pg8::StaticOrder, true, true>(l, g, S, E); }
    else { pg8::EpiPle E{a.H, a.O16, a.RSi, a.RSo, a.PPb}; pg8::gemm_phase<pg8::EpiPle, pg8::StaticOrder, true, true>(l, g, S, E); }
}

__device__ __forceinline__ int map_col(int n, int remap) { return (remap && n >= SRC_NGATE_END) ? n + 104 : n; }
__global__ void __launch_bounds__(256) k_transpose_w(const float* __restrict__ W, int K, int N, bf16* __restrict__ WT, const float* __restrict__ gk, int remap) {
    __shared__ float scr_all[4][64 * 33];
    const int lane = threadIdx.x & 63, wave = threadIdx.x >> 6;
    float* scr = scr_all[wave];
    const int nblk = (N + 31) / 32, nitems = (K / 64) * nblk;
    for (int item = blockIdx.x * 4 + wave; item < nitems; item += gridDim.x * 4) {
        const int kb = item / nblk, nb = item % nblk, k0 = 64 * kb, n0 = 32 * nb;
        for (int i = 0; i < 32; ++i) {
            const int kk = 2 * i + (lane >> 5), n = n0 + (lane & 31);
            float v = (n < N) ? W[(size_t)(k0 + kk) * N + n] : 0.f;
            if (gk) v *= gk[k0 + kk];
            scr[kk * 33 + (lane & 31)] = v;
        }
        asm volatile("s_waitcnt lgkmcnt(0)" ::: "memory");
        const int c = lane & 7;
        for (int j = 0; j < 4; ++j) {
            const int nl = (lane >> 3) + 8 * j, n = n0 + nl;
            if (n < N) {
                const float* s = scr + (8 * c) * 33 + nl;
                uint4 o; o.x = pk2(s[0 * 33], s[1 * 33]); o.y = pk2(s[2 * 33], s[3 * 33]); o.z = pk2(s[4 * 33], s[5 * 33]); o.w = pk2(s[6 * 33], s[7 * 33]);
                *(uint4*)(WT + (size_t)map_col(n, remap) * K + k0 + 8 * c) = o;
            }
        }
        asm volatile("s_waitcnt lgkmcnt(0)" ::: "memory");
    }
}
__global__ void __launch_bounds__(256) k_prep_x(const float* __restrict__ x, float* __restrict__ h, bf16* __restrict__ HB, float* __restrict__ RS) {
    const int lane = threadIdx.x & 63, row = blockIdx.x * 4 + (threadIdx.x >> 6);
    const float4* xr = (const float4*)(x + (size_t)row * D_MODEL) + lane;
    float4* hr = (float4*)(h + (size_t)row * D_MODEL) + lane;
    uint2* br = (uint2*)(HB + (size_t)row * D_MODEL) + lane;
    float ss = 0.f;
#pragma unroll
    for (int j = 0; j < 4; ++j) {
        const float4 v = xr[64 * j];
        hr[64 * j] = v;
        uint2 w; w.x = pk2(v.x, v.y); w.y = pk2(v.z, v.w); br[64 * j] = w;
        ss += (v.x * v.x + v.y * v.y) + (v.z * v.z + v.w * v.w);
    }
    for (int o = 32; o > 0; o >>= 1) ss += __shfl_xor(ss, o);
    if (lane < 16) RS[(size_t)row * 16 + lane] = (lane == 0) ? ss : 0.f;
}
__global__ void k_f32_to_bf16(const float* __restrict__ src, bf16* __restrict__ dst, int n4) {
    int i = blockIdx.x * blockDim.x + threadIdx.x;
    if (i >= n4) return;
    const float4 v = ((const float4*)src)[i];
    uint2 w; w.x = pk2(v.x, v.y); w.y = pk2(v.z, v.w);
    ((uint2*)dst)[i] = w;
}
__global__ void k_tables(const float* __restrict__ hgrn_lb, float* __restrict__ lb_all, float* __restrict__ ropec, float* __restrict__ ropes) {
    int i = blockIdx.x * blockDim.x + threadIdx.x;
    if (i < HG_W) {
        float v0 = hgrn_lb[i], v1 = hgrn_lb[HG_W + i], v2 = hgrn_lb[2 * HG_W + i], v3 = hgrn_lb[3 * HG_W + i];
        float m = fmaxf(fmaxf(v0, v1), fmaxf(v2, v3));
        v0 = expf(v0 - m); v1 = expf(v1 - m); v2 = expf(v2 - m); v3 = expf(v3 - m);
        float s = v0 + v1 + v2 + v3;
        lb_all[i] = 0.f; lb_all[HG_W + i] = v1 / s; lb_all[2 * HG_W + i] = v1 / s + v2 / s; lb_all[3 * HG_W + i] = v1 / s + v2 / s + v3 / s;
    }
    if (i < SEQ * 8) {
        int t = i >> 3, j = i & 7;
        double inv = pow(500000.0, -(double)(2 * j) / 16.0);
        double ang = (double)t * inv;
        ropec[i] = (float)cos(ang);
        ropes[i] = (float)sin(ang);
    }
}
namespace att {
using bf16x8 = __attribute__((ext_vector_type(8))) short;
using s16x4 = __attribute__((ext_vector_type(4))) short;
using f32x16 = __attribute__((ext_vector_type(16))) float;
using u32x4 = __attribute__((ext_vector_type(4))) unsigned;
constexpr int NW = 8, QBLK = 32, KVBLK = 64;
__device__ __forceinline__ int crow(int r, int hi) { return (r & 3) + 8 * (r >> 2) + 4 * hi; }
#define SBAR() __builtin_amdgcn_sched_barrier(0)
constexpr int NSLOT = 3, SLOTB = 8192;
constexpr int LDS_K = 0, LDS_V = NSLOT * SLOTB, LDS_WS = 2 * NSLOT * SLOTB, LDS_OST = LDS_WS + NW * 64 * 4, LDS_IMP = LDS_OST + NW * 4096, LDS_BYTES = LDS_IMP + 65536;
constexpr float C2 = 0.125f * 1.4426950408889634f;
__device__ __forceinline__ void glds16(const void* gsrc, unsigned lds_dst) { unsigned keep;
  asm volatile("s_mov_b32 %0, m0\n\ts_mov_b32 m0, %2\n\ts_nop 0\n\tglobal_load_lds_dwordx4 %1, off\n\ts_mov_b32 m0, %0" : "=&s"(keep) : "v"(gsrc), "s"(lds_dst) : "memory"); }
__device__ __forceinline__ float max3f(float a, float b, float c) { float r; asm("v_max3_f32 %0, %1, %2, %3" : "=v"(r) : "v"(a), "v"(b), "v"(c)); return r; }
__device__ __forceinline__ float max2f(float a, float b) { float r; asm("v_max_f32_e32 %0, %1, %2" : "=v"(r) : "v"(a), "v"(b)); return r; }
__device__ __forceinline__ float fadd_s(float a, float b) { float r; asm("v_add_f32_e32 %0, %1, %2" : "=v"(r) : "v"(a), "v"(b)); return r; }
__device__ __forceinline__ float fsub_s(float a, float b) { float r; asm("v_sub_f32_e32 %0, %1, %2" : "=v"(r) : "v"(a), "v"(b)); return r; }
typedef float f32x2_t __attribute__((ext_vector_type(2))); typedef __bf16 bf16x2_t __attribute__((ext_vector_type(2)));
__device__ __forceinline__ unsigned cvtpk_s(float lo, float hi) { f32x2_t v = {lo, hi}; bf16x2_t b = __builtin_convertvector(v, bf16x2_t); return __builtin_bit_cast(unsigned, b); }
#define WAIT_BAR(N) asm volatile("s_waitcnt vmcnt(" #N ") lgkmcnt(0)\n\ts_barrier" ::: "memory")

__device__ __forceinline__ void qkt(f32x16& p0, f32x16& p1, const char* Kslot, const bf16x8* qr, const f32x16& negm, int r32, int hi) {
  const char* kb = Kslot + hi * 1024 + r32 * 16;
#pragma unroll
  for (int d0 = 0; d0 < 4; ++d0) {
    const bf16x8 b0 = *reinterpret_cast<const bf16x8*>(kb + d0 * 2048);
    const bf16x8 b1 = *reinterpret_cast<const bf16x8*>(kb + d0 * 2048 + 512);
    if (d0 == 0) { p0 = __builtin_amdgcn_mfma_f32_32x32x16_bf16(b0, qr[0], negm, 0, 0, 0); p1 = __builtin_amdgcn_mfma_f32_32x32x16_bf16(b1, qr[0], negm, 0, 0, 0); }
    else { p0 = __builtin_amdgcn_mfma_f32_32x32x16_bf16(b0, qr[d0], p0, 0, 0, 0); p1 = __builtin_amdgcn_mfma_f32_32x32x16_bf16(b1, qr[d0], p1, 0, 0, 0); } }
}
typedef __attribute__((address_space(3))) const char* lds_cptr;
typedef short v4i16_t __attribute__((ext_vector_type(4)));
__device__ __forceinline__ void kload8(bf16x8* kf, lds_cptr kp) {
  kf[0] = *(const __attribute__((address_space(3))) bf16x8*)(kp);        kf[1] = *(const __attribute__((address_space(3))) bf16x8*)(kp + 512);
  kf[2] = *(const __attribute__((address_space(3))) bf16x8*)(kp + 2048); kf[3] = *(const __attribute__((address_space(3))) bf16x8*)(kp + 2560);
  kf[4] = *(const __attribute__((address_space(3))) bf16x8*)(kp + 4096); kf[5] = *(const __attribute__((address_space(3))) bf16x8*)(kp + 4608);
  kf[6] = *(const __attribute__((address_space(3))) bf16x8*)(kp + 6144); kf[7] = *(const __attribute__((address_space(3))) bf16x8*)(kp + 6656);
}
__device__ __forceinline__ void kload2(bf16x8* kf, lds_cptr kp, int j) { kf[2 * j] = *(const __attribute__((address_space(3))) bf16x8*)(kp + j * 2048); kf[2 * j + 1] = *(const __attribute__((address_space(3))) bf16x8*)(kp + j * 2048 + 512); }
__device__ __forceinline__ s16x4 vtr(lds_cptr p) { return __builtin_bit_cast(s16x4, __builtin_amdgcn_ds_read_tr16_b64_v4i16((__attribute__((address_space(3))) v4i16_t*)p)); }
__device__ __forceinline__ float rowmax(const f32x16& p0, const f32x16& p1) {
  float a = max3f(p0[0], p0[1], p1[0]), b = max3f(p0[2], p0[3], p1[1]); a = max3f(a, p1[2], p1[3]);
#pragma unroll
  for (int r = 4; r < 16; r += 4) { a = max3f(a, p0[r], p0[r + 1]); b = max3f(b, p0[r + 2], p0[r + 3]); a = max3f(a, p1[r], p1[r + 1]); b = max3f(b, p1[r + 2], p1[r + 3]); }
  const float m = max2f(a, b);
  auto rr = __builtin_amdgcn_permlane32_swap(__float_as_uint(m), __float_as_uint(m), false, false);
  return max2f(__uint_as_float(rr[0]), __uint_as_float(rr[1]));
}
__device__ __forceinline__ void pv(f32x16* o, int vb, bf16x8 pa0, bf16x8 pa1, bf16x8 pa2, bf16x8 pa3) {
#pragma unroll
  for (int d0 = 0; d0 < 2; ++d0) { s16x4 lo[4], hi[4];
#pragma unroll
    for (int ks = 0; ks < 4; ++ks) {
      asm volatile("ds_read_b64_tr_b16 %0,%1 offset:%c2" : "=&v"(lo[ks]) : "v"(vb), "i"(d0 * 4096 + ks * 1024) : "memory");
      asm volatile("ds_read_b64_tr_b16 %0,%1 offset:%c2" : "=&v"(hi[ks]) : "v"(vb), "i"(d0 * 4096 + ks * 1024 + 512) : "memory"); }
    asm volatile("s_waitcnt lgkmcnt(0)" ::: "memory"); SBAR();
#define PK(k) (bf16x8){lo[k][0], lo[k][1], lo[k][2], lo[k][3], hi[k][0], hi[k][1], hi[k][2], hi[k][3]}
    o[d0] = __builtin_amdgcn_mfma_f32_32x32x16_bf16(pa0, PK(0), o[d0], 0, 0, 0);
    o[d0] = __builtin_amdgcn_mfma_f32_32x32x16_bf16(pa1, PK(1), o[d0], 0, 0, 0);
    o[d0] = __builtin_amdgcn_mfma_f32_32x32x16_bf16(pa2, PK(2), o[d0], 0, 0, 0);
    o[d0] = __builtin_amdgcn_mfma_f32_32x32x16_bf16(pa3, PK(3), o[d0], 0, 0, 0);
#undef PK
  }
}
__device__ __forceinline__ void mask_gt(f32x16& p0, f32x16& p1, int thr, int hi) {
  const float NEG = -INFINITY; const int th = thr - 4 * hi;
#pragma unroll
  for (int r = 0; r < 16; ++r) { const int kc = (r & 3) + 8 * (r >> 2); if (kc > th) p0[r] = NEG; if (kc + 32 > th) p1[r] = NEG; }
}
__device__ __forceinline__ void mask_both(f32x16& p0, f32x16& p1, int tg, int tl, int hi) {
  const float NEG = -INFINITY; const int g = tg - 4 * hi, l = tl - 4 * hi;
#pragma unroll
  for (int r = 0; r < 16; ++r) { const int kc = (r & 3) + 8 * (r >> 2); if (kc > g || kc <= l) p0[r] = NEG; if (kc + 32 > g || kc + 32 <= l) p1[r] = NEG; }
}
struct AttnIO {
  bf16* P;
  const bf16* KC;
  const bf16* VC;
  bf16* Y;
  bf16* T2;
  unsigned long long* selmask;
  const float* ropec; const float* ropes;
  int pass;
};

template <int MODE, int THRL>
__device__ __forceinline__ void attn_unit(int b, int kvh, int qb, const AttnIO& io, char* shm) {
  const int tid = threadIdx.x, lane = tid & 63, r32 = lane & 31, hi = lane >> 5; const int wid = __builtin_amdgcn_readfirstlane(tid >> 6);
  const int head = kvh * 4 + (wid >> 1);
  const long rowbase = (long)b * SEQ; const int q0 = qb * 64 + (wid & 1) * 32;
  const int ql = (wid & 1) * 32 + r32;
  const int tq = qb * 64 + ql;
  const bf16* Qw = io.P + (rowbase + q0) * PP + C_NQ + head * 64;
  const bf16* Kh; const bf16* Vh; long kpitch, vpitch;
  if (MODE == 0) { Kh = io.P + rowbase * PP + C_KSL + kvh * 64; Vh = io.P + rowbase * PP + C_VSL + kvh * 64; kpitch = PP; vpitch = PP; }
  else if (MODE == 1) { Kh = io.P + rowbase * PP + C_KWN + kvh * 64; Vh = io.P + rowbase * PP + C_VWN + kvh * 64; kpitch = PP; vpitch = PP; }
  else { Kh = io.KC + (long)(b * KVH + kvh) * 256 * 64; Vh = (io.pass == 0) ? io.VC + (long)(b * KVH + kvh) * 256 * 64 : io.VC; kpitch = 64; vpitch = 64; }
  const int NTr = (MODE == 0) ? qb + 1 : (MODE == 1) ? ((qb < 8 ? qb : 8) + 1) : 4;
  const int NT = (NTr < 4) ? 4 : ((NTr + 1) & ~1);
#define MEMTILE(i) ((MODE == 0) ? ((i) < qb ? (i) : qb) : (MODE == 1) ? ((qb - (i)) > 0 ? (qb - (i)) : 0) : (i))
  const unsigned lds0 = (unsigned)(uintptr_t)shm;
  float* wsf = (float*)(shm + LDS_WS) + wid * 64;
  const bf16* ksrc = Kh + (long)lane * kpitch + wid * 8;
  const bf16* vsrc = Vh + (long)(16 * (wid & 3) + (lane >> 2)) * vpitch + (wid >> 2) * 32 + (lane & 3) * 8;
  const unsigned kdst = lds0 + LDS_K + wid * 1024, vdst = lds0 + LDS_V + wid * 1024;
#define DMA_K(t, slot) glds16(ksrc + (long)MEMTILE(t) * KVBLK * kpitch, (unsigned)__builtin_amdgcn_readfirstlane(kdst + (slot)))
#define DMA_V(t, slot) glds16(vsrc + (long)MEMTILE(t) * KVBLK * vpitch, (unsigned)__builtin_amdgcn_readfirstlane(vdst + (slot)))
  const int vb0 = (int)(lds0 + LDS_V) + ((lane >> 4) & 1) * 32 + (lane & 3) * 8 + (4 * hi + ((lane & 15) >> 2)) * 64;
  const char* Kbase = shm + LDS_K; bf16x8 kf[8];
  const lds_cptr shm3 = (lds_cptr)shm; const lds_cptr kp0 = shm3 + LDS_K + hi * 1024 + r32 * 16; const lds_cptr vp0 = shm3 + LDS_V + ((lane >> 4) & 1) * 32 + (lane & 3) * 8 + (4 * hi + ((lane & 15) >> 2)) * 64;
  DMA_K(0, 0); DMA_V(0, 0); DMA_K(1, SLOTB);
  bf16x8 qr[4];
#pragma unroll
  for (int d0 = 0; d0 < 4; ++d0) qr[d0] = *reinterpret_cast<const bf16x8*>(&Qw[(long)r32 * PP + d0 * 16 + hi * 8]);
  if (MODE != 2) {
    const u32x4 own = __builtin_bit_cast(u32x4, qr[0]);
    u32x4 par;
#pragma unroll
    for (int k = 0; k < 4; ++k) { auto rr = __builtin_amdgcn_permlane32_swap(own[k], own[k], false, false); par[k] = hi ? rr[0] : rr[1]; }
    const float4 c0 = *(const float4*)(io.ropec + (size_t)tq * 8), c1 = *(const float4*)(io.ropec + (size_t)tq * 8 + 4);
    const float4 s0 = *(const float4*)(io.ropes + (size_t)tq * 8), s1 = *(const float4*)(io.ropes + (size_t)tq * 8 + 4);
    const float cs[8] = {c0.x, c0.y, c0.z, c0.w, c1.x, c1.y, c1.z, c1.w}, sn[8] = {s0.x, s0.y, s0.z, s0.w, s1.x, s1.y, s1.z, s1.w};
    const float sg = hi ? 1.f : -1.f;
    u32x4 res;
#pragma unroll
    for (int k = 0; k < 4; ++k) {
      const float oa = __uint_as_float(own[k] << 16), ob = __uint_as_float(own[k] & 0xffff0000u);
      const float pa = __uint_as_float(par[k] << 16), pb = __uint_as_float(par[k] & 0xffff0000u);
      res[k] = cvtpk_s(oa * cs[2 * k] + sg * pa * sn[2 * k], ob * cs[2 * k + 1] + sg * pb * sn[2 * k + 1]);
    }
    qr[0] = __builtin_bit_cast(bf16x8, res);
  }
  unsigned mlo = 0xffffffffu, mhi_ = 0xffffffffu;
  if (MODE == 0) { const unsigned long long mk = io.selmask[(size_t)(b * KVH + kvh) * SEQ + tq]; mlo = (unsigned)mk; mhi_ = (unsigned)(mk >> 32); }
  int cmaxc = 0; if (MODE == 2) { cmaxc = (tq - 31) >> 4; if (cmaxc < 0) cmaxc = 0; }
  float mhat = 0.f, l_reg = 0.f; f32x16 o[2]; o[0] = f32x16{}; o[1] = f32x16{}; f32x16 negm = f32x16{}; asm volatile("" : "+v"(negm));
#define BMASK(P0, P1, t) do { \
    if (MODE == 0) { if ((t) >= qb) mask_gt(P0, P1, tq - 64 * (t), hi); } \
    else if (MODE == 1) { mask_both(P0, P1, ((t) == 0) ? ql : 1000, ((t) > qb) ? 1000 : ql + 64 * (t) - 512, hi); } \
    else { mask_gt(P0, P1, cmaxc - 64 * (t), hi); } } while (0)
#define NEGSEL(t) do { if (MODE == 0) { const int ti_ = ((t) < qb) ? (t) : qb; const unsigned w_ = (ti_ < 32) ? mlo : mhi_; const bool on_ = (w_ >> (ti_ & 31)) & 1u; \
      const float nm_ = on_ ? -mhat : -INFINITY; _Pragma("unroll") for (int r = 0; r < 16; ++r) negm[r] = nm_; asm volatile("" : "+v"(negm)); } } while (0)
  bool resc = false;
#define START(P0, P1) do { const float rm = rowmax(P0, P1); resc = false; \
    { const float dl = rm; mhat = fadd_s(mhat, dl); \
      _Pragma("unroll") for (int r = 0; r < 16; ++r) { P0[r] = fsub_s(P0[r], dl); P1[r] = fsub_s(P1[r], dl); } \
      _Pragma("unroll") for (int r = 0; r < 16; ++r) negm[r] = -mhat; asm volatile("" : "+v"(negm)); } \
    _Pragma("unroll") for (int r = 0; r < 16; ++r) P0[r] = __builtin_amdgcn_exp2f(P0[r]); } while (0)
#define RESC() do { if (resc) { asm volatile("s_waitcnt lgkmcnt(0)" ::: "memory"); \
      _Pragma("unroll") for (int d_ = 0; d_ < 2; ++d_) _Pragma("unroll") for (int r = 0; r < 16; ++r) o[d_][r] *= wsf[crow(r, hi)]; } } while (0)
  f32x16 pA0, pA1, pB0, pB1;
  int sl_prev = 0, sl_cur = 0, sl_next = SLOTB;
#define ROT() do { sl_prev = sl_cur; sl_cur = sl_next; sl_next = (sl_next == (NSLOT - 1) * SLOTB) ? 0 : sl_next + SLOTB; } while (0)
  DMA_K(2, 2 * SLOTB);
  WAIT_BAR(3);
  qkt(pA0, pA1, Kbase, qr, negm, r32, hi); asm volatile("s_nop 15\n\ts_nop 7" : "+v"(pA0), "+v"(pA1)); BMASK(pA0, pA1, 0);
  START(pA0, pA1);
  _Pragma("unroll") for (int r = 0; r < 16; ++r) pA1[r] = __builtin_amdgcn_exp2f(pA1[r]);
  WAIT_BAR(0);
  DMA_K(3, 0); DMA_V(1, SLOTB);
  ROT();
  kload8(kf, kp0 + sl_cur);
  WAIT_BAR(2);
  s16x4 vlo[8], vhi[8]; u32x4 pw0, pw1, pw2, pw3;
#define PKW(P, B) cvtpk_s(P[B], P[B + 1])
#define PAF(k) __builtin_bit_cast(bf16x8, pw##k)
#define VFR(i) (bf16x8){vlo[i][0], vlo[i][1], vlo[i][2], vlo[i][3], vhi[i][0], vhi[i][1], vhi[i][2], vhi[i][3]}
#define PIN(x) asm volatile("" : "+v"(x))
#define MX3(a, b, c) __builtin_fmaxf(__builtin_fmaxf((a), (b)), (c))
#define GAPA(MF, A0, A1, A2, A3, W0, W1, PW) do { MF; sacc += A0; sacc += A1; sacc += A2; sacc += A3; PIN(sacc); W0; W1; PIN(PW); SBAR(); } while (0)
#define EX(v) __builtin_amdgcn_exp2f(v)
#define GAPB(MF, X, B) do { MF; X[B] = EX(X[B]); X[B + 1] = EX(X[B + 1]); X[B + 2] = EX(X[B + 2]); X[B + 3] = EX(X[B + 3]); PIN(X); SBAR(); } while (0)
#define VRD(i) do { vlo[i] = vtr(vp_ + (((i) >> 2) * 4096 + ((i) & 3) * 1024)); vhi[i] = vtr(vp_ + (((i) >> 2) * 4096 + ((i) & 3) * 1024 + 512)); } while (0)
#define KRD(G, j) do { if (G) { kload2(kf, kp0 + sl_next, j); SBAR(); } } while (0)
#define STEP(C0, C1, P0, P1, t, GK, GV, GL, BAND) do { SBAR(); \
    NEGSEL(t); SBAR(); \
    const lds_cptr vp_ = vp0 + sl_prev; \
    VRD(0); SBAR(); float sacc = (P0[0] + P0[1]); \
    GAPA(C0 = __builtin_amdgcn_mfma_f32_32x32x16_bf16(kf[0], qr[0], negm, 0, 0, 0), P0[2], P0[3], P0[4], P0[5],     pw0[0] = PKW(P0, 0), pw0[1] = PKW(P0, 2), pw0); \
    VRD(4); SBAR(); GAPA(C1 = __builtin_amdgcn_mfma_f32_32x32x16_bf16(kf[1], qr[0], negm, 0, 0, 0), P0[6], P0[7], P0[8], P0[9],     pw0[2] = PKW(P0, 4), pw0[3] = PKW(P0, 6), pw0); \
    VRD(1); SBAR(); GAPA(C0 = __builtin_amdgcn_mfma_f32_32x32x16_bf16(kf[2], qr[1], C0, 0, 0, 0),   P0[10], P0[11], P0[12], P0[13], pw1[0] = PKW(P0, 8), pw1[1] = PKW(P0, 10), pw1); \
    VRD(5); SBAR(); GAPA(C1 = __builtin_amdgcn_mfma_f32_32x32x16_bf16(kf[3], qr[1], C1, 0, 0, 0),   P0[14], P0[15], P1[0], P1[1],   pw1[2] = PKW(P0, 12), pw1[3] = PKW(P0, 14), pw1); \
    VRD(2); SBAR(); GAPA(C0 = __builtin_amdgcn_mfma_f32_32x32x16_bf16(kf[4], qr[2], C0, 0, 0, 0),   P1[2], P1[3], P1[4], P1[5],     pw2[0] = PKW(P1, 0), pw2[1] = PKW(P1, 2), pw2); \
    VRD(6); SBAR(); GAPA(C1 = __builtin_amdgcn_mfma_f32_32x32x16_bf16(kf[5], qr[2], C1, 0, 0, 0),   P1[6], P1[7], P1[8], P1[9],     pw2[2] = PKW(P1, 4), pw2[3] = PKW(P1, 6), pw2); \
    VRD(3); SBAR(); GAPA(C0 = __builtin_amdgcn_mfma_f32_32x32x16_bf16(kf[6], qr[3], C0, 0, 0, 0),   P1[10], P1[11], P1[12], P1[13], pw3[0] = PKW(P1, 8), pw3[1] = PKW(P1, 10), pw3); \
    VRD(7); SBAR(); GAPA(C1 = __builtin_amdgcn_mfma_f32_32x32x16_bf16(kf[7], qr[3], C1, 0, 0, 0),   P1[14], P1[15], 0.f, 0.f,       pw3[2] = PKW(P1, 12), pw3[3] = PKW(P1, 14), pw3); \
    l_reg += sacc; \
    if (GK) { DMA_K((t) + 3, sl_cur); } if (GV) { DMA_V((t) + 1, sl_next); } \
    if (BAND) { BMASK(C0, C1, t); } \
    { float a = MX3(C0[0], C0[1], C1[0]), b = MX3(C0[2], C0[3], C1[1]); a = MX3(a, C1[2], C1[3]); \
      _Pragma("unroll") for (int r = 4; r < 16; r += 4) { a = MX3(a, C0[r], C0[r + 1]); b = MX3(b, C0[r + 2], C0[r + 3]); a = MX3(a, C1[r], C1[r + 1]); b = MX3(b, C1[r + 2], C1[r + 3]); } \
      float rm = __builtin_fmaxf(a, b); { auto rr = __builtin_amdgcn_permlane32_swap(__float_as_uint(rm), __float_as_uint(rm), false, false); rm = __builtin_fmaxf(__uint_as_float(rr[0]), __uint_as_float(rr[1])); } \
      resc = false; \
      if (__builtin_expect(__any(rm > (float)THRL), 0)) { const float dl = __builtin_fmaxf(rm, 0.f); mhat += dl; \
        _Pragma("unroll") for (int r = 0; r < 16; ++r) { C0[r] -= dl; C1[r] -= dl; } \
        _Pragma("unroll") for (int r = 0; r < 16; ++r) negm[r] = -mhat; asm volatile("" : "+v"(negm)); \
        const float f = __builtin_amdgcn_exp2f(-dl); l_reg *= f; if (hi == 0) wsf[r32] = f; resc = true; } } \
    SBAR(); \
    GAPB(o[0] = __builtin_amdgcn_mfma_f32_32x32x16_bf16(PAF(0), VFR(0), o[0], 0, 0, 0), C0, 0); \
    GAPB(o[1] = __builtin_amdgcn_mfma_f32_32x32x16_bf16(PAF(0), VFR(4), o[1], 0, 0, 0), C0, 4); \
    KRD(GL, 0); GAPB(o[0] = __builtin_amdgcn_mfma_f32_32x32x16_bf16(PAF(1), VFR(1), o[0], 0, 0, 0), C0, 8); \
    KRD(GL, 1); GAPB(o[1] = __builtin_amdgcn_mfma_f32_32x32x16_bf16(PAF(1), VFR(5), o[1], 0, 0, 0), C0, 12); \
    KRD(GL, 2); GAPB(o[0] = __builtin_amdgcn_mfma_f32_32x32x16_bf16(PAF(2), VFR(2), o[0], 0, 0, 0), C1, 0); \
    KRD(GL, 3); GAPB(o[1] = __builtin_amdgcn_mfma_f32_32x32x16_bf16(PAF(2), VFR(6), o[1], 0, 0, 0), C1, 4); \
    GAPB(o[0] = __builtin_amdgcn_mfma_f32_32x32x16_bf16(PAF(3), VFR(3), o[0], 0, 0, 0), C1, 8); \
    GAPB(o[1] = __builtin_amdgcn_mfma_f32_32x32x16_bf16(PAF(3), VFR(7), o[1], 0, 0, 0), C1, 12); \
    } while (0)
  int t = 1;
#pragma nounroll
  for (; t + 5 < NT; t += 2) {
    STEP(pB0, pB1, pA0, pA1, t, true, true, true, false);     WAIT_BAR(2); RESC(); ROT();
    STEP(pA0, pA1, pB0, pB1, t + 1, true, true, true, false); WAIT_BAR(2); RESC(); ROT();
  }
#define ENDW(tt) do { if ((tt) + 3 < NT) { WAIT_BAR(2); } else if ((tt) + 2 < NT) { WAIT_BAR(1); } else { WAIT_BAR(0); } } while (0)
#pragma nounroll
  for (; t + 1 < NT; t += 2) {
    STEP(pB0, pB1, pA0, pA1, t, (t + 3 < NT), (t + 1 < NT), (t + 1 < NT), true);       ENDW(t);     RESC(); ROT();
    STEP(pA0, pA1, pB0, pB1, t + 1, (t + 4 < NT), (t + 2 < NT), (t + 2 < NT), true);   ENDW(t + 1); RESC(); ROT();
  }
  STEP(pB0, pB1, pA0, pA1, NT - 1, false, false, false, true); RESC();
  { float sacc = pB0[0] + pB0[1]; _Pragma("unroll") for (int r = 2; r < 16; ++r) sacc += pB0[r]; _Pragma("unroll") for (int r = 0; r < 16; ++r) sacc += pB1[r]; l_reg += sacc;
    pw0 = (u32x4){PKW(pB0, 0), PKW(pB0, 2), PKW(pB0, 4), PKW(pB0, 6)}; pw1 = (u32x4){PKW(pB0, 8), PKW(pB0, 10), PKW(pB0, 12), PKW(pB0, 14)}; pw2 = (u32x4){PKW(pB1, 0), PKW(pB1, 2), PKW(pB1, 4), PKW(pB1, 6)}; pw3 = (u32x4){PKW(pB1, 8), PKW(pB1, 10), PKW(pB1, 12), PKW(pB1, 14)};
    SBAR(); pv(o, vb0 + sl_cur, PAF(0), PAF(1), PAF(2), PAF(3)); }
#undef PKW
#undef PAF
#undef VFR
#undef PIN
#undef MX3
#undef GAPA
#undef GAPB
#undef EX
#undef VRD
#undef KRD
#undef STEP
#undef ENDW
  { auto rr = __builtin_amdgcn_permlane32_swap(__float_as_uint(l_reg), __float_as_uint(l_reg), false, false); l_reg = __uint_as_float(rr[0]) + __uint_as_float(rr[1]); }
  if (hi == 0) wsf[32 + r32] = l_reg; asm volatile("s_waitcnt lgkmcnt(0)" ::: "memory");
  float rli[16];
#pragma unroll
  for (int r = 0; r < 16; ++r) rli[r] = __builtin_amdgcn_rcpf(wsf[32 + crow(r, hi)]);
  if (MODE == 2 && io.pass == 1) {
    float* imp = (float*)(shm + LDS_IMP) + ((wid >> 1) * 64 + (wid & 1) * 32) * 64;
#pragma unroll
    for (int r = 0; r < 16; ++r) { const int orow = crow(r, hi); const bool valid = (qb * 64 + (wid & 1) * 32 + orow) >= 31;
#pragma unroll
      for (int d0 = 0; d0 < 2; ++d0) imp[orow * 64 + d0 * 32 + r32] = valid ? o[d0][r] * rli[r] : 0.f; }
    asm volatile("s_waitcnt lgkmcnt(0)\n\ts_barrier" ::: "memory");
    const float* impb = (const float*)(shm + LDS_IMP);
    for (int k = 0; k < 8; ++k) {
      const int tl = wid * 8 + k, tt = qb * 64 + tl, cur = qb;
      float s = (impb[(0 * 64 + tl) * 64 + lane] + impb[(1 * 64 + tl) * 64 + lane]) + (impb[(2 * 64 + tl) * 64 + lane] + impb[(3 * 64 + tl) * 64 + lane]);
      const bool forced = (lane == 0) || (lane == cur) || (lane == cur - 1);
      s = forced ? 1e4f : ((lane <= cur) ? s : -1.0f);
      int rank = 0;
#pragma unroll
      for (int i = 0; i < 64; ++i) { const float si = __builtin_bit_cast(float, __builtin_amdgcn_readlane(__builtin_bit_cast(int, s), i)); rank += (si > s || (si == s && i < lane)) ? 1 : 0; }
      const unsigned long long m = __ballot(rank < 16);
      if (lane == 0) io.selmask[(size_t)(b * KVH + kvh) * SEQ + tt] = m;
    }
  } else {
    bf16* stg = (bf16*)(shm + LDS_OST) + wid * 2048;
#pragma unroll
    for (int r = 0; r < 16; ++r) { const int orow = crow(r, hi);
#pragma unroll
      for (int d0 = 0; d0 < 2; ++d0) stg[orow * 64 + d0 * 32 + r32] = (bf16)f2bf(o[d0][r] * rli[r]); }
    asm volatile("s_waitcnt lgkmcnt(0)" ::: "memory");
#pragma unroll
    for (int i = 0; i < 4; ++i) { const int row = i * 8 + (lane >> 3), ch = lane & 7;
      const u32x4 v = *(const u32x4*)(stg + row * 64 + ch * 8);
      const size_t grow = (size_t)(rowbase + q0 + row);
      const int tok = q0 + row;
      const bf16* pr = io.P + grow * PP;
      float ov[8];
#pragma unroll
      for (int k = 0; k < 4; ++k) { ov[2 * k] = __uint_as_float(v[k] << 16); ov[2 * k + 1] = __uint_as_float(v[k] & 0xffff0000u); }
      if (MODE == 2) {
        const float g0 = (tok >= 31) ? fast_sigmoid(bf2f(pr[C_NGATE + 0 * NSA_HEADS + head])) : 0.f;
        u32x4 w;
#pragma unroll
        for (int k = 0; k < 4; ++k) w[k] = cvtpk_s(g0 * ov[2 * k], g0 * ov[2 * k + 1]);
        *(u32x4*)(io.Y + grow * D_MODEL + HG_W + head * 64 + ch * 8) = w;
      } else if (MODE == 1) {
        const float g2 = fast_sigmoid(bf2f(pr[C_NGATE + 2 * NSA_HEADS + head]));
        u32x4 w;
#pragma unroll
        for (int k = 0; k < 4; ++k) w[k] = cvtpk_s(g2 * ov[2 * k], g2 * ov[2 * k + 1]);
        *(u32x4*)(io.T2 + grow * NSA_W + head * 64 + ch * 8) = w;
      } else {
        const float g1 = fast_sigmoid(bf2f(pr[C_NGATE + 1 * NSA_HEADS + head]));
        const u32x4 t1 = *(const u32x4*)(io.Y + grow * D_MODEL + HG_W + head * 64 + ch * 8);
        const u32x4 t2 = *(const u32x4*)(io.T2 + grow * NSA_W + head * 64 + ch * 8);
        const u32x4 nz = *(const u32x4*)(pr + C_NZ + head * 64 + ch * 8);
        u32x4 w;
#pragma unroll
        for (int k = 0; k < 4; ++k) {
          const float za = __uint_as_float(nz[k] << 16), zb = __uint_as_float(nz[k] & 0xffff0000u);
          const float ya = (__uint_as_float(t1[k] << 16) + __uint_as_float(t2[k] << 16) + g1 * ov[2 * k]) * za * fast_sigmoid(za);
          const float yb = (__uint_as_float(t1[k] & 0xffff0000u) + __uint_as_float(t2[k] & 0xffff0000u) + g1 * ov[2 * k + 1]) * zb * fast_sigmoid(zb);
          w[k] = cvtpk_s(ya, yb);
        }
        *(u32x4*)(io.Y + grow * D_MODEL + HG_W + head * 64 + ch * 8) = w;
      }
    }
  }
  asm volatile("s_waitcnt lgkmcnt(0)\n\ts_barrier" ::: "memory");
#undef DMA_K
#undef DMA_V
#undef MEMTILE
#undef BMASK
#undef NEGSEL
#undef START
#undef RESC
#undef ROT
}
#undef SBAR
#undef WAIT_BAR
}
namespace hg {
using bf16x8 = __attribute__((ext_vector_type(8))) short;
using f32x16 = __attribute__((ext_vector_type(16))) float;
constexpr int HG_NS = 4, HG_NG = SEQ / (64 * HG_NS);
constexpr int RS = 272;
constexpr int TS = 144;
constexpr int L_QD = 0, L_QR = L_QD + 64 * RS, L_KR = L_QR + 64 * RS, L_KDT = L_KR + 64 * RS, L_VT = L_KDT + 128 * TS, L_A = L_VT + 128 * TS,
              L_ST = L_A + 64 * TS, L_OST = L_ST + 128 * RS, L_BL = L_OST + 64 * RS, L_END = L_BL + 512;
__device__ __forceinline__ int crow(int r, int hi) { return (r & 3) + 8 * (r >> 2) + 4 * hi; }
__device__ __forceinline__ bf16x8 ldsfrag(const char* base, int row, int stride, int kbyte) { return *(const bf16x8*)(base + row * stride + kbyte); }
#define HG_MFMA(a, b, c) __builtin_amdgcn_mfma_f32_32x32x16_bf16(a, b, c, 0, 0, 0)

struct HgIO {
  const bf16* P; bf16* Y; const float* lb_l; const float* onorm_g;
  float* SLOC;
  float* DGL;
};

template <bool FULL>
__device__ __forceinline__ void chunk_prep(const HgIO& io, char* lds, size_t row, int h, int wid, int lane, const float* lbv, float* dgl) {
  const bf16* pr = io.P + row * PP;
  const uint4 f0 = *(const uint4*)(pr + C_HF + h * 128 + 16 * wid), f1 = *(const uint4*)(pr + C_HF + h * 128 + 16 * wid + 8);
  const uint4 v0 = *(const uint4*)(pr + C_HI + h * 128 + 16 * wid), v1 = *(const uint4*)(pr + C_HI + h * 128 + 16 * wid + 8);
  uint4 q0 = make_uint4(0, 0, 0, 0), q1 = q0;
  if (FULL) { q0 = *(const uint4*)(pr + C_HQ + h * 128 + 16 * wid); q1 = *(const uint4*)(pr + C_HQ + h * 128 + 16 * wid + 8); }
  const unsigned fw[8] = {f0.x, f0.y, f0.z, f0.w, f1.x, f1.y, f1.z, f1.w};
  const unsigned vw[8] = {v0.x, v0.y, v0.z, v0.w, v1.x, v1.y, v1.z, v1.w};
  const unsigned qw[8] = {q0.x, q0.y, q0.z, q0.w, q1.x, q1.y, q1.z, q1.w};
  float b[16], kk[16];
#pragma unroll
  for (int i = 0; i < 16; ++i) {
    const float fl = (i & 1) ? __uint_as_float(fw[i >> 1] & 0xffff0000u) : __uint_as_float(fw[i >> 1] << 16);
    const float sg = fast_sigmoid(fl);
    const float lb = lbv[i];
    const float f = lb + (1.f - lb) * sg;
    b[i] = __logf(f);
    kk[i] = (1.f - lb) * fast_sigmoid(-fl);
  }
#pragma unroll
  for (int o = 1; o < 64; o <<= 1) {
#pragma unroll
    for (int i = 0; i < 16; ++i) { const float t = __shfl_up(b[i], o); if (lane >= o) b[i] += t; }
  }
  float bl[16], rf[16];
#pragma unroll
  for (int i = 0; i < 16; ++i) { bl[i] = __shfl(b[i], 63); rf[i] = __shfl(b[i], 31); }
  if (lane == 63) {
    float* blp = (float*)(lds + L_BL) + 16 * wid;
#pragma unroll
    for (int i = 0; i < 16; ++i) { blp[i] = bl[i]; dgl[i] += bl[i]; }
  }
  unsigned short* kdt = (unsigned short*)(lds + L_KDT);
  unsigned short* vt = (unsigned short*)(lds + L_VT);
#pragma unroll
  for (int i = 0; i < 16; ++i) {
    const float kd = kk[i] * __expf(bl[i] - b[i]);
    kdt[(16 * wid + i) * (TS / 2) + lane] = (unsigned short)f2bf(kd);
    vt[(16 * wid + i) * (TS / 2) + lane] = (unsigned short)((i & 1) ? (vw[i >> 1] >> 16) : (vw[i >> 1] & 0xffffu));
  }
  if (FULL) {
    unsigned qd[8], qrr[8], krr[8];
#pragma unroll
    for (int i = 0; i < 16; i += 2) {
      const float qa = __uint_as_float(qw[i >> 1] << 16), qb = __uint_as_float(qw[i >> 1] & 0xffff0000u);
      qd[i >> 1] = pk2(qa * __expf(b[i]), qb * __expf(b[i + 1]));
      qrr[i >> 1] = pk2(qa * __expf(fminf(b[i] - rf[i], 80.f)), qb * __expf(fminf(b[i + 1] - rf[i + 1], 80.f)));
      krr[i >> 1] = pk2(kk[i] * __expf(fminf(rf[i] - b[i], 80.f)), kk[i + 1] * __expf(fminf(rf[i + 1] - b[i + 1], 80.f)));
    }
    uint4* dq = (uint4*)(lds + L_QD + lane * RS + 32 * wid);
    dq[0] = make_uint4(qd[0], qd[1], qd[2], qd[3]); dq[1] = make_uint4(qd[4], qd[5], qd[6], qd[7]);
    uint4* dr = (uint4*)(lds + L_QR + lane * RS + 32 * wid);
    dr[0] = make_uint4(qrr[0], qrr[1], qrr[2], qrr[3]); dr[1] = make_uint4(qrr[4], qrr[5], qrr[6], qrr[7]);
    uint4* dk = (uint4*)(lds + L_KR + lane * RS + 32 * wid);
    dk[0] = make_uint4(krr[0], krr[1], krr[2], krr[3]); dk[1] = make_uint4(krr[4], krr[5], krr[6], krr[7]);
  }
}

__device__ __forceinline__ void u_blocks(const char* lds, int wid, int l31, int hi, f32x16 (&u)[2]) {
  const int vb = wid & 3;
#pragma unroll
  for (int blk = 0; blk < 2; ++blk) {
    const int db = 2 * (wid >> 2) + blk;
    f32x16 acc = f32x16{};
#pragma unroll
    for (int ks = 0; ks < 4; ++ks) {
      const bf16x8 a = ldsfrag(lds + L_VT, vb * 32 + l31, TS, ks * 32 + hi * 16);
      const bf16x8 bb = ldsfrag(lds + L_KDT, db * 32 + l31, TS, ks * 32 + hi * 16);
      acc = HG_MFMA(a, bb, acc);
    }
    u[blk] = acc;
  }
}

__device__ __forceinline__ void hgrn_state_item(const HgIO& io, int item, char* lds) {
  const int tid = threadIdx.x, lane = tid & 63, l31 = lane & 31, hi = lane >> 5; const int wid = __builtin_amdgcn_readfirstlane(tid >> 6);
  const int bh = item / HG_NG, g = item % HG_NG, b = bh >> 2, h = bh & 3;
  float lbv[16];
#pragma unroll
  for (int i = 0; i < 16; ++i) lbv[i] = io.lb_l[h * 128 + 16 * wid + i];
  float dgl[16];
#pragma unroll
  for (int i = 0; i < 16; ++i) dgl[i] = 0.f;
  f32x16 S[2]; S[0] = f32x16{}; S[1] = f32x16{};
  for (int c = 0; c < HG_NS; ++c) {
    const size_t row = (size_t)b * SEQ + (size_t)(g * HG_NS + c) * 64 + lane;
    chunk_prep<false>(io, lds, row, h, wid, lane, lbv, dgl);
    __syncthreads();
    f32x16 u[2];
    u_blocks(lds, wid, l31, hi, u);
    const float* blp = (const float*)(lds + L_BL);
#pragma unroll
    for (int blk = 0; blk < 2; ++blk) {
      const float dec = __expf(blp[(2 * (wid >> 2) + blk) * 32 + l31]);
#pragma unroll
      for (int r = 0; r < 16; ++r) S[blk][r] = dec * S[blk][r] + u[blk][r];
    }
    __syncthreads();
  }
  float* dst = io.SLOC + ((size_t)(bh * HG_NG + g) * 8 + wid) * 2048;
#pragma unroll
  for (int blk = 0; blk < 2; ++blk)
#pragma unroll
    for (int r = 0; r < 16; ++r) dst[(blk * 16 + r) * 64 + lane] = S[blk][r];
  if (lane == 63) {
    float* dg = io.DGL + (size_t)(bh * HG_NG + g) * 128 + 16 * wid;
#pragma unroll
    for (int i = 0; i < 16; ++i) dg[i] = dgl[i];
  }
}

__device__ __forceinline__ void hgrn_scan_item(const HgIO& io, int item) {
  const int tid = threadIdx.x, bh = item >> 3, w = item & 7;
  float run[4] = {0.f, 0.f, 0.f, 0.f};
  for (int g = 0; g < HG_NG; ++g) {
    float* p = io.SLOC + ((size_t)(bh * HG_NG + g) * 8 + w) * 2048;
    const float* dg = io.DGL + (size_t)(bh * HG_NG + g) * 128;
#pragma unroll
    for (int k = 0; k < 4; ++k) {
      const int e = tid + 512 * k, blk = e >> 10, ln = e & 63;
      const int d = (2 * (w >> 2) + blk) * 32 + (ln & 31);
      const float loc = p[e];
      p[e] = run[k];
      run[k] = __expf(dg[d]) * run[k] + loc;
    }
  }
}

__device__ __forceinline__ void hgrn_out_item(const HgIO& io, int item, char* lds) {
  const int tid = threadIdx.x, lane = tid & 63, l31 = lane & 31, hi = lane >> 5; const int wid = __builtin_amdgcn_readfirstlane(tid >> 6);
  const int bh = item / HG_NG, g = item % HG_NG, b = bh >> 2, h = bh & 3;
  const int tb = wid >> 2, vb = wid & 3;
  float lbv[16];
#pragma unroll
  for (int i = 0; i < 16; ++i) lbv[i] = io.lb_l[h * 128 + 16 * wid + i];
  float dgl[16];
#pragma unroll
  for (int i = 0; i < 16; ++i) dgl[i] = 0.f;
  f32x16 S[2];
  {
    const float* src = io.SLOC + ((size_t)(bh * HG_NG + g) * 8 + wid) * 2048;
    unsigned short* st = (unsigned short*)(lds + L_ST);
#pragma unroll
    for (int blk = 0; blk < 2; ++blk)
#pragma unroll
      for (int r = 0; r < 16; ++r) {
        const float v = src[(blk * 16 + r) * 64 + lane];
        S[blk][r] = v;
        st[(vb * 32 + crow(r, hi)) * (RS / 2) + (2 * (wid >> 2) + blk) * 32 + l31] = (unsigned short)f2bf(v);
      }
  }
  for (int c = 0; c < HG_NS; ++c) {
    const size_t rowc = (size_t)b * SEQ + (size_t)(g * HG_NS + c) * 64;
    chunk_prep<true>(io, lds, rowc + lane, h, wid, lane, lbv, dgl);
    __syncthreads();
    f32x16 oacc = f32x16{};
#pragma unroll
    for (int ks = 0; ks < 8; ++ks) {
      const bf16x8 a = ldsfrag(lds + L_QD, tb * 32 + l31, RS, ks * 32 + hi * 16);
      const bf16x8 bb = ldsfrag(lds + L_ST, vb * 32 + l31, RS, ks * 32 + hi * 16);
      oacc = HG_MFMA(a, bb, oacc);
    }
    f32x16 u[2];
    u_blocks(lds, wid, l31, hi, u);
    if (wid < 3) {
      const int tb2 = (wid > 0) ? 1 : 0, sb2 = (wid == 2) ? 1 : 0;
      f32x16 a_acc = f32x16{};
#pragma unroll
      for (int ks = 0; ks < 8; ++ks) {
        const bf16x8 a = ldsfrag(lds + L_QR, tb2 * 32 + l31, RS, ks * 32 + hi * 16);
        const bf16x8 bb = ldsfrag(lds + L_KR, sb2 * 32 + l31, RS, ks * 32 + hi * 16);
        a_acc = HG_MFMA(a, bb, a_acc);
      }
      unsigned short* al = (unsigned short*)(lds + L_A);
#pragma unroll
      for (int r = 0; r < 16; ++r) {
        const int t = tb2 * 32 + crow(r, hi), s = sb2 * 32 + l31;
        al[t * (TS / 2) + s] = (unsigned short)f2bf((s <= t) ? a_acc[r] : 0.f);
      }
    }
    __syncthreads();
    for (int sb = 0; sb <= tb; ++sb) {
#pragma unroll
      for (int ks = 0; ks < 2; ++ks) {
        const bf16x8 a = ldsfrag(lds + L_A, tb * 32 + l31, TS, sb * 64 + ks * 32 + hi * 16);
        const bf16x8 bb = ldsfrag(lds + L_VT, vb * 32 + l31, TS, sb * 64 + ks * 32 + hi * 16);
        oacc = HG_MFMA(a, bb, oacc);
      }
    }
    {
      const float* blp = (const float*)(lds + L_BL);
      unsigned short* st = (unsigned short*)(lds + L_ST);
#pragma unroll
      for (int blk = 0; blk < 2; ++blk) {
        const int db = 2 * (wid >> 2) + blk;
        const float dec = __expf(blp[db * 32 + l31]);
#pragma unroll
        for (int r = 0; r < 16; ++r) {
          const float v = dec * S[blk][r] + u[blk][r];
          S[blk][r] = v;
          st[(vb * 32 + crow(r, hi)) * (RS / 2) + db * 32 + l31] = (unsigned short)f2bf(v);
        }
      }
      unsigned short* os = (unsigned short*)(lds + L_OST);
#pragma unroll
      for (int r = 0; r < 16; ++r) os[(tb * 32 + crow(r, hi)) * (RS / 2) + vb * 32 + l31] = (unsigned short)f2bf(oacc[r]);
    }
    __syncthreads();
    {
      const int t = tid >> 3, vc = tid & 7;
      const uint4 o0 = *(const uint4*)(lds + L_OST + t * RS + vc * 32), o1 = *(const uint4*)(lds + L_OST + t * RS + vc * 32 + 16);
      const unsigned ow[8] = {o0.x, o0.y, o0.z, o0.w, o1.x, o1.y, o1.z, o1.w};
      float ov[16]; float ss = 0.f;
#pragma unroll
      for (int k = 0; k < 8; ++k) { ov[2 * k] = __uint_as_float(ow[k] << 16); ov[2 * k + 1] = __uint_as_float(ow[k] & 0xffff0000u); ss += ov[2 * k] * ov[2 * k] + ov[2 * k + 1] * ov[2 * k + 1]; }
      ss += __shfl_xor(ss, 1); ss += __shfl_xor(ss, 2); ss += __shfl_xor(ss, 4);
      const float rstd = rsqrtf(ss * (1.0f / 128.0f) + RMS_EPS);
      const bf16* pr = io.P + (rowc + t) * PP;
      const uint4 g0 = *(const uint4*)(pr + C_HGO + h * 128 + vc * 16), g1 = *(const uint4*)(pr + C_HGO + h * 128 + vc * 16 + 8);
      const uint4 z0 = *(const uint4*)(pr + C_HZ + h * 128 + vc * 16), z1 = *(const uint4*)(pr + C_HZ + h * 128 + vc * 16 + 8);
      const unsigned gw[8] = {g0.x, g0.y, g0.z, g0.w, g1.x, g1.y, g1.z, g1.w};
      const unsigned zw[8] = {z0.x, z0.y, z0.z, z0.w, z1.x, z1.y, z1.z, z1.w};
      unsigned yw[8];
#pragma unroll
      for (int k = 0; k < 8; ++k) {
        const float ga = __uint_as_float(gw[k] << 16), gb = __uint_as_float(gw[k] & 0xffff0000u);
        const float za = __uint_as_float(zw[k] << 16), zb = __uint_as_float(zw[k] & 0xffff0000u);
        const float ya = ov[2 * k] * rstd * io.onorm_g[vc * 16 + 2 * k] * fast_sigmoid(ga) * za * fast_sigmoid(za);
        const float yb = ov[2 * k + 1] * rstd * io.onorm_g[vc * 16 + 2 * k + 1] * fast_sigmoid(gb) * zb * fast_sigmoid(zb);
        yw[k] = pk2(ya, yb);
      }
      uint4* yd = (uint4*)(io.Y + (rowc + t) * D_MODEL + h * 128 + vc * 16);
      yd[0] = make_uint4(yw[0], yw[1], yw[2], yw[3]); yd[1] = make_uint4(yw[4], yw[5], yw[6], yw[7]);
    }
  }
  __syncthreads();
}
#undef HG_MFMA
}
namespace cp {
using bf16x8 = __attribute__((ext_vector_type(8))) short;
using f32x16 = __attribute__((ext_vector_type(16))) float;
constexpr int TROWS = 528;
constexpr int BS = 144;
constexpr int HS = 272;
constexpr int L_TK = 0, L_BT = L_TK + TROWS * 128, L_HD = L_BT + 2 * 128 * BS, L_OS = L_HD + 32 * HS, L_END = L_OS + 32 * 64 * 4;
__device__ __forceinline__ int crow(int r, int hi) { return (r & 3) + 8 * (r >> 2) + 4 * hi; }
struct CmpIO {
  const bf16* P; const bf16* W1T;
  const bf16* W2T;
  const float* BIAS1;
  const float* kg0;
  bf16* KC; bf16* VC;
};
__device__ __forceinline__ void cmp_item(const CmpIO& io, int item, char* lds) {
  const int tid = threadIdx.x, lane = tid & 63, l31 = lane & 31, hi = lane >> 5; const int wid = __builtin_amdgcn_readfirstlane(tid >> 6);
  const int rb = item & 7, kv = (item >> 3) & 1, bg = item >> 4, b = bg >> 1, g = bg & 1;
  const int c0 = 32 * rb, tok0 = 16 * c0;
  const bf16* src = io.P + (size_t)b * SEQ * PP + (kv == 0 ? C_KCM : C_VCM) + g * 64;
  for (int q = tid; q < TROWS * 8; q += 512) {
    const int row = q >> 3, ch = q & 7;
    int tok = tok0 + row; if (tok > SEQ - 1) tok = SEQ - 1;
    const uint4 v = *(const uint4*)(src + (size_t)tok * PP + ch * 8);
    *(uint4*)(lds + L_TK + row * 128 + ((ch ^ ((row >> 4) & 7)) << 4)) = v;
  }
  const bf16* w1 = io.W1T + (size_t)kv * 128 * 2048;
  const int n0 = tid >> 3, chq = tid & 7;
  uint4 st0 = *(const uint4*)(w1 + (size_t)n0 * 2048 + chq * 8), st1 = *(const uint4*)(w1 + (size_t)(n0 + 64) * 2048 + chq * 8);
  *(uint4*)(lds + L_BT + n0 * BS + chq * 16) = st0; *(uint4*)(lds + L_BT + (n0 + 64) * BS + chq * 16) = st1;
  __syncthreads();
  const int nb = wid & 3, kh = wid >> 2;
  f32x16 acc = f32x16{};
  for (int l = 0; l < 32; ++l) {
    const int cur = l & 1;
    if (l + 1 < 32) { st0 = *(const uint4*)(w1 + (size_t)n0 * 2048 + (l + 1) * 64 + chq * 8); st1 = *(const uint4*)(w1 + (size_t)(n0 + 64) * 2048 + (l + 1) * 64 + chq * 8); }
#pragma unroll
    for (int kk = 0; kk < 2; ++kk) {
      const int k16 = 2 * kh + kk;
      const int row = 16 * l31 + l;
      const bf16x8 a = *(const bf16x8*)(lds + L_TK + row * 128 + (((k16 * 2 + hi) ^ ((row >> 4) & 7)) << 4));
      const bf16x8 bb = *(const bf16x8*)(lds + L_BT + cur * 128 * BS + (nb * 32 + l31) * BS + k16 * 32 + hi * 16);
      acc = __builtin_amdgcn_mfma_f32_32x32x16_bf16(a, bb, acc, 0, 0, 0);
    }
    if (l + 1 < 32) { *(uint4*)(lds + L_BT + (cur ^ 1) * 128 * BS + n0 * BS + chq * 16) = st0; *(uint4*)(lds + L_BT + (cur ^ 1) * 128 * BS + (n0 + 64) * BS + chq * 16) = st1; }
    __syncthreads();
  }
  float* red = (float*)(lds + L_BT);
  if (kh == 1) {
#pragma unroll
    for (int r = 0; r < 16; ++r) red[(nb * 16 + r) * 64 + lane] = acc[r];
  }
  __syncthreads();
  if (kh == 0) {
    const float bias = io.BIAS1[kv * 128 + nb * 32 + l31];
    unsigned short* hd = (unsigned short*)(lds + L_HD);
#pragma unroll
    for (int r = 0; r < 16; ++r) {
      const float x = acc[r] + red[(nb * 16 + r) * 64 + lane] + bias;
      hd[crow(r, hi) * (HS / 2) + nb * 32 + l31] = (unsigned short)f2bf(x * fast_sigmoid(x));
    }
  }
  __syncthreads();
  if (wid < 2) {
    const bf16* w2 = io.W2T + (size_t)kv * 64 * 128;
    f32x16 o = f32x16{};
#pragma unroll
    for (int ks = 0; ks < 8; ++ks) {
      const bf16x8 a = *(const bf16x8*)(lds + L_HD + l31 * HS + ks * 32 + hi * 16);
      const bf16x8 bb = *(const bf16x8*)(w2 + (size_t)(wid * 32 + l31) * 128 + ks * 16 + hi * 8);
      o = __builtin_amdgcn_mfma_f32_32x32x16_bf16(a, bb, o, 0, 0, 0);
    }
    float* os = (float*)(lds + L_OS);
#pragma unroll
    for (int r = 0; r < 16; ++r) os[crow(r, hi) * 64 + wid * 32 + l31] = o[r];
  }
  __syncthreads();
  {
    const int c = tid >> 4, j4 = (tid & 15) * 4;
    const float4 v = *(const float4*)(lds + L_OS + (c * 64 + j4) * 4);
    float ss = v.x * v.x + v.y * v.y + v.z * v.z + v.w * v.w;
    ss += __shfl_xor(ss, 1); ss += __shfl_xor(ss, 2); ss += __shfl_xor(ss, 4); ss += __shfl_xor(ss, 8);
    float o0 = v.x, o1 = v.y, o2 = v.z, o3 = v.w;
    if (kv == 0) { const float r = rsqrtf(ss * (1.0f / 64.0f) + RMS_EPS); o0 *= r * io.kg0[j4]; o1 *= r * io.kg0[j4 + 1]; o2 *= r * io.kg0[j4 + 2]; o3 *= r * io.kg0[j4 + 3]; }
    if (c0 + c >= NC) { o0 = 0.f; o1 = 0.f; o2 = 0.f; o3 = 0.f; }
    bf16* dst = (kv == 0 ? io.KC : io.VC) + ((size_t)bg * 256 + c0 + c) * 64 + j4;
    *(uint2*)dst = make_uint2(pk2(o0, o1), pk2(o2, o3));
  }
  __syncthreads();
}
}
__global__ void __launch_bounds__(256) k_nsa_prep(bf16* __restrict__ P, const float* __restrict__ qg, const float* __restrict__ kg,
                                                 const float* __restrict__ ropec, const float* __restrict__ ropes) {
    int i = blockIdx.x * blockDim.x + threadIdx.x;
    if (i >= MROWS * 12) return;
    const int row = i / 12, u = i % 12, t = row % SEQ;
    bf16* src; const float* g;
    if (u < 8) { src = P + (size_t)row * PP + C_NQ + u * DH; g = qg; }
    else if (u < 10) { src = P + (size_t)row * PP + C_KSL + (u - 8) * DH; g = kg + 1 * DH; }
    else { src = P + (size_t)row * PP + C_KWN + (u - 10) * DH; g = kg + 2 * DH; }
    uint4 raw[8];
    float ss = 0.f;
#pragma unroll
    for (int c = 0; c < 8; ++c) {
        raw[c] = ((const uint4*)src)[c];
        const unsigned w[4] = {raw[c].x, raw[c].y, raw[c].z, raw[c].w};
#pragma unroll
        for (int k = 0; k < 4; ++k) { const float a = __uint_as_float(w[k] << 16), b = __uint_as_float(w[k] & 0xffff0000u); ss += a * a + b * b; }
    }
    float r = rsqrtf(ss * (1.0f / DH) + RMS_EPS);
    if (u < 8) { r *= 0.125f * 1.4426950408889634f; ((uint4*)src)[0] = raw[0]; }
    float v01[16];
#pragma unroll
    for (int c = 0; c < 8; ++c) {
        const unsigned w[4] = {raw[c].x, raw[c].y, raw[c].z, raw[c].w};
        float v[8];
#pragma unroll
        for (int k = 0; k < 4; ++k) { v[2 * k] = __uint_as_float(w[k] << 16) * r * g[c * 8 + 2 * k]; v[2 * k + 1] = __uint_as_float(w[k] & 0xffff0000u) * r * g[c * 8 + 2 * k + 1]; }
        uint4 o; o.x = pk2(v[0], v[1]); o.y = pk2(v[2], v[3]); o.z = pk2(v[4], v[5]); o.w = pk2(v[6], v[7]);
        if (c < 2 && u >= 8) {
#pragma unroll
            for (int k = 0; k < 8; ++k) v01[c * 8 + k] = v[k];
        } else {
            ((uint4*)src)[c] = o;
        }
    }
    if (u < 8) return;
    float ro[16];
#pragma unroll
    for (int j = 0; j < 8; ++j) {
        const float cs = ropec[t * 8 + j], sn = ropes[t * 8 + j];
        ro[j] = v01[j] * cs - v01[j + 8] * sn;
        ro[j + 8] = v01[j] * sn + v01[j + 8] * cs;
    }
    uint4 o0, o1;
    o0.x = pk2(ro[0], ro[1]); o0.y = pk2(ro[2], ro[3]); o0.z = pk2(ro[4], ro[5]); o0.w = pk2(ro[6], ro[7]);
    o1.x = pk2(ro[8], ro[9]); o1.y = pk2(ro[10], ro[11]); o1.z = pk2(ro[12], ro[13]); o1.w = pk2(ro[14], ro[15]);
    uint4* dst = (uint4*)src;
    dst[0] = o0; dst[1] = o1;
}

__global__ void __launch_bounds__(64) k_hgrn_scan(const bf16* __restrict__ Pb, const float* __restrict__ lb_l, float* __restrict__ o_raw) {
    int hv = blockIdx.x, hd = hv >> 7, lane = threadIdx.x;
    int c0 = hd * HG_DK + lane, c1 = c0 + 64;
    float lb0 = lb_l[c0], lb1 = lb_l[c1];
    float S0 = 0.f, S1 = 0.f;
    for (int t = 0; t < SEQ; ++t) {
        const bf16* pr = Pb + (size_t)t * PP;
        float fl0 = bf2f(pr[C_HF + c0]), fl1 = bf2f(pr[C_HF + c1]);
        float q0 = bf2f(pr[C_HQ + c0]), q1 = bf2f(pr[C_HQ + c1]);
        float v = bf2f(pr[C_HI + hv]);
        float f0 = lb0 + (1.f - lb0) * sigmoidf_(fl0), f1 = lb1 + (1.f - lb1) * sigmoidf_(fl1);
        float k0 = (1.f - lb0) * sigmoidf_(-fl0), k1 = (1.f - lb1) * sigmoidf_(-fl1);
        S0 = f0 * S0 + k0 * v;
        S1 = f1 * S1 + k1 * v;
        float part = q0 * S0 + q1 * S1;
        for (int o = 32; o > 0; o >>= 1) part += __shfl_xor(part, o);
        if (lane == 0) o_raw[(size_t)t * HG_W + hv] = part;
    }
}
__global__ void __launch_bounds__(512) k_hgrn_out(const float* __restrict__ o_raw, const bf16* __restrict__ Pb, const float* __restrict__ onorm_g, bf16* __restrict__ Yb) {
    __shared__ float red[8];
    int t = blockIdx.x, c = threadIdx.x;
    float v = o_raw[(size_t)t * HG_W + c];
    float ss = v * v;
    for (int o = 32; o > 0; o >>= 1) ss += __shfl_xor(ss, o);
    if ((c & 63) == 0) red[c >> 6] = ss;
    __syncthreads();
    int hd = c >> 7;
    float tot = red[hd * 2] + red[hd * 2 + 1];
    float r = rsqrtf(tot / (float)HG_DV + RMS_EPS);
    const bf16* pr = Pb + (size_t)t * PP;
    float o = v * r * onorm_g[c & 127];
    Yb[(size_t)t * D_MODEL + c] = (bf16)f2bf(o * sigmoidf_(bf2f(pr[C_HGO + c])) * siluf_(bf2f(pr[C_HZ + c])));
}
__global__ void k_cmp_hidden(const bf16* __restrict__ Pb, const float* __restrict__ pe, const float* __restrict__ w1, float* __restrict__ hid) {
    int i = blockIdx.x * blockDim.x + threadIdx.x;
    if (i >= 2 * KVH * NC * CMP_HIDDEN) return;
    int n = i % CMP_HIDDEN, c = (i / CMP_HIDDEN) % NC, g = (i / (CMP_HIDDEN * NC)) % KVH, kv = i / (CMP_HIDDEN * NC * KVH);
    int col = (kv == 0 ? C_KCM : C_VCM) + g * DH;
    const float* pek = pe + (size_t)kv * CMP_BLOCK * DH;
    const float* w = w1 + (size_t)kv * CMP_BLOCK * DH * CMP_HIDDEN;
    float acc = 0.f;
    for (int l = 0; l < CMP_BLOCK; ++l) {
        const bf16* pr = Pb + (size_t)(c * CMP_STRIDE + l) * PP + col;
        for (int j = 0; j < DH; ++j) acc = fmaf(bf2f(pr[j]) + pek[l * DH + j], w[(size_t)(l * DH + j) * CMP_HIDDEN + n], acc);
    }
    hid[i] = siluf_(acc);
}
__global__ void k_cmp_out(const float* __restrict__ hid, const float* __restrict__ w2, const float* __restrict__ kg0, float* __restrict__ kvc, bf16* __restrict__ KCb, bf16* __restrict__ VCb) {
    int i = blockIdx.x * blockDim.x + threadIdx.x;
    if (i >= 2 * KVH * NC) return;
    int kv = i / (KVH * NC);
    const float* hrow = hid + (size_t)i * CMP_HIDDEN;
    const float* w = w2 + (size_t)kv * CMP_HIDDEN * DH;
    float out[DH];
#pragma unroll
    for (int j = 0; j < DH; ++j) out[j] = 0.f;
    for (int n = 0; n < CMP_HIDDEN; ++n) {
        float hv = hrow[n];
#pragma unroll
        for (int j = 0; j < DH; ++j) out[j] = fmaf(hv, w[n * DH + j], out[j]);
    }
    float r = 1.f;
    if (kv == 0) {
        float ss = 0.f;
#pragma unroll
        for (int j = 0; j < DH; ++j) ss += out[j] * out[j];
        r = rsqrtf(ss / (float)DH + RMS_EPS);
    }
    const int g_ = (i / NC) % KVH, cc_ = i % NC;
    bf16* dst = (kv == 0 ? KCb : VCb) + ((size_t)g_ * 256 + cc_) * DH;
#pragma unroll
    for (int j = 0; j < DH; ++j) { const float v = (kv == 0) ? out[j] * r * kg0[j] : out[j]; kvc[(size_t)i * DH + j] = v; dst[j] = (bf16)f2bf(v); }
}
__global__ void k_cmp_consts(bf16* __restrict__ OV, bf16* __restrict__ KC, bf16* __restrict__ VC) {
    int i = blockIdx.x * blockDim.x + threadIdx.x;
    if (i < 256 * 64) {
        const int c = i >> 6, j = i & 63;
        float v = 0.f;
        if (c < NC) { const int j0 = (16 * c) >> 6, j1 = (16 * c + 31) >> 6; if (j0 == j1) v = (j == j0) ? 1.f : 0.f; else v = (j == j0 || j == j1) ? 0.5f : 0.f; }
        OV[i] = (bf16)f2bf(v);
    }
    if (i < BATCH * KVH * 64) { const int bg = i >> 6, j = i & 63; KC[((size_t)bg * 256 + 255) * 64 + j] = 0; VC[((size_t)bg * 256 + 255) * 64 + j] = 0; }
}
constexpr int ATT_LDS = 149504 + 256;
template <int MODE>
__global__ void __launch_bounds__(512, 2) k_attn(att::AttnIO io) {
    extern __shared__ __attribute__((aligned(16))) unsigned char lds[];
    const int c = blockIdx.x, bk = c >> 5, s = c & 31;
    att::attn_unit<MODE, 8>(bk >> 1, bk & 1, 63 - s, io, (char*)lds);
    att::attn_unit<MODE, 8>(bk >> 1, bk & 1, s, io, (char*)lds);
}
constexpr int HG_LDS = hg::L_END;
__global__ void __launch_bounds__(512, 2) k_hgrn_state(hg::HgIO io) {
    extern __shared__ __attribute__((aligned(16))) unsigned char lds[];
    hg::hgrn_state_item(io, blockIdx.x, (char*)lds);
}
__global__ void __launch_bounds__(512, 2) k_hgrn_scan2(hg::HgIO io) { hg::hgrn_scan_item(io, blockIdx.x); }
__global__ void __launch_bounds__(512, 2) k_hgrn_out2(hg::HgIO io) {
    extern __shared__ __attribute__((aligned(16))) unsigned char lds[];
    hg::hgrn_out_item(io, blockIdx.x, (char*)lds);
}
constexpr int CMP_LDS = cp::L_END;
__global__ void __launch_bounds__(512, 2) k_cmp_mfma(cp::CmpIO io) {
    extern __shared__ __attribute__((aligned(16))) unsigned char lds[];
    cp::cmp_item(io, blockIdx.x, (char*)lds);
}
__global__ void k_cmp_bias(const float* __restrict__ pe, const float* __restrict__ w1, float* __restrict__ bias1) {
    const int i = threadIdx.x, kv = i >> 7, n = i & 127;
    const float* pk = pe + (size_t)kv * 2048; const float* w = w1 + (size_t)kv * 2048 * 128;
    float acc = 0.f;
    for (int k = 0; k < 2048; ++k) acc = fmaf(pk[k], w[(size_t)k * 128 + n], acc);
    bias1[i] = acc;
}
extern "C" void kernel_launch(void* const* d_in, const int* in_sizes, int n_in, void* d_out, int out_size, void* d_ws, size_t ws_size, hipStream_t stream) {
    const float* x = (const float*)d_in[0];
    const float* p = (const float*)d_in[1];
    const float* norm_g = (const float*)d_in[2];
    const float* w_in = (const float*)d_in[3];
    const float* hgrn_lb = (const float*)d_in[4];
    const float* hgrn_onorm_g = (const float*)d_in[5];
    const float* nsa_qnorm_g = (const float*)d_in[6];
    const float* nsa_knorm_g = (const float*)d_in[7];
    const float* cmp_pe = (const float*)d_in[8];
    const float* cmp_w1 = (const float*)d_in[9];
    const float* cmp_w2 = (const float*)d_in[10];
    const float* w_out = (const float*)d_in[11];
    const float* ple_norm_g = (const float*)d_in[12];
    const float* w_pg = (const float*)d_in[13];
    const float* w_pp = (const float*)d_in[14];
    float* h = (float*)d_out;
    unsigned char* ws = (unsigned char*)d_ws;
    constexpr size_t MiB = 1u << 20;
    bf16* WIN_T = (bf16*)(ws + 1 * MiB);
    bf16* WOUT_T = (bf16*)(ws + 10 * MiB);
    bf16* WPG_T = (bf16*)(ws + 12 * MiB);
    bf16* WPP_T = (bf16*)(ws + 14 * MiB);
    bf16* W1T = (bf16*)(ws + 15 * MiB);
    float* lb_all = (float*)(ws + 16 * MiB);
    float* ropec = lb_all + DEPTH * HG_W;
    float* ropes = ropec + SEQ * 8;
    float* RSA = (float*)(ws + 17 * MiB);
    float* RSB = (float*)(ws + 18 * MiB);
    bf16* BUF[2] = {(bf16*)(ws + 20 * MiB), (bf16*)(ws + 52 * MiB)};
    bf16* PB = (bf16*)(ws + 84 * MiB);
    bf16* T2 = (bf16*)(ws + 92 * MiB);
    bf16* P = (bf16*)(ws + 108 * MiB);
    bf16* PPb = P;
    float* misc = (float*)(ws + 248 * MiB);
    size_t off = 0;
    auto take = [&](size_t n) { float* r = misc + off; off += (n + 63) & ~(size_t)63; return r; };
    float* SLOC = take((size_t)16 * hg::HG_NG * 8 * 2048);
    float* DGL = take((size_t)16 * hg::HG_NG * 128);
    bf16* W2T = (bf16*)take((size_t)2 * 64 * 128 / 2);
    float* BIAS1 = take(256);
    unsigned long long* selmask = (unsigned long long*)take((size_t)BATCH * KVH * SEQ * 2);
    bf16* KC = (bf16*)take((size_t)BATCH * KVH * 256 * 64 / 2);
    bf16* VC = (bf16*)take((size_t)BATCH * KVH * 256 * 64 / 2);
    bf16* OV = (bf16*)take((size_t)256 * 64 / 2);
    if (248 * MiB + off * 4 > ws_size) { fprintf(stderr, "workspace too small: need %zu have %zu\n", 248 * MiB + off * 4, ws_size); return; }

    static bool attr_set = false;
    if (!attr_set) {
        (void)hipFuncSetAttribute((const void*)k_gemm_phase, hipFuncAttributeMaxDynamicSharedMemorySize, GEMM_LDS);
        (void)hipFuncSetAttribute((const void*)k_cmp_mfma, hipFuncAttributeMaxDynamicSharedMemorySize, CMP_LDS);
        (void)hipFuncSetAttribute((const void*)k_hgrn_state, hipFuncAttributeMaxDynamicSharedMemorySize, HG_LDS);
        (void)hipFuncSetAttribute((const void*)k_hgrn_out2, hipFuncAttributeMaxDynamicSharedMemorySize, HG_LDS);
        (void)hipFuncSetAttribute((const void*)k_attn<0>, hipFuncAttributeMaxDynamicSharedMemorySize, ATT_LDS);
        (void)hipFuncSetAttribute((const void*)k_attn<1>, hipFuncAttributeMaxDynamicSharedMemorySize, ATT_LDS);
        (void)hipFuncSetAttribute((const void*)k_attn<2>, hipFuncAttributeMaxDynamicSharedMemorySize, ATT_LDS);
        attr_set = true;
    }

    k_prep_x<<<MROWS / 4, 256, 0, stream>>>(x, h, BUF[0], RSB);
    k_tables<<<(SEQ * 8 + 255) / 256, 256, 0, stream>>>(hgrn_lb, lb_all, ropec, ropes);
    k_cmp_consts<<<64, 256, 0, stream>>>(OV, KC, VC);
    (void)hipMemsetAsync(WIN_T + (size_t)SRC_NGATE_END * D_MODEL, 0, (size_t)104 * D_MODEL * 2, stream);
    (void)hipMemsetAsync(WIN_T + (size_t)4480 * D_MODEL, 0, (size_t)128 * D_MODEL * 2, stream);

    int cur = 0;
    for (int i = 0; i < DEPTH; ++i) {
        k_transpose_w<<<512, 256, 0, stream>>>(w_in + (size_t)i * D_MODEL * IN_COLS, D_MODEL, IN_COLS, WIN_T, norm_g + i * D_MODEL, 1);
        k_transpose_w<<<256, 256, 0, stream>>>(w_out + (size_t)i * D_MODEL * D_MODEL, D_MODEL, D_MODEL, WOUT_T, nullptr, 0);
        k_transpose_w<<<256, 256, 0, stream>>>(w_pg + (size_t)i * D_MODEL * D_MODEL, D_MODEL, D_MODEL, WPG_T, ple_norm_g + i * D_MODEL, 0);
        k_transpose_w<<<128, 256, 0, stream>>>(w_pp + (size_t)i * PLE * D_MODEL, PLE, D_MODEL, WPP_T, nullptr, 0);
        k_f32_to_bf16<<<(MROWS * PLE / 4 + 255) / 256, 256, 0, stream>>>(p + (size_t)i * MROWS * PLE, PB, MROWS * PLE / 4);
        for (int kv = 0; kv < 2; ++kv) {
            k_transpose_w<<<128, 256, 0, stream>>>(cmp_w1 + (size_t)(i * 2 + kv) * 2048 * 128, 2048, 128, W1T + (size_t)kv * 128 * 2048, nullptr, 0);
            k_transpose_w<<<4, 256, 0, stream>>>(cmp_w2 + (size_t)(i * 2 + kv) * 128 * 64, 128, 64, W2T + (size_t)kv * 64 * 128, nullptr, 0);
        }
        k_cmp_bias<<<1, 256, 0, stream>>>(cmp_pe + (size_t)i * 2 * 2048, cmp_w1 + (size_t)i * 2 * 2048 * 128, BIAS1);
        bf16* HB = BUF[cur];
        bf16* Y = BUF[cur ^ 1];
        { GemmArgs a{}; a.A = HB; a.Bt = WIN_T; a.M = MROWS; a.N = NPROJ; a.K = D_MODEL; a.mode = 0; a.O16 = P; a.RSi = RSB;
          k_gemm_phase<<<256, 512, GEMM_LDS, stream>>>(a); }
        k_nsa_prep<<<(MROWS * 12 + 255) / 256, 256, 0, stream>>>(P, nsa_qnorm_g + i * DH, nsa_knorm_g + (size_t)i * 3 * DH, ropec, ropes);
        { cp::CmpIO cio{}; cio.P = P; cio.W1T = W1T; cio.W2T = W2T; cio.BIAS1 = BIAS1; cio.kg0 = nsa_knorm_g + (size_t)i * 3 * DH; cio.KC = KC; cio.VC = VC;
          k_cmp_mfma<<<128, 512, CMP_LDS, stream>>>(cio); }
        { hg::HgIO hio{}; hio.P = P; hio.Y = Y; hio.lb_l = lb_all + i * HG_W; hio.onorm_g = hgrn_onorm_g + i * HG_DV; hio.SLOC = SLOC; hio.DGL = DGL;
          k_hgrn_state<<<256, 512, HG_LDS, stream>>>(hio);
          k_hgrn_scan2<<<128, 512, 0, stream>>>(hio);
          k_hgrn_out2<<<256, 512, HG_LDS, stream>>>(hio); }
        att::AttnIO io{}; io.P = P; io.KC = KC; io.VC = VC; io.Y = Y; io.T2 = T2; io.selmask = selmask; io.ropec = ropec; io.ropes = ropes; io.pass = 0;
        k_attn<2><<<256, 512, ATT_LDS, stream>>>(io);
        { att::AttnIO io1 = io; io1.VC = OV; io1.pass = 1; k_attn<2><<<256, 512, ATT_LDS, stream>>>(io1); }
        k_attn<1><<<256, 512, ATT_LDS, stream>>>(io);
        k_attn<0><<<256, 512, ATT_LDS, stream>>>(io);
        { GemmArgs a{}; a.A = PB; a.Bt = WPP_T; a.M = MROWS; a.N = D_MODEL; a.K = PLE; a.mode = 1; a.O16 = PPb;
          k_gemm_phase<<<256, 512, GEMM_LDS, stream>>>(a); }
        { GemmArgs a{}; a.A = Y; a.Bt = WOUT_T; a.M = MROWS; a.N = D_MODEL; a.K = D_MODEL; a.mode = 2; a.O16 = HB; a.H = h; a.RSo = RSA;
          k_gemm_phase<<<256, 512, GEMM_LDS, stream>>>(a); }
        { GemmArgs a{}; a.A = HB; a.Bt = WPG_T; a.M = MROWS; a.N = D_MODEL; a.K = D_MODEL; a.mode = 3; a.O16 = (i + 1 < DEPTH) ? Y : nullptr; a.H = h; a.RSi = RSA;
          a.RSo = (i + 1 < DEPTH) ? RSB : nullptr; a.PPb = PPb;
          k_gemm_phase<<<256, 512, GEMM_LDS, stream>>>(a); }
        cur ^= 1;
    }
}
```

```cpp
#include <hip/hip_runtime.h>
#include <stdint.h>
#include <cstdio>

constexpr int D_MODEL = 1024, BATCH = 4, SEQ = 4096, DEPTH = 4, MROWS = BATCH * SEQ;
constexpr int HG_HEADS = 4, HG_DK = 128, HG_DV = 128, HG_W = 512;
constexpr int NSA_HEADS = 8, KVH = 2, DH = 64, GRP = 4, NSA_W = 512, KV_W = 128;
constexpr int CMP_BLOCK = 32, CMP_STRIDE = 16, CMP_HIDDEN = 128, SLC_BLOCK = 64, SLC_TOPK = 16, WINDOW = 512;
constexpr int NC = (SEQ - CMP_BLOCK) / CMP_STRIDE + 1;
constexpr int NSB = SEQ / SLC_BLOCK;
constexpr int PLE = 256;
constexpr int IN_COLS = 4376;
constexpr int NPROJ = 4608;
constexpr int PP = 4480;
constexpr float RMS_EPS = 1e-6f;
constexpr int C_HQ = 0, C_HF = 512, C_HI = 1024, C_HGO = 1536, C_HZ = 2048, C_NQ = 2560, C_KCM = 3072, C_VCM = 3200,
              C_KSL = 3328, C_VSL = 3456, C_KWN = 3584, C_VWN = 3712, C_NGATE = 3840, C_NZ = 3968;
constexpr int SRC_NGATE_END = 3864;

typedef unsigned short bf16;
#define LAS __attribute__((address_space(3)))
__device__ __forceinline__ int opq_tid() { int t = threadIdx.x; asm volatile("" : "+v"(t)); return t; }
typedef float f32x16_g __attribute__((ext_vector_type(16)));
__device__ __forceinline__ f32x16_g zero16() { float z; asm volatile("v_mov_b32 %0, 0" : "=v"(z)); f32x16_g r = {z, z, z, z, z, z, z, z, z, z, z, z, z, z, z, z}; return r; }
__device__ __forceinline__ float bf2f(bf16 v) { return __uint_as_float((unsigned)v << 16); }
__device__ __forceinline__ unsigned f2bf(float f) { unsigned u = __float_as_uint(f); return (u + 0x7fffu + ((u >> 16) & 1u)) >> 16; }
__device__ __forceinline__ unsigned pk2(float lo, float hi) { return f2bf(lo) | (f2bf(hi) << 16); }
__device__ __forceinline__ float sigmoidf_(float x) { return 1.f / (1.f + expf(-x)); }
__device__ __forceinline__ float siluf_(float x) { return x * sigmoidf_(x); }
__device__ __forceinline__ float fast_sigmoid(float x) { return __builtin_amdgcn_rcpf(1.f + __builtin_amdgcn_exp2f(-1.4426950408889634f * x)); }

namespace pg8 {
#define PG8_LAS __attribute__((address_space(3)))
typedef unsigned short bf16_t;
typedef short bf16x8 __attribute__((ext_vector_type(8)));
typedef float f32x4 __attribute__((ext_vector_type(4)));
typedef unsigned u32x4 __attribute__((ext_vector_type(4)));
constexpr int BM = 256, BK = 64, HALF = 128, HTB = HALF * BK * 2  , STAGE_BYTES = 8 * HTB, NXCD = 8, WGM = 8;

__host__ __device__ __forceinline__ int lds_byte(int r, int c) { const int st = (r >> 4) * 2 + (c >> 5), rr = r & 15, cc = c & 31, ob = rr * 64 + cc * 2; return st * 1024 + (ob ^ (((ob >> 9) & 1) << 5)); }
__host__ __device__ __forceinline__ void stage_rc(int b, int& R, int& C) { const int st = b / 1024, sb = b % 1024, swz = sb ^ (((sb >> 9) & 1) << 5); R = (st >> 1) * 16 + swz / 64; C = (st & 1) * 32 + (swz % 64) / 2; }
__host__ __device__ __forceinline__ int perm32(int rho) { const int n = rho >> 4, i = rho & 15; return 8 * (i >> 2) + 4 * n + (i & 3); }

struct Unit { int pm, pn; };
struct Gemm { const bf16_t* A; const bf16_t* Bt; int M, N, K; };

struct StaticOrder {
    int nM, nN, nwg, G, c;
    __host__ __device__ void init(int M, int N, int G_, int c_) { nM = M / BM; nN = N / BM; nwg = nM * nN; G = G_; c = c_; }
    __host__ __device__ bool next(int i, Unit& u) const {
        const long L = (long)i * G + c; if (L >= nwg) return false;
        int wgid = (int)L; { const int q = nwg / NXCD, r = nwg % NXCD, xcd = wgid % NXCD, off = wgid / NXCD; wgid = (xcd < r ? xcd * (q + 1) : r * (q + 1) + (xcd - r) * q) + off; }
        const int nig = WGM * nN, gid = wgid / nig, fm = gid * WGM, gsz = (nM - fm) < WGM ? (nM - fm) : WGM;
        u.pm = fm + ((wgid % nig) % gsz); u.pn = (wgid % nig) / gsz; return true;
    }
    __device__ __forceinline__ void a_ready(const Unit&) const {}
    __device__ __forceinline__ void done(const Unit&) const {}
};

__device__ __forceinline__ unsigned cvt_pk_bf16(float lo, float hi) { unsigned r; asm volatile("v_cvt_pk_bf16_f32 %0, %1, %2" : "=v"(r) : "v"(lo), "v"(hi)); return r; }
template <class Epi, class Sched, bool ALIGN_EPI = false, bool SP2 = false>
__device__ __forceinline__ void gemm_phase(PG8_LAS unsigned char* lds, const Gemm g, const Sched& S, const Epi& E) {
    const int tid = opq_tid(), wid = __builtin_amdgcn_readfirstlane(tid >> 6), lane = tid & 63, wr = wid >> 2, wc = wid & 3, fr = lane & 15, fq = lane >> 4;
    const int K = g.K, nt = K / BK;
    unsigned voffA[2], voffB[2];
#pragma unroll
    for (int i = 0; i < 2; ++i) { int R, C; stage_rc(tid * 16 + i * 8192, R, C); const int Rb = Epi::PERM ? ((R & ~31) + perm32(R & 31)) : R;
        voffA[i] = (unsigned)(R * K + C) * 2u; voffB[i] = (unsigned)(Rb * K + C) * 2u; }
    const size_t kstep = (size_t)(BK * 2);
    const size_t hstep = (size_t)HALF * K * 2;
    const size_t tstep = 2 * hstep;
    const unsigned ldsw = (unsigned)wid * 1024u;
    const int aoff = lds_byte(wr * 64 + fr, fq * 8), boff = lds_byte(wc * 32 + fr, fq * 8);
#define PG8_SA(b, h) (((b) * 2 + (h)) * HTB)
#define PG8_SB(b, h) ((4 + (b) * 2 + (h)) * HTB)
#define PG8_STAGE(bufoff, gbase, voff) do { _Pragma("unroll") for (int _i = 0; _i < 2; ++_i) \
        __builtin_amdgcn_global_load_lds((const unsigned*)((const char*)(gbase) + (voff)[_i]), (PG8_LAS unsigned*)(lds + (bufoff) + ldsw + _i * 8192), 16, 0, 0); } while (0)
#define PG8_LDA(dst, b, h) do { _Pragma("unroll") for (int m = 0; m < 4; ++m) _Pragma("unroll") for (int k = 0; k < 2; ++k) dst[m][k] = *(const PG8_LAS bf16x8*)(lds + PG8_SA(b, h) + aoff + m * 2048 + k * 1024); } while (0)
#define PG8_LDB(dst, b, h) do { _Pragma("unroll") for (int n = 0; n < 2; ++n) _Pragma("unroll") for (int k = 0; k < 2; ++k) dst[n][k] = *(const PG8_LAS bf16x8*)(lds + PG8_SB(b, h) + boff + n * 2048 + k * 1024); } while (0)
#define PG8_MMA(ai, bj, At, Bt) do { __builtin_amdgcn_s_setprio(1); _Pragma("unroll") for (int m = 0; m < 4; ++m) _Pragma("unroll") for (int n = 0; n < 2; ++n) _Pragma("unroll") for (int k = 0; k < 2; ++k) \
        acc[ai][bj][m][n] = __builtin_amdgcn_mfma_f32_16x16x32_bf16(Bt[n][k], At[m][k], acc[ai][bj][m][n], 0, 0, 0); __builtin_amdgcn_s_setprio(0); } while (0)
#define PG8_WAIT_V(n) asm volatile("s_waitcnt vmcnt(" #n ")" ::: "memory")
#define PG8_WAIT_L(n) asm volatile("s_waitcnt lgkmcnt(" #n ")" ::: "memory")
#define PG8_BAR __builtin_amdgcn_s_barrier()
#define PG8_SCHED __builtin_amdgcn_sched_barrier(0)
    Unit cur, nxt; int ui = 0;
    if (!S.next(0, cur)) return;
    f32x4 acc[2][2][4][2];
#pragma unroll
    for (int a = 0; a < 2; ++a)
#pragma unroll
        for (int b = 0; b < 2; ++b)
#pragma unroll
            for (int m = 0; m < 4; ++m)
#pragma unroll
                for (int n = 0; n < 2; ++n) acc[a][b][m][n] = (f32x4){0.f, 0.f, 0.f, 0.f};
    bf16x8 At[4][2], B0[2][2], B1[2][2];
    const char* cA = (const char*)g.A + (size_t)cur.pm * tstep; const char* cB = (const char*)g.Bt + (size_t)cur.pn * tstep;
    S.a_ready(cur);
    if constexpr (SP2) {
        PG8_STAGE(PG8_SB(0, 0), cB, voffB); PG8_STAGE(PG8_SB(0, 1), cB + hstep, voffB); PG8_STAGE(PG8_SA(0, 0), cA, voffA); PG8_STAGE(PG8_SA(0, 1), cA + hstep, voffA);
        if (wr == 1) PG8_BAR;
        PG8_WAIT_V(2); PG8_BAR;
        PG8_STAGE(PG8_SB(1, 0), cB + kstep, voffB); PG8_STAGE(PG8_SA(1, 0), cA + kstep, voffA); PG8_STAGE(PG8_SB(1, 1), cB + hstep + kstep, voffB);
        PG8_WAIT_V(6); PG8_BAR;
    } else {
        PG8_STAGE(PG8_SB(0, 0), cB, voffB); PG8_STAGE(PG8_SA(0, 0), cA, voffA); PG8_STAGE(PG8_SB(0, 1), cB + hstep, voffB); PG8_STAGE(PG8_SA(0, 1), cA + hstep, voffA);
        if (wr == 1) PG8_BAR;
        PG8_WAIT_V(4); PG8_BAR;
        PG8_STAGE(PG8_SB(1, 0), cB + kstep, voffB); PG8_STAGE(PG8_SA(1, 0), cA + kstep, voffA); PG8_STAGE(PG8_SB(1, 1), cB + hstep + kstep, voffB);
        PG8_WAIT_V(6); PG8_BAR;
    }
    for (;;) {
        const bool has_next = S.next(ui + 1, nxt);
        const char* nA = has_next ? (const char*)g.A + (size_t)nxt.pm * tstep : cA; const char* nB = has_next ? (const char*)g.Bt + (size_t)nxt.pn * tstep : cB;
        for (int t = 0; t < nt; t += 2) {
            const bool last = (t == nt - 2);
            const char* a1 = cA + (size_t)(t + 1) * kstep;
            const char* a2 = last ? nA : cA + (size_t)(t + 2) * kstep; const char* b2 = last ? nB : cB + (size_t)(t + 2) * kstep;
            const char* a3 = a2 + kstep; const char* b3 = b2 + kstep;
            if (last && has_next) S.a_ready(nxt);
            if constexpr (SP2) {
            PG8_LDB(B0, 0, 0); PG8_LDB(B1, 0, 1); PG8_SCHED; PG8_LDA(At, 0, 0); PG8_STAGE(PG8_SA(1, 1), a1 + hstep, voffA);
            PG8_WAIT_V(8); PG8_WAIT_L(0); PG8_BAR; PG8_MMA(0, 0, At, B0); PG8_MMA(0, 1, At, B1); PG8_BAR; PG8_SCHED;
            PG8_LDA(At, 0, 1); PG8_STAGE(PG8_SB(0, 0), b2, voffB); PG8_STAGE(PG8_SB(0, 1), b2 + hstep, voffB); PG8_STAGE(PG8_SA(0, 0), a2, voffA);
            PG8_WAIT_V(8); PG8_WAIT_L(0); PG8_BAR; PG8_MMA(1, 0, At, B0); PG8_MMA(1, 1, At, B1); PG8_BAR; PG8_SCHED;
            PG8_LDB(B0, 1, 0); PG8_LDB(B1, 1, 1); PG8_SCHED; PG8_LDA(At, 1, 0); PG8_STAGE(PG8_SA(0, 1), a2 + hstep, voffA);
            PG8_WAIT_V(8); PG8_WAIT_L(0); PG8_BAR; PG8_MMA(0, 0, At, B0); PG8_MMA(0, 1, At, B1); PG8_BAR; PG8_SCHED;
            PG8_LDA(At, 1, 1); PG8_STAGE(PG8_SB(1, 0), b3, voffB); PG8_STAGE(PG8_SB(1, 1), b3 + hstep, voffB); PG8_STAGE(PG8_SA(1, 0), a3, voffA);
            PG8_WAIT_V(8); PG8_WAIT_L(0); PG8_BAR; PG8_MMA(1, 0, At, B0); PG8_MMA(1, 1, At, B1); PG8_BAR; PG8_SCHED;
            } else {
            PG8_LDB(B0, 0, 0); PG8_SCHED; PG8_LDA(At, 0, 0); PG8_STAGE(PG8_SA(1, 1), a1 + hstep, voffA);
            PG8_WAIT_L(8); PG8_BAR; PG8_WAIT_L(0); PG8_MMA(0, 0, At, B0); PG8_BAR; PG8_SCHED;
            PG8_LDB(B1, 0, 1); PG8_STAGE(PG8_SB(0, 0), b2, voffB);
            PG8_BAR; PG8_WAIT_L(0); PG8_MMA(0, 1, At, B1); PG8_BAR;
            PG8_LDA(At, 0, 1); PG8_STAGE(PG8_SA(0, 0), a2, voffA);
            PG8_BAR; PG8_WAIT_L(0); PG8_MMA(1, 0, At, B0); PG8_BAR; PG8_SCHED;
            PG8_STAGE(PG8_SB(0, 1), b2 + hstep, voffB);
            PG8_WAIT_V(6); PG8_BAR; PG8_MMA(1, 1, At, B1); PG8_BAR;
            PG8_LDB(B0, 1, 0); PG8_SCHED; PG8_LDA(At, 1, 0); PG8_STAGE(PG8_SA(0, 1), a2 + hstep, voffA);
            PG8_WAIT_L(8); PG8_BAR; PG8_WAIT_L(0); PG8_MMA(0, 0, At, B0); PG8_BAR; PG8_SCHED;
            PG8_LDB(B1, 1, 1); PG8_STAGE(PG8_SB(1, 0), b3, voffB);
            PG8_BAR; PG8_WAIT_L(0); PG8_MMA(0, 1, At, B1); PG8_BAR;
            PG8_LDA(At, 1, 1); PG8_STAGE(PG8_SA(1, 0), a3, voffA);
            PG8_BAR; PG8_WAIT_L(0); PG8_MMA(1, 0, At, B0); PG8_BAR; PG8_SCHED;
            PG8_STAGE(PG8_SB(1, 1), b3 + hstep, voffB);
            PG8_WAIT_V(6); PG8_BAR; PG8_MMA(1, 1, At, B1); PG8_BAR;
            }
        }
        if constexpr (ALIGN_EPI) { if (wr == 0) PG8_BAR; }
        if constexpr (!Epi::AFTER_DRAIN) { E(acc, cur, wr, wc, fr, fq); S.done(cur); }
        if (!has_next) break;
#pragma unroll
        for (int a = 0; a < 2; ++a)
#pragma unroll
            for (int b = 0; b < 2; ++b)
#pragma unroll
                for (int m = 0; m < 4; ++m)
#pragma unroll
                    for (int n = 0; n < 2; ++n) acc[a][b][m][n] = (f32x4){0.f, 0.f, 0.f, 0.f};
        cur = nxt; cA = nA; cB = nB; ++ui;
        if constexpr (ALIGN_EPI) { if (wr == 1) PG8_BAR; }
    }
    PG8_WAIT_V(0);
    if constexpr (!ALIGN_EPI) { if (wr == 0) PG8_BAR; }
    PG8_BAR;
    if constexpr (Epi::AFTER_DRAIN) { E.fused(acc, cur, wr, wc, fr, fq, lds, wid, lane); S.done(cur); }
#undef PG8_SA
#undef PG8_SB
#undef PG8_STAGE
#undef PG8_LDA
#undef PG8_LDB
#undef PG8_MMA
#undef PG8_WAIT_V
#undef PG8_WAIT_L
#undef PG8_BAR
#undef PG8_SCHED
}
}

namespace pg8 {
typedef unsigned u32x2 __attribute__((ext_vector_type(2)));
__device__ __forceinline__ float row_rstd(const float* rs, int row) {
    const f32x4* p = (const f32x4*)(rs + (size_t)row * 16);
    const f32x4 a = p[0], b = p[1], c = p[2], d = p[3];
    const float s = ((a[0] + a[1]) + (a[2] + a[3])) + ((b[0] + b[1]) + (b[2] + b[3])) + ((c[0] + c[1]) + (c[2] + c[3])) + ((d[0] + d[1]) + (d[2] + d[3]));
    return rsqrtf(s * (1.0f / 1024.0f) + 1e-6f);
}
struct EpiProj {
    static constexpr bool PERM = true, AFTER_DRAIN = false;
    bf16_t* O; int ldc; const float* rs; int ncols_store;
    __device__ __forceinline__ void operator()(const f32x4 (&acc)[2][2][4][2], const Unit& u, int wr, int wc, int fr, int fq) const {
        const int row0 = u.pm * BM + wr * 64 + fr, col0 = u.pn * BM + wc * 32 + 8 * fq;
#pragma unroll
        for (int ai = 0; ai < 2; ++ai)
#pragma unroll
            for (int m = 0; m < 4; ++m) {
                const int row = row0 + ai * HALF + m * 16;
                const float sc = rs ? row_rstd(rs, row) : 1.0f;
                bf16_t* rowp = O + (size_t)row * ldc + col0;
#pragma unroll
                for (int bj = 0; bj < 2; ++bj) {
                    if (col0 + bj * HALF < ncols_store) {
                        const f32x4 v0 = acc[ai][bj][m][0] * sc, v1 = acc[ai][bj][m][1] * sc;
                        u32x4 w; w.x = cvt_pk_bf16(v0[0], v0[1]); w.y = cvt_pk_bf16(v0[2], v0[3]); w.z = cvt_pk_bf16(v1[0], v1[1]); w.w = cvt_pk_bf16(v1[2], v1[3]);
                        *(u32x4*)(rowp + bj * HALF) = w;
                    }
                }
            }
    }
};
struct EpiHnew {
    static constexpr bool PERM = false, AFTER_DRAIN = false;
    float* H; bf16_t* HN; float* RS;
    __device__ __forceinline__ void operator()(const f32x4 (&acc)[2][2][4][2], const Unit& u, int wr, int wc, int fr, int fq) const {
        const int row0 = u.pm * BM + wr * 64 + fr, col0 = u.pn * BM + wc * 32 + 4 * fq;
#pragma unroll
        for (int ai = 0; ai < 2; ++ai)
#pragma unroll
            for (int m = 0; m < 4; ++m) {
                const int row = row0 + ai * HALF + m * 16;
                const size_t off = (size_t)row * 1024 + col0;
                float ss = 0.f;
#pragma unroll
                for (int bj = 0; bj < 2; ++bj)
#pragma unroll
                    for (int n = 0; n < 2; ++n) {
                        const f32x4 h4 = *(const f32x4*)(H + off + bj * HALF + n * 16);
                        const f32x4 v = h4 + acc[ai][bj][m][n];
                        *(f32x4*)(H + off + bj * HALF + n * 16) = v;
                        u32x2 w; w.x = cvt_pk_bf16(v[0], v[1]); w.y = cvt_pk_bf16(v[2], v[3]);
                        *(u32x2*)(HN + off + bj * HALF + n * 16) = w;
                        ss += (v[0] * v[0] + v[1] * v[1]) + (v[2] * v[2] + v[3] * v[3]);
                    }
                ss += __shfl_xor(ss, 16); ss += __shfl_xor(ss, 32);
                if (fq == 0) RS[(size_t)row * 16 + u.pn * 4 + wc] = ss;
            }
    }
};
struct EpiPle {
    static constexpr bool PERM = false, AFTER_DRAIN = false;
    float* H; bf16_t* HB; const float* RSi; float* RSo; const bf16_t* PPb;
    __device__ __forceinline__ void operator()(const f32x4 (&acc)[2][2][4][2], const Unit& u, int wr, int wc, int fr, int fq) const {
        const int row0 = u.pm * BM + wr * 64 + fr, col0 = u.pn * BM + wc * 32 + 4 * fq;
#pragma unroll
        for (int ai = 0; ai < 2; ++ai)
#pragma unroll
            for (int m = 0; m < 4; ++m) {
                const int row = row0 + ai * HALF + m * 16;
                const size_t off = (size_t)row * 1024 + col0;
                const float sc = row_rstd(RSi, row);
                float ss = 0.f;
#pragma unroll
                for (int bj = 0; bj < 2; ++bj)
#pragma unroll
                    for (int n = 0; n < 2; ++n) {
                        const f32x4 h4 = *(const f32x4*)(H + off + bj * HALF + n * 16);
                        const u32x2 pw = *(const u32x2*)(PPb + off + bj * HALF + n * 16);
                        const f32x4 a = acc[ai][bj][m][n] * sc;
                        f32x4 v;
                        v[0] = h4[0] + fast_sigmoid(a[0]) * __uint_as_float(pw.x << 16);
                        v[1] = h4[1] + fast_sigmoid(a[1]) * __uint_as_float(pw.x & 0xffff0000u);
                        v[2] = h4[2] + fast_sigmoid(a[2]) * __uint_as_float(pw.y << 16);
                        v[3] = h4[3] + fast_sigmoid(a[3]) * __uint_as_float(pw.y & 0xffff0000u);
                        *(f32x4*)(H + off + bj * HALF + n * 16) = v;
                        if (HB) { u32x2 w; w.x = cvt_pk_bf16(v[0], v[1]); w.y = cvt_pk_bf16(v[2], v[3]); *(u32x2*)(HB + off + bj * HALF + n * 16) = w; }
                        ss += (v[0] * v[0] + v[1] * v[1]) + (v[2] * v[2] + v[3] * v[3]);
                    }
                if (RSo) {
                    ss += __shfl_xor(ss, 16); ss += __shfl_xor(ss, 32);
                    if (fq == 0) RSo[(size_t)row * 16 + u.pn * 4 + wc] = ss;
                }
            }
    }
};
}

namespace att {
using bf16x8 = __attribute__((ext_vector_type(8))) short;
using s16x4 = __attribute__((ext_vector_type(4))) short;
using f32x16 = __attribute__((ext_vector_type(16))) float;
using u32x4 = __attribute__((ext_vector_type(4))) unsigned;
constexpr int NW = 8, QBLK = 32, KVBLK = 64;
__device__ __forceinline__ int crow(int r, int hi) { return (r & 3) + 8 * (r >> 2) + 4 * hi; }
#define SBAR() __builtin_amdgcn_sched_barrier(0)
constexpr int NSLOT = 3, SLOTB = 8192;
constexpr int LDS_K = 0, LDS_V = NSLOT * SLOTB, LDS_WS = 2 * NSLOT * SLOTB, LDS_OST = LDS_WS + NW * 64 * 4, LDS_IMP = LDS_OST + NW * 4096, LDS_BYTES = LDS_IMP + 65536;
constexpr float C2 = 0.125f * 1.4426950408889634f;
__device__ __forceinline__ void glds16(const void* gsrc, unsigned lds_dst) { unsigned keep;
  asm volatile("s_mov_b32 %0, m0\n\ts_mov_b32 m0, %2\n\ts_nop 0\n\tglobal_load_lds_dwordx4 %1, off\n\ts_mov_b32 m0, %0" : "=&s"(keep) : "v"(gsrc), "s"(lds_dst) : "memory"); }
__device__ __forceinline__ float max3f(float a, float b, float c) { float r; asm("v_max3_f32 %0, %1, %2, %3" : "=v"(r) : "v"(a), "v"(b), "v"(c)); return r; }
__device__ __forceinline__ float max2f(float a, float b) { float r; asm("v_max_f32_e32 %0, %1, %2" : "=v"(r) : "v"(a), "v"(b)); return r; }
__device__ __forceinline__ float fadd_s(float a, float b) { float r; asm("v_add_f32_e32 %0, %1, %2" : "=v"(r) : "v"(a), "v"(b)); return r; }
__device__ __forceinline__ float fsub_s(float a, float b) { float r; asm("v_sub_f32_e32 %0, %1, %2" : "=v"(r) : "v"(a), "v"(b)); return r; }
typedef float f32x2_t __attribute__((ext_vector_type(2))); typedef __bf16 bf16x2_t __attribute__((ext_vector_type(2)));
__device__ __forceinline__ unsigned cvtpk_s(float lo, float hi) { f32x2_t v = {lo, hi}; bf16x2_t b = __builtin_convertvector(v, bf16x2_t); return __builtin_bit_cast(unsigned, b); }
#define WAIT_BAR(N) asm volatile("s_waitcnt vmcnt(" #N ") lgkmcnt(0)\n\ts_barrier" ::: "memory")

__device__ __forceinline__ void qkt(f32x16& p0, f32x16& p1, const char* Kslot, const bf16x8* qr, const f32x16& negm, int r32, int hi) {
  const char* kb = Kslot + hi * 1024 + r32 * 16;
#pragma unroll
  for (int d0 = 0; d0 < 4; ++d0) {
    const bf16x8 b0 = *reinterpret_cast<const bf16x8*>(kb + d0 * 2048);
    const bf16x8 b1 = *reinterpret_cast<const bf16x8*>(kb + d0 * 2048 + 512);
    if (d0 == 0) { p0 = __builtin_amdgcn_mfma_f32_32x32x16_bf16(b0, qr[0], negm, 0, 0, 0); p1 = __builtin_amdgcn_mfma_f32_32x32x16_bf16(b1, qr[0], negm, 0, 0, 0); }
    else { p0 = __builtin_amdgcn_mfma_f32_32x32x16_bf16(b0, qr[d0], p0, 0, 0, 0); p1 = __builtin_amdgcn_mfma_f32_32x32x16_bf16(b1, qr[d0], p1, 0, 0, 0); } }
}
typedef __attribute__((address_space(3))) const char* lds_cptr;
typedef short v4i16_t __attribute__((ext_vector_type(4)));
__device__ __forceinline__ void kload8(bf16x8* kf, lds_cptr kp) {
  kf[0] = *(const __attribute__((address_space(3))) bf16x8*)(kp);        kf[1] = *(const __attribute__((address_space(3))) bf16x8*)(kp + 512);
  kf[2] = *(const __attribute__((address_space(3))) bf16x8*)(kp + 2048); kf[3] = *(const __attribute__((address_space(3))) bf16x8*)(kp + 2560);
  kf[4] = *(const __attribute__((address_space(3))) bf16x8*)(kp + 4096); kf[5] = *(const __attribute__((address_space(3))) bf16x8*)(kp + 4608);
  kf[6] = *(const __attribute__((address_space(3))) bf16x8*)(kp + 6144); kf[7] = *(const __attribute__((address_space(3))) bf16x8*)(kp + 6656);
}
__device__ __forceinline__ void kload2(bf16x8* kf, lds_cptr kp, int j) { kf[2 * j] = *(const __attribute__((address_space(3))) bf16x8*)(kp + j * 2048); kf[2 * j + 1] = *(const __attribute__((address_space(3))) bf16x8*)(kp + j * 2048 + 512); }
__device__ __forceinline__ s16x4 vtr(lds_cptr p) { return __builtin_bit_cast(s16x4, __builtin_amdgcn_ds_read_tr16_b64_v4i16((__attribute__((address_space(3))) v4i16_t*)p)); }
__device__ __forceinline__ float rowmax(const f32x16& p0, const f32x16& p1) {
  float a = max3f(p0[0], p0[1], p1[0]), b = max3f(p0[2], p0[3], p1[1]); a = max3f(a, p1[2], p1[3]);
#pragma unroll
  for (int r = 4; r < 16; r += 4) { a = max3f(a, p0[r], p0[r + 1]); b = max3f(b, p0[r + 2], p0[r + 3]); a = max3f(a, p1[r], p1[r + 1]); b = max3f(b, p1[r + 2], p1[r + 3]); }
  const float m = max2f(a, b);
  auto rr = __builtin_amdgcn_permlane32_swap(__float_as_uint(m), __float_as_uint(m), false, false);
  return max2f(__uint_as_float(rr[0]), __uint_as_float(rr[1]));
}
__device__ __forceinline__ void pv(f32x16* o, int vb, bf16x8 pa0, bf16x8 pa1, bf16x8 pa2, bf16x8 pa3) {
#pragma unroll
  for (int d0 = 0; d0 < 2; ++d0) { s16x4 lo[4], hi[4];
#pragma unroll
    for (int ks = 0; ks < 4; ++ks) {
      asm volatile("ds_read_b64_tr_b16 %0,%1 offset:%c2" : "=&v"(lo[ks]) : "v"(vb), "i"(d0 * 4096 + ks * 1024) : "memory");
      asm volatile("ds_read_b64_tr_b16 %0,%1 offset:%c2" : "=&v"(hi[ks]) : "v"(vb), "i"(d0 * 4096 + ks * 1024 + 512) : "memory"); }
    asm volatile("s_waitcnt lgkmcnt(0)" ::: "memory"); SBAR();
#define PK(k) (bf16x8){lo[k][0], lo[k][1], lo[k][2], lo[k][3], hi[k][0], hi[k][1], hi[k][2], hi[k][3]}
    o[d0] = __builtin_amdgcn_mfma_f32_32x32x16_bf16(pa0, PK(0), o[d0], 0, 0, 0);
    o[d0] = __builtin_amdgcn_mfma_f32_32x32x16_bf16(pa1, PK(1), o[d0], 0, 0, 0);
    o[d0] = __builtin_amdgcn_mfma_f32_32x32x16_bf16(pa2, PK(2), o[d0], 0, 0, 0);
    o[d0] = __builtin_amdgcn_mfma_f32_32x32x16_bf16(pa3, PK(3), o[d0], 0, 0, 0);
#undef PK
  }
}
__device__ __forceinline__ void mask_gt(f32x16& p0, f32x16& p1, int thr, int hi) {
  const float NEG = -INFINITY; const int th = thr - 4 * hi;
#pragma unroll
  for (int r = 0; r < 16; ++r) { const int kc = (r & 3) + 8 * (r >> 2); if (kc > th) p0[r] = NEG; if (kc + 32 > th) p1[r] = NEG; }
}
__device__ __forceinline__ void mask_both(f32x16& p0, f32x16& p1, int tg, int tl, int hi) {
  const float NEG = -INFINITY; const int g = tg - 4 * hi, l = tl - 4 * hi;
#pragma unroll
  for (int r = 0; r < 16; ++r) { const int kc = (r & 3) + 8 * (r >> 2); if (kc > g || kc <= l) p0[r] = NEG; if (kc + 32 > g || kc + 32 <= l) p1[r] = NEG; }
}
struct AttnIO {
  bf16* P;
  const bf16* KC;
  const bf16* VC;
  bf16* Y;
  bf16* T2;
  unsigned long long* selmask;
  const float* ropec; const float* ropes;
  int pass;
};

template <int MODE, int THRL>
__device__ __forceinline__ void attn_unit(int b, int kvh, int qb, const AttnIO& io, char* shm) {
  const int tid = opq_tid(), lane = tid & 63, r32 = lane & 31, hi = lane >> 5; const int wid = __builtin_amdgcn_readfirstlane(tid >> 6);
  const int head = kvh * 4 + (wid >> 1);
  const long rowbase = (long)b * SEQ; const int q0 = qb * 64 + (wid & 1) * 32;
  const int ql = (wid & 1) * 32 + r32;
  const int tq = qb * 64 + ql;
  const bf16* Qw = io.P + (rowbase + q0) * PP + C_NQ + head * 64;
  const bf16* Kh; const bf16* Vh; long kpitch, vpitch;
  if (MODE == 0) { Kh = io.P + rowbase * PP + C_KSL + kvh * 64; Vh = io.P + rowbase * PP + C_VSL + kvh * 64; kpitch = PP; vpitch = PP; }
  else if (MODE == 1) { Kh = io.P + rowbase * PP + C_KWN + kvh * 64; Vh = io.P + rowbase * PP + C_VWN + kvh * 64; kpitch = PP; vpitch = PP; }
  else { Kh = io.KC + (long)(b * KVH + kvh) * 256 * 64; Vh = (io.pass == 0) ? io.VC + (long)(b * KVH + kvh) * 256 * 64 : io.VC; kpitch = 64; vpitch = 64; }
  const int NTr = (MODE == 0) ? qb + 1 : (MODE == 1) ? ((qb < 8 ? qb : 8) + 1) : 4;
  const int NT = (NTr < 4) ? 4 : ((NTr + 1) & ~1);
#define MEMTILE(i) ((MODE == 0) ? ((i) < qb ? (i) : qb) : (MODE == 1) ? ((qb - (i)) > 0 ? (qb - (i)) : 0) : (i))
  const unsigned lds0 = (unsigned)(uintptr_t)shm;
  float* wsf = (float*)(shm + LDS_WS) + wid * 64;
  const bf16* ksrc = Kh + (long)lane * kpitch + wid * 8;
  const bf16* vsrc = Vh + (long)(16 * (wid & 3) + (lane >> 2)) * vpitch + (wid >> 2) * 32 + (lane & 3) * 8;
  const unsigned kdst = lds0 + LDS_K + wid * 1024, vdst = lds0 + LDS_V + wid * 1024;
#define DMA_K(t, slot) glds16(ksrc + (long)MEMTILE(t) * KVBLK * kpitch, (unsigned)__builtin_amdgcn_readfirstlane(kdst + (slot)))
#define DMA_V(t, slot) glds16(vsrc + (long)MEMTILE(t) * KVBLK * vpitch, (unsigned)__builtin_amdgcn_readfirstlane(vdst + (slot)))
  const int vb0 = (int)(lds0 + LDS_V) + ((lane >> 4) & 1) * 32 + (lane & 3) * 8 + (4 * hi + ((lane & 15) >> 2)) * 64;
  const char* Kbase = shm + LDS_K; bf16x8 kf[8];
  const lds_cptr shm3 = (lds_cptr)shm; const lds_cptr kp0 = shm3 + LDS_K + hi * 1024 + r32 * 16; const lds_cptr vp0 = shm3 + LDS_V + ((lane >> 4) & 1) * 32 + (lane & 3) * 8 + (4 * hi + ((lane & 15) >> 2)) * 64;
  DMA_K(0, 0); DMA_V(0, 0); DMA_K(1, SLOTB);
  bf16x8 qr[4];
#pragma unroll
  for (int d0 = 0; d0 < 4; ++d0) qr[d0] = *reinterpret_cast<const bf16x8*>(&Qw[(long)r32 * PP + d0 * 16 + hi * 8]);
  if (MODE != 2) {
    const u32x4 own = __builtin_bit_cast(u32x4, qr[0]);
    u32x4 par;
#pragma unroll
    for (int k = 0; k < 4; ++k) { auto rr = __builtin_amdgcn_permlane32_swap(own[k], own[k], false, false); par[k] = hi ? rr[0] : rr[1]; }
    const float4 c0 = *(const float4*)(io.ropec + (size_t)tq * 8), c1 = *(const float4*)(io.ropec + (size_t)tq * 8 + 4);
    const float4 s0 = *(const float4*)(io.ropes + (size_t)tq * 8), s1 = *(const float4*)(io.ropes + (size_t)tq * 8 + 4);
    const float cs[8] = {c0.x, c0.y, c0.z, c0.w, c1.x, c1.y, c1.z, c1.w}, sn[8] = {s0.x, s0.y, s0.z, s0.w, s1.x, s1.y, s1.z, s1.w};
    const float sg = hi ? 1.f : -1.f;
    u32x4 res;
#pragma unroll
    for (int k = 0; k < 4; ++k) {
      const float oa = __uint_as_float(own[k] << 16), ob = __uint_as_float(own[k] & 0xffff0000u);
      const float pa = __uint_as_float(par[k] << 16), pb = __uint_as_float(par[k] & 0xffff0000u);
      res[k] = cvtpk_s(oa * cs[2 * k] + sg * pa * sn[2 * k], ob * cs[2 * k + 1] + sg * pb * sn[2 * k + 1]);
    }
    qr[0] = __builtin_bit_cast(bf16x8, res);
  }
  unsigned mlo = 0xffffffffu, mhi_ = 0xffffffffu;
  if (MODE == 0) { const unsigned long long mk = io.selmask[(size_t)(b * KVH + kvh) * SEQ + tq]; mlo = (unsigned)mk; mhi_ = (unsigned)(mk >> 32); }
  int cmaxc = 0; if (MODE == 2) { cmaxc = (tq - 31) >> 4; if (cmaxc < 0) cmaxc = 0; }
  float mhat = 0.f, l_reg = 0.f; f32x16 o[2]; o[0] = zero16(); o[1] = zero16(); f32x16 negm = zero16(); asm volatile("" : "+v"(negm));
#define BMASK(P0, P1, t) do { \
    if (MODE == 0) { if ((t) >= qb) mask_gt(P0, P1, tq - 64 * (t), hi); } \
    else if (MODE == 1) { mask_both(P0, P1, ((t) == 0) ? ql : 1000, ((t) > qb) ? 1000 : ql + 64 * (t) - 512, hi); } \
    else { mask_gt(P0, P1, cmaxc - 64 * (t), hi); } } while (0)
#define NEGSEL(t) do { if (MODE == 0) { const int ti_ = ((t) < qb) ? (t) : qb; const unsigned w_ = (ti_ < 32) ? mlo : mhi_; const bool on_ = (w_ >> (ti_ & 31)) & 1u; \
      const float nm_ = on_ ? -mhat : -INFINITY; _Pragma("unroll") for (int r = 0; r < 16; ++r) negm[r] = nm_; asm volatile("" : "+v"(negm)); } } while (0)
  bool resc = false;
#define START(P0, P1) do { const float rm = rowmax(P0, P1); resc = false; \
    { const float dl = rm; mhat = fadd_s(mhat, dl); \
      _Pragma("unroll") for (int r = 0; r < 16; ++r) { P0[r] = fsub_s(P0[r], dl); P1[r] = fsub_s(P1[r], dl); } \
      _Pragma("unroll") for (int r = 0; r < 16; ++r) negm[r] = -mhat; asm volatile("" : "+v"(negm)); } \
    _Pragma("unroll") for (int r = 0; r < 16; ++r) P0[r] = __builtin_amdgcn_exp2f(P0[r]); } while (0)
#define RESC() do { if (resc) { asm volatile("s_waitcnt lgkmcnt(0)" ::: "memory"); \
      _Pragma("unroll") for (int d_ = 0; d_ < 2; ++d_) _Pragma("unroll") for (int r = 0; r < 16; ++r) o[d_][r] *= wsf[crow(r, hi)]; } } while (0)
  f32x16 pA0, pA1, pB0, pB1;
  int sl_prev = 0, sl_cur = 0, sl_next = SLOTB;
#define ROT() do { sl_prev = sl_cur; sl_cur = sl_next; sl_next = (sl_next == (NSLOT - 1) * SLOTB) ? 0 : sl_next + SLOTB; } while (0)
  DMA_K(2, 2 * SLOTB);
  WAIT_BAR(3);
  qkt(pA0, pA1, Kbase, qr, negm, r32, hi); asm volatile("s_nop 15\n\ts_nop 7" : "+v"(pA0), "+v"(pA1)); BMASK(pA0, pA1, 0);
  START(pA0, pA1);
  _Pragma("unroll") for (int r = 0; r < 16; ++r) pA1[r] = __builtin_amdgcn_exp2f(pA1[r]);
  WAIT_BAR(0);
  DMA_K(3, 0); DMA_V(1, SLOTB);
  ROT();
  kload8(kf, kp0 + sl_cur);
  WAIT_BAR(2);
  s16x4 vlo[8], vhi[8]; u32x4 pw0, pw1, pw2, pw3;
#define PKW(P, B) cvtpk_s(P[B], P[B + 1])
#define PAF(k) __builtin_bit_cast(bf16x8, pw##k)
#define VFR(i) (bf16x8){vlo[i][0], vlo[i][1], vlo[i][2], vlo[i][3], vhi[i][0], vhi[i][1], vhi[i][2], vhi[i][3]}
#define PIN(x) asm volatile("" : "+v"(x))
#define MX3(a, b, c) __builtin_fmaxf(__builtin_fmaxf((a), (b)), (c))
#define GAPA(MF, A0, A1, A2, A3, W0, W1, PW) do { MF; sacc += A0; sacc += A1; sacc += A2; sacc += A3; PIN(sacc); W0; W1; PIN(PW); SBAR(); } while (0)
#define EX(v) __builtin_amdgcn_exp2f(v)
#define GAPB(MF, X, B) do { MF; X[B] = EX(X[B]); X[B + 1] = EX(X[B + 1]); X[B + 2] = EX(X[B + 2]); X[B + 3] = EX(X[B + 3]); PIN(X); SBAR(); } while (0)
#define VRD(i) do { vlo[i] = vtr(vp_ + (((i) >> 2) * 4096 + ((i) & 3) * 1024)); vhi[i] = vtr(vp_ + (((i) >> 2) * 4096 + ((i) & 3) * 1024 + 512)); } while (0)
#define KRD(G, j) do { if (G) { kload2(kf, kp0 + sl_next, j); SBAR(); } } while (0)
#define STEP(C0, C1, P0, P1, t, GK, GV, GL, BAND) do { SBAR(); \
    NEGSEL(t); SBAR(); \
    const lds_cptr vp_ = vp0 + sl_prev; \
    VRD(0); SBAR(); float sacc = (P0[0] + P0[1]); \
    GAPA(C0 = __builtin_amdgcn_mfma_f32_32x32x16_bf16(kf[0], qr[0], negm, 0, 0, 0), P0[2], P0[3], P0[4], P0[5],     pw0[0] = PKW(P0, 0), pw0[1] = PKW(P0, 2), pw0); \
    VRD(4); SBAR(); GAPA(C1 = __builtin_amdgcn_mfma_f32_32x32x16_bf16(kf[1], qr[0], negm, 0, 0, 0), P0[6], P0[7], P0[8], P0[9],     pw0[2] = PKW(P0, 4), pw0[3] = PKW(P0, 6), pw0); \
    VRD(1); SBAR(); GAPA(C0 = __builtin_amdgcn_mfma_f32_32x32x16_bf16(kf[2], qr[1], C0, 0, 0, 0),   P0[10], P0[11], P0[12], P0[13], pw1[0] = PKW(P0, 8), pw1[1] = PKW(P0, 10), pw1); \
    VRD(5); SBAR(); GAPA(C1 = __builtin_amdgcn_mfma_f32_32x32x16_bf16(kf[3], qr[1], C1, 0, 0, 0),   P0[14], P0[15], P1[0], P1[1],   pw1[2] = PKW(P0, 12), pw1[3] = PKW(P0, 14), pw1); \
    VRD(2); SBAR(); GAPA(C0 = __builtin_amdgcn_mfma_f32_32x32x16_bf16(kf[4], qr[2], C0, 0, 0, 0),   P1[2], P1[3], P1[4], P1[5],     pw2[0] = PKW(P1, 0), pw2[1] = PKW(P1, 2), pw2); \
    VRD(6); SBAR(); GAPA(C1 = __builtin_amdgcn_mfma_f32_32x32x16_bf16(kf[5], qr[2], C1, 0, 0, 0),   P1[6], P1[7], P1[8], P1[9],     pw2[2] = PKW(P1, 4), pw2[3] = PKW(P1, 6), pw2); \
    VRD(3); SBAR(); GAPA(C0 = __builtin_amdgcn_mfma_f32_32x32x16_bf16(kf[6], qr[3], C0, 0, 0, 0),   P1[10], P1[11], P1[12], P1[13], pw3[0] = PKW(P1, 8), pw3[1] = PKW(P1, 10), pw3); \
    VRD(7); SBAR(); GAPA(C1 = __builtin_amdgcn_mfma_f32_32x32x16_bf16(kf[7], qr[3], C1, 0, 0, 0),   P1[14], P1[15], 0.f, 0.f,       pw3[2] = PKW(P1, 12), pw3[3] = PKW(P1, 14), pw3); \
    l_reg += sacc; \
    if (GK) { DMA_K((t) + 3, sl_cur); } if (GV) { DMA_V((t) + 1, sl_next); } \
    if (BAND) { BMASK(C0, C1, t); } \
    { float a = MX3(C0[0], C0[1], C1[0]), b = MX3(C0[2], C0[3], C1[1]); a = MX3(a, C1[2], C1[3]); \
      _Pragma("unroll") for (int r = 4; r < 16; r += 4) { a = MX3(a, C0[r], C0[r + 1]); b = MX3(b, C0[r + 2], C0[r + 3]); a = MX3(a, C1[r], C1[r + 1]); b = MX3(b, C1[r + 2], C1[r + 3]); } \
      float rm = __builtin_fmaxf(a, b); { auto rr = __builtin_amdgcn_permlane32_swap(__float_as_uint(rm), __float_as_uint(rm), false, false); rm = __builtin_fmaxf(__uint_as_float(rr[0]), __uint_as_float(rr[1])); } \
      resc = false; \
      if (__builtin_expect(__any(rm > (float)THRL), 0)) { const float dl = __builtin_fmaxf(rm, 0.f); mhat += dl; \
        _Pragma("unroll") for (int r = 0; r < 16; ++r) { C0[r] -= dl; C1[r] -= dl; } \
        _Pragma("unroll") for (int r = 0; r < 16; ++r) negm[r] = -mhat; asm volatile("" : "+v"(negm)); \
        const float f = __builtin_amdgcn_exp2f(-dl); l_reg *= f; if (hi == 0) wsf[r32] = f; resc = true; } } \
    SBAR(); \
    GAPB(o[0] = __builtin_amdgcn_mfma_f32_32x32x16_bf16(PAF(0), VFR(0), o[0], 0, 0, 0), C0, 0); \
    GAPB(o[1] = __builtin_amdgcn_mfma_f32_32x32x16_bf16(PAF(0), VFR(4), o[1], 0, 0, 0), C0, 4); \
    KRD(GL, 0); GAPB(o[0] = __builtin_amdgcn_mfma_f32_32x32x16_bf16(PAF(1), VFR(1), o[0], 0, 0, 0), C0, 8); \
    KRD(GL, 1); GAPB(o[1] = __builtin_amdgcn_mfma_f32_32x32x16_bf16(PAF(1), VFR(5), o[1], 0, 0, 0), C0, 12); \
    KRD(GL, 2); GAPB(o[0] = __builtin_amdgcn_mfma_f32_32x32x16_bf16(PAF(2), VFR(2), o[0], 0, 0, 0), C1, 0); \
    KRD(GL, 3); GAPB(o[1] = __builtin_amdgcn_mfma_f32_32x32x16_bf16(PAF(2), VFR(6), o[1], 0, 0, 0), C1, 4); \
    GAPB(o[0] = __builtin_amdgcn_mfma_f32_32x32x16_bf16(PAF(3), VFR(3), o[0], 0, 0, 0), C1, 8); \
    GAPB(o[1] = __builtin_amdgcn_mfma_f32_32x32x16_bf16(PAF(3), VFR(7), o[1], 0, 0, 0), C1, 12); \
    } while (0)
  int t = 1;
#pragma nounroll
  for (; t + 5 < NT; t += 2) {
    STEP(pB0, pB1, pA0, pA1, t, true, true, true, false);     WAIT_BAR(2); RESC(); ROT();
    STEP(pA0, pA1, pB0, pB1, t + 1, true, true, true, false); WAIT_BAR(2); RESC(); ROT();
  }
#define ENDW(tt) do { if ((tt) + 3 < NT) { WAIT_BAR(2); } else if ((tt) + 2 < NT) { WAIT_BAR(1); } else { WAIT_BAR(0); } } while (0)
#pragma nounroll
  for (; t + 1 < NT; t += 2) {
    STEP(pB0, pB1, pA0, pA1, t, (t + 3 < NT), (t + 1 < NT), (t + 1 < NT), true);       ENDW(t);     RESC(); ROT();
    STEP(pA0, pA1, pB0, pB1, t + 1, (t + 4 < NT), (t + 2 < NT), (t + 2 < NT), true);   ENDW(t + 1); RESC(); ROT();
  }
  STEP(pB0, pB1, pA0, pA1, NT - 1, false, false, false, true); RESC();
  { float sacc = pB0[0] + pB0[1]; _Pragma("unroll") for (int r = 2; r < 16; ++r) sacc += pB0[r]; _Pragma("unroll") for (int r = 0; r < 16; ++r) sacc += pB1[r]; l_reg += sacc;
    pw0 = (u32x4){PKW(pB0, 0), PKW(pB0, 2), PKW(pB0, 4), PKW(pB0, 6)}; pw1 = (u32x4){PKW(pB0, 8), PKW(pB0, 10), PKW(pB0, 12), PKW(pB0, 14)}; pw2 = (u32x4){PKW(pB1, 0), PKW(pB1, 2), PKW(pB1, 4), PKW(pB1, 6)}; pw3 = (u32x4){PKW(pB1, 8), PKW(pB1, 10), PKW(pB1, 12), PKW(pB1, 14)};
    SBAR(); pv(o, vb0 + sl_cur, PAF(0), PAF(1), PAF(2), PAF(3)); }
#undef PKW
#undef PAF
#undef VFR
#undef PIN
#undef MX3
#undef GAPA
#undef GAPB
#undef EX
#undef VRD
#undef KRD
#undef STEP
#undef ENDW
  { auto rr = __builtin_amdgcn_permlane32_swap(__float_as_uint(l_reg), __float_as_uint(l_reg), false, false); l_reg = __uint_as_float(rr[0]) + __uint_as_float(rr[1]); }
  if (hi == 0) wsf[32 + r32] = l_reg; asm volatile("s_waitcnt lgkmcnt(0)" ::: "memory");
  float rli[16];
#pragma unroll
  for (int r = 0; r < 16; ++r) rli[r] = __builtin_amdgcn_rcpf(wsf[32 + crow(r, hi)]);
  if (MODE == 2 && io.pass == 1) {
    float* imp = (float*)(shm + LDS_IMP) + ((wid >> 1) * 64 + (wid & 1) * 32) * 64;
#pragma unroll
    for (int r = 0; r < 16; ++r) { const int orow = crow(r, hi); const bool valid = (qb * 64 + (wid & 1) * 32 + orow) >= 31;
#pragma unroll
      for (int d0 = 0; d0 < 2; ++d0) imp[orow * 64 + d0 * 32 + r32] = valid ? o[d0][r] * rli[r] : 0.f; }
    asm volatile("s_waitcnt lgkmcnt(0)\n\ts_barrier" ::: "memory");
    const float* impb = (const float*)(shm + LDS_IMP);
    for (int k = 0; k < 8; ++k) {
      const int tl = wid * 8 + k, tt = qb * 64 + tl, cur = qb;
      float s = (impb[(0 * 64 + tl) * 64 + lane] + impb[(1 * 64 + tl) * 64 + lane]) + (impb[(2 * 64 + tl) * 64 + lane] + impb[(3 * 64 + tl) * 64 + lane]);
      const bool forced = (lane == 0) || (lane == cur) || (lane == cur - 1);
      s = forced ? 1e4f : ((lane <= cur) ? s : -1.0f);
      int rank = 0;
#pragma unroll
      for (int i = 0; i < 64; ++i) { const float si = __builtin_bit_cast(float, __builtin_amdgcn_readlane(__builtin_bit_cast(int, s), i)); rank += (si > s || (si == s && i < lane)) ? 1 : 0; }
      const unsigned long long m = __ballot(rank < 16);
      if (lane == 0) io.selmask[(size_t)(b * KVH + kvh) * SEQ + tt] = m;
    }
  } else {
    bf16* stg = (bf16*)(shm + LDS_OST) + wid * 2048;
#pragma unroll
    for (int r = 0; r < 16; ++r) { const int orow = crow(r, hi);
#pragma unroll
      for (int d0 = 0; d0 < 2; ++d0) stg[orow * 64 + d0 * 32 + r32] = (bf16)f2bf(o[d0][r] * rli[r]); }
    asm volatile("s_waitcnt lgkmcnt(0)" ::: "memory");
#pragma unroll
    for (int i = 0; i < 4; ++i) { const int row = i * 8 + (lane >> 3), ch = lane & 7;
      const u32x4 v = *(const u32x4*)(stg + row * 64 + ch * 8);
      const size_t grow = (size_t)(rowbase + q0 + row);
      const int tok = q0 + row;
      const bf16* pr = io.P + grow * PP;
      float ov[8];
#pragma unroll
      for (int k = 0; k < 4; ++k) { ov[2 * k] = __uint_as_float(v[k] << 16); ov[2 * k + 1] = __uint_as_float(v[k] & 0xffff0000u); }
      if (MODE == 2) {
        const float g0 = (tok >= 31) ? fast_sigmoid(bf2f(pr[C_NGATE + 0 * NSA_HEADS + head])) : 0.f;
        u32x4 w;
#pragma unroll
        for (int k = 0; k < 4; ++k) w[k] = cvtpk_s(g0 * ov[2 * k], g0 * ov[2 * k + 1]);
        *(u32x4*)(io.Y + grow * D_MODEL + HG_W + head * 64 + ch * 8) = w;
      } else if (MODE == 1) {
        const float g2 = fast_sigmoid(bf2f(pr[C_NGATE + 2 * NSA_HEADS + head]));
        u32x4 w;
#pragma unroll
        for (int k = 0; k < 4; ++k) w[k] = cvtpk_s(g2 * ov[2 * k], g2 * ov[2 * k + 1]);
        *(u32x4*)(io.T2 + grow * NSA_W + head * 64 + ch * 8) = w;
      } else {
        const float g1 = fast_sigmoid(bf2f(pr[C_NGATE + 1 * NSA_HEADS + head]));
        const u32x4 t1 = *(const u32x4*)(io.Y + grow * D_MODEL + HG_W + head * 64 + ch * 8);
        const u32x4 t2 = *(const u32x4*)(io.T2 + grow * NSA_W + head * 64 + ch * 8);
        const u32x4 nz = *(const u32x4*)(pr + C_NZ + head * 64 + ch * 8);
        u32x4 w;
#pragma unroll
        for (int k = 0; k < 4; ++k) {
          const float za = __uint_as_float(nz[k] << 16), zb = __uint_as_float(nz[k] & 0xffff0000u);
          const float ya = (__uint_as_float(t1[k] << 16) + __uint_as_float(t2[k] << 16) + g1 * ov[2 * k]) * za * fast_sigmoid(za);
          const float yb = (__uint_as_float(t1[k] & 0xffff0000u) + __uint_as_float(t2[k] & 0xffff0000u) + g1 * ov[2 * k + 1]) * zb * fast_sigmoid(zb);
          w[k] = cvtpk_s(ya, yb);
        }
        *(u32x4*)(io.Y + grow * D_MODEL + HG_W + head * 64 + ch * 8) = w;
      }
    }
  }
  asm volatile("s_waitcnt lgkmcnt(0)\n\ts_barrier" ::: "memory");
#undef DMA_K
#undef DMA_V
#undef MEMTILE
#undef BMASK
#undef NEGSEL
#undef START
#undef RESC
#undef ROT
}
#undef SBAR
#undef WAIT_BAR
}
namespace hg {
using bf16x8 = __attribute__((ext_vector_type(8))) short;
using f32x16 = __attribute__((ext_vector_type(16))) float;
constexpr int HG_NS = 4, HG_NG = SEQ / (64 * HG_NS);
constexpr int RS = 272;
constexpr int TS = 144;
constexpr int L_QD = 0, L_QR = L_QD + 64 * RS, L_KR = L_QR + 64 * RS, L_KDT = L_KR + 64 * RS, L_VT = L_KDT + 128 * TS, L_A = L_VT + 128 * TS,
              L_ST = L_A + 64 * TS, L_OST = L_ST + 128 * RS, L_BL = L_OST + 64 * RS, L_END = L_BL + 512;
__device__ __forceinline__ int crow(int r, int hi) { return (r & 3) + 8 * (r >> 2) + 4 * hi; }
__device__ __forceinline__ bf16x8 ldsfrag(const char* base, int row, int stride, int kbyte) { return *(const bf16x8*)(base + row * stride + kbyte); }
#define HG_MFMA(a, b, c) __builtin_amdgcn_mfma_f32_32x32x16_bf16(a, b, c, 0, 0, 0)

struct HgIO {
  const bf16* P; bf16* Y; const float* lb_l; const float* onorm_g;
  float* SLOC;
  float* DGL;
};

template <bool FULL>
__device__ __forceinline__ void chunk_prep(const HgIO& io, char* lds, size_t row, int h, int wid, int lane, const float* lbv, float* dgl) {
  const bf16* pr = io.P + row * PP;
  const uint4 f0 = *(const uint4*)(pr + C_HF + h * 128 + 16 * wid), f1 = *(const uint4*)(pr + C_HF + h * 128 + 16 * wid + 8);
  const uint4 v0 = *(const uint4*)(pr + C_HI + h * 128 + 16 * wid), v1 = *(const uint4*)(pr + C_HI + h * 128 + 16 * wid + 8);
  uint4 q0 = make_uint4(0, 0, 0, 0), q1 = q0;
  if (FULL) { q0 = *(const uint4*)(pr + C_HQ + h * 128 + 16 * wid); q1 = *(const uint4*)(pr + C_HQ + h * 128 + 16 * wid + 8); }
  const unsigned fw[8] = {f0.x, f0.y, f0.z, f0.w, f1.x, f1.y, f1.z, f1.w};
  const unsigned vw[8] = {v0.x, v0.y, v0.z, v0.w, v1.x, v1.y, v1.z, v1.w};
  const unsigned qw[8] = {q0.x, q0.y, q0.z, q0.w, q1.x, q1.y, q1.z, q1.w};
  float b[16], kk[16];
#pragma unroll
  for (int i = 0; i < 16; ++i) {
    const float fl = (i & 1) ? __uint_as_float(fw[i >> 1] & 0xffff0000u) : __uint_as_float(fw[i >> 1] << 16);
    const float sg = fast_sigmoid(fl);
    const float lb = lbv[i];
    const float f = lb + (1.f - lb) * sg;
    b[i] = __logf(f);
    kk[i] = (1.f - lb) * fast_sigmoid(-fl);
  }
#pragma unroll
  for (int o = 1; o < 64; o <<= 1) {
#pragma unroll
    for (int i = 0; i < 16; ++i) { const float t = __shfl_up(b[i], o); if (lane >= o) b[i] += t; }
  }
  float bl[16], rf[16];
#pragma unroll
  for (int i = 0; i < 16; ++i) { bl[i] = __shfl(b[i], 63); rf[i] = __shfl(b[i], 31); }
  if (lane == 63) {
    float* blp = (float*)(lds + L_BL) + 16 * wid;
#pragma unroll
    for (int i = 0; i < 16; ++i) { blp[i] = bl[i]; dgl[i] += bl[i]; }
  }
  unsigned short* kdt = (unsigned short*)(lds + L_KDT);
  unsigned short* vt = (unsigned short*)(lds + L_VT);
#pragma unroll
  for (int i = 0; i < 16; ++i) {
    const float kd = kk[i] * __expf(bl[i] - b[i]);
    kdt[(16 * wid + i) * (TS / 2) + lane] = (unsigned short)f2bf(kd);
    vt[(16 * wid + i) * (TS / 2) + lane] = (unsigned short)((i & 1) ? (vw[i >> 1] >> 16) : (vw[i >> 1] & 0xffffu));
  }
  if (FULL) {
    unsigned qd[8], qrr[8], krr[8];
#pragma unroll
    for (int i = 0; i < 16; i += 2) {
      const float qa = __uint_as_float(qw[i >> 1] << 16), qb = __uint_as_float(qw[i >> 1] & 0xffff0000u);
      qd[i >> 1] = pk2(qa * __expf(b[i]), qb * __expf(b[i + 1]));
      qrr[i >> 1] = pk2(qa * __expf(fminf(b[i] - rf[i], 80.f)), qb * __expf(fminf(b[i + 1] - rf[i + 1], 80.f)));
      krr[i >> 1] = pk2(kk[i] * __expf(fminf(rf[i] - b[i], 80.f)), kk[i + 1] * __expf(fminf(rf[i + 1] - b[i + 1], 80.f)));
    }
    uint4* dq = (uint4*)(lds + L_QD + lane * RS + 32 * wid);
    dq[0] = make_uint4(qd[0], qd[1], qd[2], qd[3]); dq[1] = make_uint4(qd[4], qd[5], qd[6], qd[7]);
    uint4* dr = (uint4*)(lds + L_QR + lane * RS + 32 * wid);
    dr[0] = make_uint4(qrr[0], qrr[1], qrr[2], qrr[3]); dr[1] = make_uint4(qrr[4], qrr[5], qrr[6], qrr[7]);
    uint4* dk = (uint4*)(lds + L_KR + lane * RS + 32 * wid);
    dk[0] = make_uint4(krr[0], krr[1], krr[2], krr[3]); dk[1] = make_uint4(krr[4], krr[5], krr[6], krr[7]);
  }
}

__device__ __forceinline__ void u_blocks(const char* lds, int wid, int l31, int hi, f32x16 (&u)[2]) {
  const int vb = wid & 3;
#pragma unroll
  for (int blk = 0; blk < 2; ++blk) {
    const int db = 2 * (wid >> 2) + blk;
    f32x16 acc = zero16();
#pragma unroll
    for (int ks = 0; ks < 4; ++ks) {
      const bf16x8 a = ldsfrag(lds + L_VT, vb * 32 + l31, TS, ks * 32 + hi * 16);
      const bf16x8 bb = ldsfrag(lds + L_KDT, db * 32 + l31, TS, ks * 32 + hi * 16);
      acc = HG_MFMA(a, bb, acc);
    }
    u[blk] = acc;
  }
}

__device__ __forceinline__ void hgrn_state_item(const HgIO& io, int item, char* lds) {
  const int tid = opq_tid(), lane = tid & 63, l31 = lane & 31, hi = lane >> 5; const int wid = __builtin_amdgcn_readfirstlane(tid >> 6);
  const int bh = item / HG_NG, g = item % HG_NG, b = bh >> 2, h = bh & 3;
  float lbv[16];
#pragma unroll
  for (int i = 0; i < 16; ++i) lbv[i] = io.lb_l[h * 128 + 16 * wid + i];
  float dgl[16];
#pragma unroll
  for (int i = 0; i < 16; ++i) dgl[i] = 0.f;
  f32x16 S[2]; S[0] = zero16(); S[1] = zero16();
  for (int c = 0; c < HG_NS; ++c) {
    const size_t row = (size_t)b * SEQ + (size_t)(g * HG_NS + c) * 64 + lane;
    chunk_prep<false>(io, lds, row, h, wid, lane, lbv, dgl);
    __syncthreads();
    f32x16 u[2];
    u_blocks(lds, wid, l31, hi, u);
    const float* blp = (const float*)(lds + L_BL);
#pragma unroll
    for (int blk = 0; blk < 2; ++blk) {
      const float dec = __expf(blp[(2 * (wid >> 2) + blk) * 32 + l31]);
#pragma unroll
      for (int r = 0; r < 16; ++r) S[blk][r] = dec * S[blk][r] + u[blk][r];
    }
    __syncthreads();
  }
  float* dst = io.SLOC + ((size_t)(bh * HG_NG + g) * 8 + wid) * 2048;
#pragma unroll
  for (int blk = 0; blk < 2; ++blk)
#pragma unroll
    for (int r = 0; r < 16; ++r) dst[(blk * 16 + r) * 64 + lane] = S[blk][r];
  if (lane == 63) {
    float* dg = io.DGL + (size_t)(bh * HG_NG + g) * 128 + 16 * wid;
#pragma unroll
    for (int i = 0; i < 16; ++i) dg[i] = dgl[i];
  }
}

__device__ __forceinline__ void hgrn_scan_item(const HgIO& io, int item) {
  const int tid = opq_tid(), bh = item >> 3, w = item & 7;
  float run[4] = {0.f, 0.f, 0.f, 0.f};
  for (int g = 0; g < HG_NG; ++g) {
    float* p = io.SLOC + ((size_t)(bh * HG_NG + g) * 8 + w) * 2048;
    const float* dg = io.DGL + (size_t)(bh * HG_NG + g) * 128;
#pragma unroll
    for (int k = 0; k < 4; ++k) {
      const int e = tid + 512 * k, blk = e >> 10, ln = e & 63;
      const int d = (2 * (w >> 2) + blk) * 32 + (ln & 31);
      const float loc = p[e];
      p[e] = run[k];
      run[k] = __expf(dg[d]) * run[k] + loc;
    }
  }
}

__device__ __forceinline__ void hgrn_out_item(const HgIO& io, int item, char* lds) {
  const int tid = opq_tid(), lane = tid & 63, l31 = lane & 31, hi = lane >> 5; const int wid = __builtin_amdgcn_readfirstlane(tid >> 6);
  const int bh = item / HG_NG, g = item % HG_NG, b = bh >> 2, h = bh & 3;
  const int tb = wid >> 2, vb = wid & 3;
  float lbv[16];
#pragma unroll
  for (int i = 0; i < 16; ++i) lbv[i] = io.lb_l[h * 128 + 16 * wid + i];
  float dgl[16];
#pragma unroll
  for (int i = 0; i < 16; ++i) dgl[i] = 0.f;
  f32x16 S[2];
  {
    const float* src = io.SLOC + ((size_t)(bh * HG_NG + g) * 8 + wid) * 2048;
    unsigned short* st = (unsigned short*)(lds + L_ST);
#pragma unroll
    for (int blk = 0; blk < 2; ++blk)
#pragma unroll
      for (int r = 0; r < 16; ++r) {
        const float v = src[(blk * 16 + r) * 64 + lane];
        S[blk][r] = v;
        st[(vb * 32 + crow(r, hi)) * (RS / 2) + (2 * (wid >> 2) + blk) * 32 + l31] = (unsigned short)f2bf(v);
      }
  }
  for (int c = 0; c < HG_NS; ++c) {
    const size_t rowc = (size_t)b * SEQ + (size_t)(g * HG_NS + c) * 64;
    chunk_prep<true>(io, lds, rowc + lane, h, wid, lane, lbv, dgl);
    __syncthreads();
    f32x16 oacc = zero16();
#pragma unroll
    for (int ks = 0; ks < 8; ++ks) {
      const bf16x8 a = ldsfrag(lds + L_QD, tb * 32 + l31, RS, ks * 32 + hi * 16);
      const bf16x8 bb = ldsfrag(lds + L_ST, vb * 32 + l31, RS, ks * 32 + hi * 16);
      oacc = HG_MFMA(a, bb, oacc);
    }
    f32x16 u[2];
    u_blocks(lds, wid, l31, hi, u);
    if (wid < 3) {
      const int tb2 = (wid > 0) ? 1 : 0, sb2 = (wid == 2) ? 1 : 0;
      f32x16 a_acc = zero16();
#pragma unroll
      for (int ks = 0; ks < 8; ++ks) {
        const bf16x8 a = ldsfrag(lds + L_QR, tb2 * 32 + l31, RS, ks * 32 + hi * 16);
        const bf16x8 bb = ldsfrag(lds + L_KR, sb2 * 32 + l31, RS, ks * 32 + hi * 16);
        a_acc = HG_MFMA(a, bb, a_acc);
      }
      unsigned short* al = (unsigned short*)(lds + L_A);
#pragma unroll
      for (int r = 0; r < 16; ++r) {
        const int t = tb2 * 32 + crow(r, hi), s = sb2 * 32 + l31;
        al[t * (TS / 2) + s] = (unsigned short)f2bf((s <= t) ? a_acc[r] : 0.f);
      }
    }
    __syncthreads();
    for (int sb = 0; sb <= tb; ++sb) {
#pragma unroll
      for (int ks = 0; ks < 2; ++ks) {
        const bf16x8 a = ldsfrag(lds + L_A, tb * 32 + l31, TS, sb * 64 + ks * 32 + hi * 16);
        const bf16x8 bb = ldsfrag(lds + L_VT, vb * 32 + l31, TS, sb * 64 + ks * 32 + hi * 16);
        oacc = HG_MFMA(a, bb, oacc);
      }
    }
    {
      const float* blp = (const float*)(lds + L_BL);
      unsigned short* st = (unsigned short*)(lds + L_ST);
#pragma unroll
      for (int blk = 0; blk < 2; ++blk) {
        const int db = 2 * (wid >> 2) + blk;
        const float dec = __expf(blp[db * 32 + l31]);
#pragma unroll
        for (int r = 0; r < 16; ++r) {
          const float v = dec * S[blk][r] + u[blk][r];
          S[blk][r] = v;
          st[(vb * 32 + crow(r, hi)) * (RS / 2) + db * 32 + l31] = (unsigned short)f2bf(v);
        }
      }
      unsigned short* os = (unsigned short*)(lds + L_OST);
#pragma unroll
      for (int r = 0; r < 16; ++r) os[(tb * 32 + crow(r, hi)) * (RS / 2) + vb * 32 + l31] = (unsigned short)f2bf(oacc[r]);
    }
    __syncthreads();
    {
      const int t = tid >> 3, vc = tid & 7;
      const uint4 o0 = *(const uint4*)(lds + L_OST + t * RS + vc * 32), o1 = *(const uint4*)(lds + L_OST + t * RS + vc * 32 + 16);
      const unsigned ow[8] = {o0.x, o0.y, o0.z, o0.w, o1.x, o1.y, o1.z, o1.w};
      float ov[16]; float ss = 0.f;
#pragma unroll
      for (int k = 0; k < 8; ++k) { ov[2 * k] = __uint_as_float(ow[k] << 16); ov[2 * k + 1] = __uint_as_float(ow[k] & 0xffff0000u); ss += ov[2 * k] * ov[2 * k] + ov[2 * k + 1] * ov[2 * k + 1]; }
      ss += __shfl_xor(ss, 1); ss += __shfl_xor(ss, 2); ss += __shfl_xor(ss, 4);
      const float rstd = rsqrtf(ss * (1.0f / 128.0f) + RMS_EPS);
      const bf16* pr = io.P + (rowc + t) * PP;
      const uint4 g0 = *(const uint4*)(pr + C_HGO + h * 128 + vc * 16), g1 = *(const uint4*)(pr + C_HGO + h * 128 + vc * 16 + 8);
      const uint4 z0 = *(const uint4*)(pr + C_HZ + h * 128 + vc * 16), z1 = *(const uint4*)(pr + C_HZ + h * 128 + vc * 16 + 8);
      const unsigned gw[8] = {g0.x, g0.y, g0.z, g0.w, g1.x, g1.y, g1.z, g1.w};
      const unsigned zw[8] = {z0.x, z0.y, z0.z, z0.w, z1.x, z1.y, z1.z, z1.w};
      unsigned yw[8];
#pragma unroll
      for (int k = 0; k < 8; ++k) {
        const float ga = __uint_as_float(gw[k] << 16), gb = __uint_as_float(gw[k] & 0xffff0000u);
        const float za = __uint_as_float(zw[k] << 16), zb = __uint_as_float(zw[k] & 0xffff0000u);
        const float ya = ov[2 * k] * rstd * io.onorm_g[vc * 16 + 2 * k] * fast_sigmoid(ga) * za * fast_sigmoid(za);
        const float yb = ov[2 * k + 1] * rstd * io.onorm_g[vc * 16 + 2 * k + 1] * fast_sigmoid(gb) * zb * fast_sigmoid(zb);
        yw[k] = pk2(ya, yb);
      }
      uint4* yd = (uint4*)(io.Y + (rowc + t) * D_MODEL + h * 128 + vc * 16);
      yd[0] = make_uint4(yw[0], yw[1], yw[2], yw[3]); yd[1] = make_uint4(yw[4], yw[5], yw[6], yw[7]);
    }
  }
  __syncthreads();
}
#undef HG_MFMA
}
namespace cp {
using bf16x8 = __attribute__((ext_vector_type(8))) short;
using f32x16 = __attribute__((ext_vector_type(16))) float;
constexpr int TROWS = 528;
constexpr int BS = 144;
constexpr int HS = 272;
constexpr int L_TK = 0, L_BT = L_TK + TROWS * 128, L_HD = L_BT + 2 * 128 * BS, L_OS = L_HD + 32 * HS, L_END = L_OS + 32 * 64 * 4;
__device__ __forceinline__ int crow(int r, int hi) { return (r & 3) + 8 * (r >> 2) + 4 * hi; }
struct CmpIO {
  const bf16* P; const bf16* W1T;
  const bf16* W2T;
  const float* BIAS1;
  const float* kg0;
  bf16* KC; bf16* VC;
};
__device__ __forceinline__ void cmp_item(const CmpIO& io, int item, char* lds) {
  const int tid = opq_tid(), lane = tid & 63, l31 = lane & 31, hi = lane >> 5; const int wid = __builtin_amdgcn_readfirstlane(tid >> 6);
  const int rb = item & 7, kv = (item >> 3) & 1, bg = item >> 4, b = bg >> 1, g = bg & 1;
  const int c0 = 32 * rb, tok0 = 16 * c0;
  const bf16* src = io.P + (size_t)b * SEQ * PP + (kv == 0 ? C_KCM : C_VCM) + g * 64;
  for (int q = tid; q < TROWS * 8; q += 512) {
    const int row = q >> 3, ch = q & 7;
    int tok = tok0 + row; if (tok > SEQ - 1) tok = SEQ - 1;
    const uint4 v = *(const uint4*)(src + (size_t)tok * PP + ch * 8);
    *(uint4*)(lds + L_TK + row * 128 + ((ch ^ ((row >> 4) & 7)) << 4)) = v;
  }
  const bf16* w1 = io.W1T + (size_t)kv * 128 * 2048;
  const int n0 = tid >> 3, chq = tid & 7;
  uint4 st0 = *(const uint4*)(w1 + (size_t)n0 * 2048 + chq * 8), st1 = *(const uint4*)(w1 + (size_t)(n0 + 64) * 2048 + chq * 8);
  *(uint4*)(lds + L_BT + n0 * BS + chq * 16) = st0; *(uint4*)(lds + L_BT + (n0 + 64) * BS + chq * 16) = st1;
  __syncthreads();
  const int nb = wid & 3, kh = wid >> 2;
  f32x16 acc = zero16();
  for (int l = 0; l < 32; ++l) {
    const int cur = l & 1;
    if (l + 1 < 32) { st0 = *(const uint4*)(w1 + (size_t)n0 * 2048 + (l + 1) * 64 + chq * 8); st1 = *(const uint4*)(w1 + (size_t)(n0 + 64) * 2048 + (l + 1) * 64 + chq * 8); }
#pragma unroll
    for (int kk = 0; kk < 2; ++kk) {
      const int k16 = 2 * kh + kk;
      const int row = 16 * l31 + l;
      const bf16x8 a = *(const bf16x8*)(lds + L_TK + row * 128 + (((k16 * 2 + hi) ^ ((row >> 4) & 7)) << 4));
      const bf16x8 bb = *(const bf16x8*)(lds + L_BT + cur * 128 * BS + (nb * 32 + l31) * BS + k16 * 32 + hi * 16);
      acc = __builtin_amdgcn_mfma_f32_32x32x16_bf16(a, bb, acc, 0, 0, 0);
    }
    if (l + 1 < 32) { *(uint4*)(lds + L_BT + (cur ^ 1) * 128 * BS + n0 * BS + chq * 16) = st0; *(uint4*)(lds + L_BT + (cur ^ 1) * 128 * BS + (n0 + 64) * BS + chq * 16) = st1; }
    __syncthreads();
  }
  float* red = (float*)(lds + L_BT);
  if (kh == 1) {
#pragma unroll
    for (int r = 0; r < 16; ++r) red[(nb * 16 + r) * 64 + lane] = acc[r];
  }
  __syncthreads();
  if (kh == 0) {
    const float bias = io.BIAS1[kv * 128 + nb * 32 + l31];
    unsigned short* hd = (unsigned short*)(lds + L_HD);
#pragma unroll
    for (int r = 0; r < 16; ++r) {
      const float x = acc[r] + red[(nb * 16 + r) * 64 + lane] + bias;
      hd[crow(r, hi) * (HS / 2) + nb * 32 + l31] = (unsigned short)f2bf(x * fast_sigmoid(x));
    }
  }
  __syncthreads();
  if (wid < 2) {
    const bf16* w2 = io.W2T + (size_t)kv * 64 * 128;
    f32x16 o = zero16();
#pragma unroll
    for (int ks = 0; ks < 8; ++ks) {
      const bf16x8 a = *(const bf16x8*)(lds + L_HD + l31 * HS + ks * 32 + hi * 16);
      const bf16x8 bb = *(const bf16x8*)(w2 + (size_t)(wid * 32 + l31) * 128 + ks * 16 + hi * 8);
      o = __builtin_amdgcn_mfma_f32_32x32x16_bf16(a, bb, o, 0, 0, 0);
    }
    float* os = (float*)(lds + L_OS);
#pragma unroll
    for (int r = 0; r < 16; ++r) os[crow(r, hi) * 64 + wid * 32 + l31] = o[r];
  }
  __syncthreads();
  {
    const int c = tid >> 4, j4 = (tid & 15) * 4;
    const float4 v = *(const float4*)(lds + L_OS + (c * 64 + j4) * 4);
    float ss = v.x * v.x + v.y * v.y + v.z * v.z + v.w * v.w;
    ss += __shfl_xor(ss, 1); ss += __shfl_xor(ss, 2); ss += __shfl_xor(ss, 4); ss += __shfl_xor(ss, 8);
    float o0 = v.x, o1 = v.y, o2 = v.z, o3 = v.w;
    if (kv == 0) { const float r = rsqrtf(ss * (1.0f / 64.0f) + RMS_EPS); o0 *= r * io.kg0[j4]; o1 *= r * io.kg0[j4 + 1]; o2 *= r * io.kg0[j4 + 2]; o3 *= r * io.kg0[j4 + 3]; }
    if (c0 + c >= NC) { o0 = 0.f; o1 = 0.f; o2 = 0.f; o3 = 0.f; }
    bf16* dst = (kv == 0 ? io.KC : io.VC) + ((size_t)bg * 256 + c0 + c) * 64 + j4;
    *(uint2*)dst = make_uint2(pk2(o0, o1), pk2(o2, o3));
  }
  __syncthreads();
}
}
#define GAS __attribute__((address_space(1)))
#define XB_TMO      128
#define XB_XCNT(j)  (256  + 64 * (j))
#define XB_XSUB(j)  (1280 + 64 * (j))
#define XB_XGEN(j)  (2304 + 64 * (j))
#define XB_TOP      3328
#define XB_TOPGEN   3392
#define XCD_BAR_WORDS 3456
#define XB_SPIN_CAP (1u << 18)

__device__ __forceinline__ unsigned xb_ld(unsigned* p)              { return __hip_atomic_load(p, __ATOMIC_RELAXED, __HIP_MEMORY_SCOPE_AGENT); }
__device__ __forceinline__ unsigned xb_add(unsigned* p, unsigned v) { return __hip_atomic_fetch_add(p, v, __ATOMIC_RELAXED, __HIP_MEMORY_SCOPE_AGENT); }
__device__ __forceinline__ unsigned xb_xcc_id() { return (unsigned)__builtin_amdgcn_s_getreg((3 << 11) | 20) & 0xFu; }
#define XB_SPIN(cond, bar) do { unsigned _sp = 0; while (cond) { __builtin_amdgcn_s_sleep(1); \
    if ((++_sp & 255u) == 0u) { if (xb_ld(&(bar)[XB_TMO])) break; if (_sp > XB_SPIN_CAP) { atomicAdd(&(bar)[XB_TMO], 1u); break; } } } } while (0)

struct XcdBarrier {
    unsigned* bar; unsigned x;
    volatile LAS unsigned* st;
};

__device__ __forceinline__ XcdBarrier xcd_barrier_post(unsigned* bar, volatile LAS unsigned* st) {
    XcdBarrier b; b.bar = bar; b.x = xb_xcc_id(); b.st = st;
    if (threadIdx.x == 0) (void)xb_add(&bar[XB_XCNT(b.x)], 1u);
    return b;
}
__device__ __forceinline__ void xcd_barrier_complete(unsigned* bar, unsigned x, unsigned& nloc, unsigned& nx) {
    const unsigned G = gridDim.x * gridDim.y * gridDim.z;
    unsigned sum, cnt, mine, sp = 0u;
    for (;;) {
        sum = 0u; cnt = 0u; mine = 0u;
#pragma unroll
        for (unsigned j = 0; j < 16; ++j) { const unsigned c = xb_ld(&bar[XB_XCNT(j)]); sum += c; cnt += (c > 0u) ? 1u : 0u; mine = (j == x) ? c : mine; }
        if (sum == G) break;
        __builtin_amdgcn_s_sleep(1);
        if ((++sp & 255u) == 0u) { if (xb_ld(&bar[XB_TMO])) break; if (sp > XB_SPIN_CAP) { atomicAdd(&bar[XB_TMO], 1u); break; } }
    }
    nloc = mine > 0u ? mine : 1u; nx = cnt > 0u ? cnt : 1u;
}

__device__ __forceinline__ void xcd_barrier(const XcdBarrier& b) {
    asm volatile("s_waitcnt vmcnt(0)" ::: "memory");
    __syncthreads();
    if (threadIdx.x == 0) {
        unsigned* bar = b.bar;
        __builtin_amdgcn_s_waitcnt(0);
        unsigned nloc = b.st[0], nx = b.st[1];
        if (nloc == 0u) { xcd_barrier_complete(bar, b.x, nloc, nx); b.st[0] = nloc; b.st[1] = nx; }
        const unsigned old = xb_add(&bar[XB_XSUB(b.x)], 1u);
        const unsigned gen = old / nloc;
        if (old + 1u == (gen + 1u) * nloc) {
            __builtin_amdgcn_fence(__ATOMIC_RELEASE, "agent");
            asm volatile("s_waitcnt vmcnt(0)" ::: "memory");
            const unsigned og = xb_add(&bar[XB_TOP], 1u);
            const unsigned tg = og / nx;
            if (og + 1u == (tg + 1u) * nx) xb_add(&bar[XB_TOPGEN], 1u);
            else XB_SPIN(xb_ld(&bar[XB_TOPGEN]) == tg, bar);
            __builtin_amdgcn_fence(__ATOMIC_ACQUIRE, "agent");
            xb_add(&bar[XB_XGEN(b.x)], 1u);
            asm volatile("s_waitcnt vmcnt(0)" ::: "memory");
        } else {
            XB_SPIN(xb_ld(&bar[XB_XGEN(b.x)]) == gen, bar);
            __builtin_amdgcn_fence(__ATOMIC_ACQUIRE, "agent");
            asm volatile("s_waitcnt vmcnt(0)" ::: "memory");
        }
    }
    __syncthreads();
}
__device__ __forceinline__ int map_col(int n, int remap) { return (remap && n >= SRC_NGATE_END) ? n + 104 : n; }
__device__ __forceinline__ void dev_transpose_w(const float* __restrict__ W, int K, int N, bf16* __restrict__ WT, const float* __restrict__ gk, int remap,
                                                float* scr, int gw, int ngw, int lane) {
    const int nblk = (N + 31) / 32, nitems = (K / 64) * nblk;
    for (int item = gw; item < nitems; item += ngw) {
        const int kb = item / nblk, nb = item % nblk, k0 = 64 * kb, n0 = 32 * nb;
        for (int i = 0; i < 32; ++i) {
            const int kk = 2 * i + (lane >> 5), n = n0 + (lane & 31);
            float v = (n < N) ? W[(size_t)(k0 + kk) * N + n] : 0.f;
            if (gk) v *= gk[k0 + kk];
            scr[kk * 33 + (lane & 31)] = v;
        }
        asm volatile("s_waitcnt lgkmcnt(0)" ::: "memory");
        const int c = lane & 7;
        for (int j = 0; j < 4; ++j) {
            const int nl = (lane >> 3) + 8 * j, n = n0 + nl;
            if (n < N) {
                const float* s = scr + (8 * c) * 33 + nl;
                uint4 o; o.x = pk2(s[0 * 33], s[1 * 33]); o.y = pk2(s[2 * 33], s[3 * 33]); o.z = pk2(s[4 * 33], s[5 * 33]); o.w = pk2(s[6 * 33], s[7 * 33]);
                *(uint4*)(WT + (size_t)map_col(n, remap) * K + k0 + 8 * c) = o;
            }
        }
        asm volatile("s_waitcnt lgkmcnt(0)" ::: "memory");
    }
}
__device__ __forceinline__ void dev_prep_x(const float* __restrict__ x, float* __restrict__ h, bf16* __restrict__ HB, float* __restrict__ RS, int gw, int ngw, int lane) {
    for (int row = gw; row < MROWS; row += ngw) {
        const float4* xr = (const float4*)(x + (size_t)row * D_MODEL) + lane;
        float4* hr = (float4*)(h + (size_t)row * D_MODEL) + lane;
        uint2* br = (uint2*)(HB + (size_t)row * D_MODEL) + lane;
        float ss = 0.f;
#pragma unroll
        for (int j = 0; j < 4; ++j) {
            const float4 v = xr[64 * j];
            hr[64 * j] = v;
            uint2 w; w.x = pk2(v.x, v.y); w.y = pk2(v.z, v.w); br[64 * j] = w;
            ss += (v.x * v.x + v.y * v.y) + (v.z * v.z + v.w * v.w);
        }
        for (int o = 32; o > 0; o >>= 1) ss += __shfl_xor(ss, o);
        if (lane < 16) RS[(size_t)row * 16 + lane] = (lane == 0) ? ss : 0.f;
    }
}
__device__ __forceinline__ void dev_f32_to_bf16(const float* __restrict__ src, bf16* __restrict__ dst, int n4, int gt, int ngt) {
    for (int i = gt; i < n4; i += ngt) {
        const float4 v = ((const float4*)src)[i];
        uint2 w; w.x = pk2(v.x, v.y); w.y = pk2(v.z, v.w);
        ((uint2*)dst)[i] = w;
    }
}
__device__ __forceinline__ void dev_tables(const float* __restrict__ hgrn_lb, float* __restrict__ lb_all, float* __restrict__ ropec, float* __restrict__ ropes,
                                           bf16* __restrict__ OV, bf16* __restrict__ KC, bf16* __restrict__ VC, bf16* __restrict__ WIN_T, int gt, int ngt) {
    for (int i = gt; i < SEQ * 8; i += ngt) {
        if (i < HG_W) {
            float v0 = hgrn_lb[i], v1 = hgrn_lb[HG_W + i], v2 = hgrn_lb[2 * HG_W + i], v3 = hgrn_lb[3 * HG_W + i];
            float m = fmaxf(fmaxf(v0, v1), fmaxf(v2, v3));
            v0 = expf(v0 - m); v1 = expf(v1 - m); v2 = expf(v2 - m); v3 = expf(v3 - m);
            float s = v0 + v1 + v2 + v3;
            lb_all[i] = 0.f; lb_all[HG_W + i] = v1 / s; lb_all[2 * HG_W + i] = v1 / s + v2 / s; lb_all[3 * HG_W + i] = v1 / s + v2 / s + v3 / s;
        }
        {
            int t = i >> 3, j = i & 7;
            double inv = pow(500000.0, -(double)(2 * j) / 16.0);
            double ang = (double)t * inv;
            ropec[i] = (float)cos(ang);
            ropes[i] = (float)sin(ang);
        }
        if (i < 256 * 64) {
            const int c = i >> 6, j = i & 63;
            float v = 0.f;
            if (c < NC) { const int j0 = (16 * c) >> 6, j1 = (16 * c + 31) >> 6; if (j0 == j1) v = (j == j0) ? 1.f : 0.f; else v = (j == j0 || j == j1) ? 0.5f : 0.f; }
            OV[i] = (bf16)f2bf(v);
        }
        if (i < BATCH * KVH * 64) { const int bg = i >> 6, j = i & 63; KC[((size_t)bg * 256 + 255) * 64 + j] = 0; VC[((size_t)bg * 256 + 255) * 64 + j] = 0; }
    }
    for (int i = gt; i < 232 * (D_MODEL / 8); i += ngt) {
        const int r = i / (D_MODEL / 8), c = i % (D_MODEL / 8);
        const int row = (r < 104) ? SRC_NGATE_END + r : 4480 + (r - 104);
        *(uint4*)(WIN_T + (size_t)row * D_MODEL + c * 8) = make_uint4(0, 0, 0, 0);
    }
}
__device__ __forceinline__ void dev_cmp_bias(const float* __restrict__ pe, const float* __restrict__ w1, float* __restrict__ bias1, int gw, int ngw, int lane) {
    for (int o = gw; o < 256; o += ngw) {
        const int kv = o >> 7, n = o & 127;
        const float* pk = pe + (size_t)kv * 2048; const float* w = w1 + (size_t)kv * 2048 * 128;
        float acc = 0.f;
        for (int k = lane; k < 2048; k += 64) acc = fmaf(pk[k], w[(size_t)k * 128 + n], acc);
        for (int s = 32; s > 0; s >>= 1) acc += __shfl_xor(acc, s);
        if (lane == 0) bias1[o] = acc;
    }
}
__device__ __forceinline__ void dev_nsa_prep(bf16* __restrict__ P, const float* __restrict__ qg, const float* __restrict__ kg, const float* __restrict__ ropec,
                                             const float* __restrict__ ropes, int gt, int ngt) {
    for (int i = gt; i < MROWS * 12; i += ngt) {
        const int row = i / 12, u = i % 12, t = row % SEQ;
        bf16* src; const float* g;
        if (u < 8) { src = P + (size_t)row * PP + C_NQ + u * DH; g = qg; }
        else if (u < 10) { src = P + (size_t)row * PP + C_KSL + (u - 8) * DH; g = kg + 1 * DH; }
        else { src = P + (size_t)row * PP + C_KWN + (u - 10) * DH; g = kg + 2 * DH; }
        uint4 raw[8];
        float ss = 0.f;
#pragma unroll
        for (int c = 0; c < 8; ++c) {
            raw[c] = ((const uint4*)src)[c];
            const unsigned w[4] = {raw[c].x, raw[c].y, raw[c].z, raw[c].w};
#pragma unroll
            for (int k = 0; k < 4; ++k) { const float a = __uint_as_float(w[k] << 16), b = __uint_as_float(w[k] & 0xffff0000u); ss += a * a + b * b; }
        }
        float r = rsqrtf(ss * (1.0f / DH) + RMS_EPS);
        if (u < 8) r *= 0.125f * 1.4426950408889634f;
        float v01[16];
#pragma unroll
        for (int c = 0; c < 8; ++c) {
            const unsigned w[4] = {raw[c].x, raw[c].y, raw[c].z, raw[c].w};
            float v[8];
#pragma unroll
            for (int k = 0; k < 4; ++k) { v[2 * k] = __uint_as_float(w[k] << 16) * r * g[c * 8 + 2 * k]; v[2 * k + 1] = __uint_as_float(w[k] & 0xffff0000u) * r * g[c * 8 + 2 * k + 1]; }
            uint4 o; o.x = pk2(v[0], v[1]); o.y = pk2(v[2], v[3]); o.z = pk2(v[4], v[5]); o.w = pk2(v[6], v[7]);
            if (c < 2 && u >= 8) {
#pragma unroll
                for (int k = 0; k < 8; ++k) v01[c * 8 + k] = v[k];
            } else {
                ((uint4*)src)[c] = o;
            }
        }
        if (u >= 8) {
            float ro[16];
#pragma unroll
            for (int j = 0; j < 8; ++j) {
                const float cs = ropec[t * 8 + j], sn = ropes[t * 8 + j];
                ro[j] = v01[j] * cs - v01[j + 8] * sn;
                ro[j + 8] = v01[j] * sn + v01[j + 8] * cs;
            }
            uint4 o0, o1;
            o0.x = pk2(ro[0], ro[1]); o0.y = pk2(ro[2], ro[3]); o0.z = pk2(ro[4], ro[5]); o0.w = pk2(ro[6], ro[7]);
            o1.x = pk2(ro[8], ro[9]); o1.y = pk2(ro[10], ro[11]); o1.z = pk2(ro[12], ro[13]); o1.w = pk2(ro[14], ro[15]);
            ((uint4*)src)[0] = o0; ((uint4*)src)[1] = o1;
        }
    }
}

constexpr int LDS_TOTAL = 153600;
constexpr int MISC_OFF = 152576;
static_assert(att::LDS_BYTES <= MISC_OFF && hg::L_END <= MISC_OFF && cp::L_END <= MISC_OFF && pg8::STAGE_BYTES <= MISC_OFF, "LDS map");
constexpr size_t MiB = 1u << 20;
constexpr size_t WS_CTL = 0, CTL_ZERO_BYTES = 64 * 1024;
constexpr size_t WS_WIN = 1 * MiB, WS_WOUT = 10 * MiB, WS_WPG = 12 * MiB, WS_WPP = 14 * MiB, WS_W1T = 15 * MiB, WS_TAB = 16 * MiB, WS_RSA = 17 * MiB, WS_RSB = 18 * MiB,
                 WS_SMALL = 19 * MiB, WS_BUF0 = 20 * MiB, WS_BUF1 = 52 * MiB, WS_PB = 84 * MiB, WS_T2 = 92 * MiB, WS_P = 108 * MiB, WS_SLOC = 248 * MiB, WS_END = 265 * MiB;
struct MegaArgs { const float* in[15]; float* out; unsigned char* ws; };

__global__ void __launch_bounds__(512, 2) mega_fwd(MegaArgs a) {
    extern __shared__ __attribute__((aligned(16))) unsigned char lds[];
    const int blk = blockIdx.x, G = gridDim.x;
    const int ngt = G * 512, ngw = G * 8;
#define THIN_IDS() const int tid_ = opq_tid(), lane = tid_ & 63, wid_ = __builtin_amdgcn_readfirstlane(tid_ >> 6); const int gt = blk * 512 + tid_, gw = blk * 8 + wid_; \
    float* scr = (float*)(lds + wid_ * 8448); (void)gt; (void)gw; (void)lane; (void)scr
    LAS unsigned char* l3 = (LAS unsigned char*)lds;
    volatile LAS unsigned* MISC = (volatile LAS unsigned*)(l3 + MISC_OFF);
    if (threadIdx.x < 64) MISC[threadIdx.x] = 0u;
    __syncthreads();
    XcdBarrier bar = xcd_barrier_post((unsigned*)(a.ws + WS_CTL) + 1024, MISC + 8);
#define KARG() ({ const __attribute__((address_space(4))) unsigned long long* k_ = (const __attribute__((address_space(4))) unsigned long long*)__builtin_amdgcn_kernarg_segment_ptr(); asm volatile("" : "+s"(k_)); k_; })
#define LPTR(k) ((unsigned char*)(GAS unsigned char*)(KARG()[k]))
#define IN_F(k) ((const float*)LPTR(k))
#define shm_() ((char*)lds)
#define WS_PTRS() unsigned char* ws = LPTR(16); \
    bf16* WIN_T = (bf16*)(ws + WS_WIN); bf16* WOUT_T = (bf16*)(ws + WS_WOUT); bf16* WPG_T = (bf16*)(ws + WS_WPG); bf16* WPP_T = (bf16*)(ws + WS_WPP); \
    bf16* W1T = (bf16*)(ws + WS_W1T); \
    float* lb_all = (float*)(ws + WS_TAB); float* ropec = lb_all + DEPTH * HG_W; float* ropes = ropec + SEQ * 8; \
    float* RSA = (float*)(ws + WS_RSA); float* RSB = (float*)(ws + WS_RSB); \
    unsigned long long* selmask = (unsigned long long*)(ws + WS_SMALL); \
    bf16* KC = (bf16*)(ws + WS_SMALL + 256 * 1024); bf16* VC = KC + (size_t)BATCH * KVH * 256 * 64; \
    bf16* OV = VC + (size_t)BATCH * KVH * 256 * 64; bf16* W2T = OV + 256 * 64; float* BIAS1 = (float*)(W2T + 2 * 64 * 128); float* DGL = BIAS1 + 256; \
    bf16* BUF0 = (bf16*)(ws + WS_BUF0); bf16* BUF1 = (bf16*)(ws + WS_BUF1); \
    bf16* PB = (bf16*)(ws + WS_PB); bf16* T2 = (bf16*)(ws + WS_T2); bf16* P = (bf16*)(ws + WS_P); bf16* PPb = P; float* SLOC = (float*)(ws + WS_SLOC); \
    bf16* HB = (i & 1) ? BUF1 : BUF0; bf16* Y = (i & 1) ? BUF0 : BUF1; float* h = (float*)LPTR(15); \
    (void)WIN_T; (void)WOUT_T; (void)WPG_T; (void)WPP_T; (void)W1T; (void)lb_all; (void)ropec; (void)ropes; (void)RSA; (void)RSB; (void)selmask; (void)KC; (void)VC; (void)OV; (void)W2T; \
    (void)BIAS1; (void)DGL; (void)PB; (void)T2; (void)P; (void)PPb; (void)SLOC; (void)HB; (void)Y; (void)h

    {
    const int i = 0;
    WS_PTRS();
    THIN_IDS();
    const float* x = IN_F(0); const float* norm_g = IN_F(2); const float* w_in = IN_F(3); const float* hgrn_lb = IN_F(4); const float* cmp_pe = IN_F(8);
    const float* cmp_w1 = IN_F(9); const float* cmp_w2 = IN_F(10);
    dev_tables(hgrn_lb, lb_all, ropec, ropes, OV, KC, VC, WIN_T, gt, ngt);
    dev_prep_x(x, h, BUF0, RSB, gw, ngw, lane);
    dev_transpose_w(w_in, D_MODEL, IN_COLS, WIN_T, norm_g, 1, scr, gw, ngw, lane);
    for (int kv = 0; kv < 2; ++kv) {
        dev_transpose_w(cmp_w1 + (size_t)kv * 2048 * 128, 2048, 128, W1T + (size_t)kv * 128 * 2048, nullptr, 0, scr, gw, ngw, lane);
        dev_transpose_w(cmp_w2 + (size_t)kv * 128 * 64, 128, 64, W2T + (size_t)kv * 64 * 128, nullptr, 0, scr, gw, ngw, lane);
    }
    dev_cmp_bias(cmp_pe, cmp_w1, BIAS1, gw, ngw, lane);
    }
    xcd_barrier(bar);

    for (int i = 0; i < DEPTH; ++i) {
        {
            WS_PTRS();
            pg8::Gemm g{HB, WIN_T, MROWS, NPROJ, D_MODEL};
            pg8::StaticOrder S; S.init(MROWS, NPROJ, G, blk);
            pg8::EpiProj E{P, PP, RSB, PP};
            pg8::gemm_phase<pg8::EpiProj, pg8::StaticOrder, true, true>(l3, g, S, E);
        }
        xcd_barrier(bar);
        {
        WS_PTRS();
        const float* nsa_qnorm_g = IN_F(6); const float* nsa_knorm_g = IN_F(7); const float* hgrn_onorm_g = IN_F(5);
        { THIN_IDS(); dev_nsa_prep(P, nsa_qnorm_g + i * DH, nsa_knorm_g + (size_t)i * 3 * DH, ropec, ropes, gt, ngt); }
        {
            hg::HgIO hio{P, Y, lb_all + i * HG_W, hgrn_onorm_g + i * HG_DV, SLOC, DGL};
            hg::hgrn_state_item(hio, blk, shm_());
        }
        if (blk < 128) {
            cp::CmpIO cio{P, W1T, W2T, BIAS1, nsa_knorm_g + (size_t)i * 3 * DH, KC, VC};
            cp::cmp_item(cio, blk, shm_());
        }
        {
        THIN_IDS();
        const float* p = IN_F(1); const float* norm_g = IN_F(2); const float* w_in = IN_F(3); const float* w_out = IN_F(11); const float* ple_norm_g = IN_F(12);
        const float* w_pg = IN_F(13); const float* w_pp = IN_F(14);
        dev_transpose_w(w_out + (size_t)i * D_MODEL * D_MODEL, D_MODEL, D_MODEL, WOUT_T, nullptr, 0, scr, gw, ngw, lane);
        dev_transpose_w(w_pg + (size_t)i * D_MODEL * D_MODEL, D_MODEL, D_MODEL, WPG_T, ple_norm_g + i * D_MODEL, 0, scr, gw, ngw, lane);
        dev_transpose_w(w_pp + (size_t)i * PLE * D_MODEL, PLE, D_MODEL, WPP_T, nullptr, 0, scr, gw, ngw, lane);
        dev_f32_to_bf16(p + (size_t)i * MROWS * PLE, PB, MROWS * PLE / 4, gt, ngt);
        if (i + 1 < DEPTH) dev_transpose_w(w_in + (size_t)(i + 1) * D_MODEL * IN_COLS, D_MODEL, IN_COLS, WIN_T, norm_g + (i + 1) * D_MODEL, 1, scr, gw, ngw, lane);
        }
        }
        xcd_barrier(bar);
        {
            WS_PTRS();
            const float* hgrn_onorm_g = IN_F(5);
            hg::HgIO hio{P, Y, lb_all + i * HG_W, hgrn_onorm_g + i * HG_DV, SLOC, DGL};
            if (blk < 128) hg::hgrn_scan_item(hio, blk);
            const int bk = blk >> 5, s = blk & 31;
            att::AttnIO io{P, KC, VC, Y, T2, selmask, ropec, ropes, 0};
            att::AttnIO io1{P, KC, OV, Y, T2, selmask, ropec, ropes, 1};
            att::attn_unit<2, 8>(bk >> 1, bk & 1, 63 - s, io, shm_());
            att::attn_unit<2, 8>(bk >> 1, bk & 1, s, io, shm_());
            att::attn_unit<2, 8>(bk >> 1, bk & 1, 63 - s, io1, shm_());
            att::attn_unit<2, 8>(bk >> 1, bk & 1, s, io1, shm_());
            att::attn_unit<1, 8>(bk >> 1, bk & 1, 63 - s, io, shm_());
            att::attn_unit<1, 8>(bk >> 1, bk & 1, s, io, shm_());
            if (i + 1 < DEPTH) {
                THIN_IDS();
                const float* cmp_pe = IN_F(8); const float* cmp_w1 = IN_F(9); const float* cmp_w2 = IN_F(10);
                for (int kv = 0; kv < 2; ++kv) {
                    dev_transpose_w(cmp_w1 + (size_t)((i + 1) * 2 + kv) * 2048 * 128, 2048, 128, W1T + (size_t)kv * 128 * 2048, nullptr, 0, scr, gw, ngw, lane);
                    dev_transpose_w(cmp_w2 + (size_t)((i + 1) * 2 + kv) * 128 * 64, 128, 64, W2T + (size_t)kv * 64 * 128, nullptr, 0, scr, gw, ngw, lane);
                }
                dev_cmp_bias(cmp_pe + (size_t)(i + 1) * 2 * 2048, cmp_w1 + (size_t)(i + 1) * 2 * 2048 * 128, BIAS1, gw, ngw, lane);
            }
        }
        xcd_barrier(bar);
        {
            WS_PTRS();
            const float* hgrn_onorm_g = IN_F(5);
            hg::HgIO hio{P, Y, lb_all + i * HG_W, hgrn_onorm_g + i * HG_DV, SLOC, DGL};
            hg::hgrn_out_item(hio, blk, shm_());
            const int bk = blk >> 5, s = blk & 31;
            att::AttnIO io{P, KC, VC, Y, T2, selmask, ropec, ropes, 0};
            att::attn_unit<0, 8>(bk >> 1, bk & 1, 63 - s, io, shm_());
            att::attn_unit<0, 8>(bk >> 1, bk & 1, s, io, shm_());
        }
        xcd_barrier(bar);
        {
            WS_PTRS();
            pg8::Gemm g{PB, WPP_T, MROWS, D_MODEL, PLE};
            pg8::StaticOrder S; S.init(MROWS, D_MODEL, G, blk);
            pg8::EpiProj E{PPb, 1024, nullptr, 1024};
            pg8::gemm_phase<pg8::EpiProj, pg8::StaticOrder, true, true>(l3, g, S, E);
        }
        {
            WS_PTRS();
            pg8::Gemm g{Y, WOUT_T, MROWS, D_MODEL, D_MODEL};
            pg8::StaticOrder S; S.init(MROWS, D_MODEL, G, blk);
            pg8::EpiHnew E{h, HB, RSA};
            pg8::gemm_phase<pg8::EpiHnew, pg8::StaticOrder, true, true>(l3, g, S, E);
        }
        xcd_barrier(bar);
        {
            WS_PTRS();
            pg8::Gemm g{HB, WPG_T, MROWS, D_MODEL, D_MODEL};
            pg8::StaticOrder S; S.init(MROWS, D_MODEL, G, blk);
            pg8::EpiPle E{h, (i + 1 < DEPTH) ? Y : nullptr, RSA, (i + 1 < DEPTH) ? RSB : nullptr, PPb};
            pg8::gemm_phase<pg8::EpiPle, pg8::StaticOrder, true, true>(l3, g, S, E);
        }
        if (i + 1 < DEPTH) xcd_barrier(bar);
    }
}

extern "C" void kernel_launch(void* const* d_in, const int* in_sizes, int n_in, void* d_out, int out_size, void* d_ws, size_t ws_size, hipStream_t stream) {
    static int grid = 0;
    if (grid == 0) {
        if (n_in != 15 || ws_size < WS_END) { fprintf(stderr, "kernel_launch: unexpected inputs / workspace (%d inputs, ws %zu < %zu)\n", n_in, ws_size, (size_t)WS_END); grid = -1; return; }
        int dev = 0, cus = 0, per_cu = 0;
        (void)hipGetDevice(&dev);
        (void)hipDeviceGetAttribute(&cus, hipDeviceAttributeMultiprocessorCount, dev);
        if (hipFuncSetAttribute((const void*)mega_fwd, hipFuncAttributeMaxDynamicSharedMemorySize, LDS_TOTAL) != hipSuccess) { fprintf(stderr, "kernel_launch: hipFuncSetAttribute failed\n"); grid = -1; return; }
        (void)hipOccupancyMaxActiveBlocksPerMultiprocessor(&per_cu, (const void*)mega_fwd, 512, LDS_TOTAL);
        (void)hipGetLastError();
        if (per_cu < 1 || cus != 256) { fprintf(stderr, "kernel_launch: needs one resident 512-thread workgroup on each of 256 CUs (cus %d, per_cu %d)\n", cus, per_cu); grid = -1; return; }
        grid = 256;
    }
    if (grid < 0) return;
    (void)hipMemsetAsync((char*)d_ws + WS_CTL, 0, CTL_ZERO_BYTES, stream);
    MegaArgs a{};
    for (int i = 0; i < 15; ++i) a.in[i] = (const float*)d_in[i];
    a.out = (float*)d_out; a.ws = (unsigned char*)d_ws;
    hipLaunchKernelGGL(mega_fwd, dim3(grid), dim3(512), LDS_TOTAL, stream, a);
}
```
